# Optimizing an MI355X kernel written in HIP

```python
import jax, jax.numpy as jnp
from jax import lax
import numpy as np

D_MODEL = 1024
BATCH = 2
SEQ = 8192
DEPTH = 4
DEC_BATCH = 128
DEC_SEQ = 1
PAST_LEN = 8192
PAGE_SIZE = 128

N_EVEN = (DEPTH + 1) // 2
N_ODD = DEPTH // 2
EPS = 1e-6

DN_HEADS = 4
DN_DK = 128
DN_DV = 128
DN_CONV = 4
DN_CHUNK = 64
SW_HEADS = 8
SW_KV_HEADS = 2
SW_GROUP = SW_HEADS // SW_KV_HEADS
SW_HD = 64
WINDOW = 128
GLA_HEADS = 4
GLA_DK = 128
GLA_DV = 256
GLA_RANK = 16
GLA_TAU = 16.0
GLA_CHUNK = 64
D_FF = 4 * D_MODEL

DN_QK = DN_HEADS * DN_DK
DN_V = DN_HEADS * DN_DV
DN_CONV_CH = 2 * DN_QK + DN_V
SW_Q = SW_HEADS * SW_HD
SW_KV = SW_KV_HEADS * SW_HD
EVEN_IN = DN_CONV_CH + DN_V + 2 * DN_HEADS + SW_Q + 2 * SW_KV
EVEN_MIX = DN_V + SW_Q
GLA_QK = GLA_HEADS * GLA_DK
GLA_V = GLA_HEADS * GLA_DV
ODD_IN = 2 * GLA_QK + 2 * GLA_V + GLA_RANK

kernel_name = "hybrid_deltanet_swa_gla_step"


def _split(a, sizes):
    out, o = [], 0
    for s in sizes:
        out.append(a[..., o:o + s])
        o += s
    return out


def _pad_time(a, lp):
    pad = lp - a.shape[1]
    if pad == 0:
        return a
    widths = [(0, 0)] * a.ndim
    widths[1] = (0, pad)
    return jnp.pad(a, widths)


def rmsnorm(x, g):
    xf = x.astype(jnp.float32)
    y = xf * lax.rsqrt(jnp.mean(xf * xf, -1, keepdims=True) + EPS)
    return (y * g.astype(jnp.float32)).astype(x.dtype)


def l2norm(x):
    xf = x.astype(jnp.float32)
    return xf * lax.rsqrt(jnp.sum(xf * xf, -1, keepdims=True) + EPS)


def causal_conv(u, buf, w):
    L = u.shape[1]
    ext = jnp.concatenate([buf.astype(u.dtype), u], 1)
    out = ext[:, 0:L] * w[0]
    for i in range(1, DN_CONV):
        out = out + ext[:, i:i + L] * w[i]
    return out, ext[:, ext.shape[1] - (DN_CONV - 1):]


def _to_chunks(a, C, nc):
    B = a.shape[0]
    a = _pad_time(a.astype(jnp.float32), nc * C)
    a = a.reshape((B, nc, C) + a.shape[2:])
    a = jnp.moveaxis(a, 3, 2)
    return jnp.moveaxis(a, 1, 0)


def _from_chunks(o, L):
    nc, B, H, C, d = o.shape
    o = jnp.swapaxes(jnp.moveaxis(o, 0, 1), 2, 3).reshape(B, nc * C, H, d)
    return o[:, :L]


def gated_delta_chunked(q, k, v, g, beta, S0):
    L = q.shape[1]
    C = min(DN_CHUNK, L)
    nc = -(-L // C)
    qc, kc, vc, gc, bc = (_to_chunks(t, C, nc) for t in (q, k, v, g, beta))
    tri_incl = jnp.tril(jnp.ones((C, C), bool))
    tri_strict = jnp.tril(jnp.ones((C, C), jnp.float32), -1)
    eye = jnp.eye(C, dtype=jnp.float32)

    def step(S, inp):
        qi, ki, vi, gi, bi = inp
        G = jnp.cumsum(gi, -1)
        decay = jnp.exp(jnp.where(tri_incl, G[..., :, None] - G[..., None, :], -jnp.inf))
        kb = ki * bi[..., None]
        M = jnp.einsum('bhid,bhjd->bhij', kb, ki) * decay * tri_strict
        T = lax.linalg.triangular_solve(eye + M, jnp.broadcast_to(eye, M.shape),
                                        left_side=True, lower=True, unit_diagonal=True)
        eG = jnp.exp(G)[..., None]
        u = T @ (vi * bi[..., None])
        w = T @ (kb * eG)
        v_new = u - w @ S
        attn = jnp.einsum('bhid,bhjd->bhij', qi, ki) * decay
        o = (qi * eG) @ S + attn @ v_new
        g_last = G[..., -1]
        S = S * jnp.exp(g_last)[..., None, None] + jnp.einsum(
            'bhcd,bhce->bhde', ki * jnp.exp(g_last[..., None] - G)[..., None], v_new)
        return S, o

    S, o = lax.scan(step, S0, (qc, kc, vc, gc, bc))
    return _from_chunks(o, L), S


def gla_chunked(q, k, v, glog, S0):
    L = q.shape[1]
    C = min(GLA_CHUNK, L)
    nc = -(-L // C)
    qc, kc, vc, gc = (_to_chunks(t, C, nc) for t in (q, k, v, glog))
    tri_incl = jnp.tril(jnp.ones((C, C), bool))[:, :, None]

    def step(S, inp):
        qi, ki, vi, gi = inp
        G = jnp.cumsum(gi, axis=2)
        dec = jnp.exp(jnp.where(tri_incl, G[:, :, :, None, :] - G[:, :, None, :, :], -jnp.inf))
        attn = jnp.einsum('bhid,bhjd,bhijd->bhij', qi, ki, dec)
        o = (qi * jnp.exp(G)) @ S + attn @ vi
        gl = G[:, :, -1]
        S = S * jnp.exp(gl)[..., None] + jnp.einsum(
            'bhcd,bhce->bhde', ki * jnp.exp(gl[:, :, None] - G), vi)
        return S, o

    S, o = lax.scan(step, S0, (qc, kc, vc, gc))
    return _from_chunks(o, L), S


def swa_attention(q, k, v, k_past, v_past, sinks, start):
    B, L = q.shape[:2]
    Qb = min(WINDOW, L)
    nb = -(-L // Qb)
    Lp = nb * Qb
    k_all = jnp.concatenate([k_past.astype(k.dtype), _pad_time(k, Lp)], 1)
    v_all = jnp.concatenate([v_past.astype(v.dtype), _pad_time(v, Lp)], 1)
    idx = (jnp.arange(nb) * Qb)[:, None] + jnp.arange(WINDOW + Qb)[None]
    kb = k_all[:, idx]
    vb = v_all[:, idx]
    qb = _pad_time(q, Lp).reshape(B, nb, Qb, SW_KV_HEADS, SW_GROUP, SW_HD)
    qpos = start + jnp.arange(Lp).reshape(nb, Qb)
    kpos = start - WINDOW + idx
    rel = qpos[:, :, None] - kpos[:, None, :]
    valid = (rel >= 0) & (rel < WINDOW) & (kpos[:, None, :] >= 0)
    slopes = jnp.exp2(-8.0 * jnp.arange(1, SW_HEADS + 1, dtype=jnp.float32) / SW_HEADS)
    slopes = slopes.reshape(SW_KV_HEADS, SW_GROUP)[:, :, None, None]
    s = jnp.einsum('bnqkgd,bnskd->bnkgqs', qb, kb).astype(jnp.float32) * (SW_HD ** -0.5)
    s = s - slopes * rel[:, None, None].astype(jnp.float32)
    s = jnp.where(valid[None, :, None, None], s, -jnp.inf)
    sink = sinks.astype(jnp.float32).reshape(SW_KV_HEADS, SW_GROUP)[:, :, None, None]
    m = jnp.maximum(jnp.max(s, -1, keepdims=True), sink)
    p = jnp.exp(s - m)
    p = p / (jnp.sum(p, -1, keepdims=True) + jnp.exp(sink - m))
    o = jnp.einsum('bnkgqs,bnskd->bnqkgd', p.astype(v.dtype), vb)
    o = o.reshape(B, Lp, SW_Q)[:, :L]
    new_k = jnp.concatenate([k_past.astype(k.dtype), k], 1)[:, L:]
    new_v = jnp.concatenate([v_past.astype(v.dtype), v], 1)[:, L:]
    return o, new_k, new_v


def even_mixer(h, start, S0, conv_buf, k_past, v_past, w_in, conv_w, a_log, dt_bias, dn_norm, sinks, w_out):
    B, L, _ = h.shape
    f32 = jnp.float32
    proj = h @ w_in
    qkv, z, a, b, q_sw, k_sw, v_sw = _split(proj, [DN_CONV_CH, DN_V, DN_HEADS, DN_HEADS, SW_Q, SW_KV, SW_KV])
    conv, new_buf = causal_conv(qkv, conv_buf, conv_w)
    conv = jax.nn.silu(conv.astype(f32))
    qd, kd, vd = _split(conv, [DN_QK, DN_QK, DN_V])
    qd = l2norm(qd.reshape(B, L, DN_HEADS, DN_DK)) * (DN_DK ** -0.5)
    kd = l2norm(kd.reshape(B, L, DN_HEADS, DN_DK))
    vd = vd.reshape(B, L, DN_HEADS, DN_DV)
    beta = jax.nn.sigmoid(b.astype(f32))
    g = -jnp.exp(a_log.astype(f32)) * jax.nn.softplus(a.astype(f32) + dt_bias.astype(f32))
    o_dn, S = gated_delta_chunked(qd, kd, vd, g, beta, S0.astype(f32))
    o_dn = rmsnorm(o_dn, dn_norm) * jax.nn.silu(z.astype(f32)).reshape(B, L, DN_HEADS, DN_DV)
    o_dn = o_dn.reshape(B, L, DN_V).astype(h.dtype)
    o_sw, new_k, new_v = swa_attention(q_sw.reshape(B, L, SW_HEADS, SW_HD),
                                       k_sw.reshape(B, L, SW_KV_HEADS, SW_HD),
                                       v_sw.reshape(B, L, SW_KV_HEADS, SW_HD),
                                       k_past, v_past, sinks, start)
    out = jnp.concatenate([o_dn, o_sw.astype(h.dtype)], -1) @ w_out
    return out, S.astype(h.dtype), new_buf, new_k, new_v


def odd_mixer(h, S0, w_in, w_gate_up, b_gate, gla_norm, w_out):
    B, L, _ = h.shape
    f32 = jnp.float32
    proj = h @ w_in
    q, k, v, r, gdown = _split(proj, [GLA_QK, GLA_QK, GLA_V, GLA_V, GLA_RANK])
    glog = jax.nn.log_sigmoid((gdown @ w_gate_up + b_gate).astype(f32)) / GLA_TAU
    q = q.astype(f32).reshape(B, L, GLA_HEADS, GLA_DK) * (GLA_DK ** -0.5)
    k = k.astype(f32).reshape(B, L, GLA_HEADS, GLA_DK)
    v = v.astype(f32).reshape(B, L, GLA_HEADS, GLA_DV)
    o, S = gla_chunked(q, k, v, glog.reshape(B, L, GLA_HEADS, GLA_DK), S0.astype(f32))
    o = rmsnorm(o, gla_norm) * jax.nn.silu(r.astype(f32)).reshape(B, L, GLA_HEADS, GLA_DV)
    out = o.reshape(B, L, GLA_V).astype(h.dtype) @ w_out
    return out, S.astype(h.dtype)


def trunk(x, start, st_dn, st_conv, c_k, c_v, st_gla,
          norm_mix, norm_mlp, norm_final,
          even_w_in, dn_conv_w, dn_a_log, dn_dt_bias, dn_norm, sw_sinks, even_w_out,
          gla_w_in, gla_w_gate_up, gla_b_gate, gla_norm, gla_w_out,
          mlp_w_up, mlp_w_down):
    n_dn, n_conv, n_k, n_v, n_gla = [], [], [], [], []
    for layer in range(DEPTH):
        h = rmsnorm(x, norm_mix[layer])
        if layer % 2 == 0:
            e = layer // 2
            mix, S, buf, nk, nv = even_mixer(h, start, st_dn[e], st_conv[e], c_k[e], c_v[e],
                                             even_w_in[e], dn_conv_w[e], dn_a_log[e], dn_dt_bias[e],
                                             dn_norm[e], sw_sinks[e], even_w_out[e])
            n_dn.append(S); n_conv.append(buf); n_k.append(nk); n_v.append(nv)
        else:
            o_i = layer // 2
            mix, S = odd_mixer(h, st_gla[o_i], gla_w_in[o_i], gla_w_gate_up[o_i], gla_b_gate[o_i],
                               gla_norm[o_i], gla_w_out[o_i])
            n_gla.append(S)
        x = x + mix
        h = rmsnorm(x, norm_mlp[layer])
        x = x + jnp.square(jax.nn.relu(h @ mlp_w_up[layer])) @ mlp_w_down[layer]
    y = rmsnorm(x, norm_final)
    return y, jnp.stack(n_dn), jnp.stack(n_conv), jnp.stack(n_k), jnp.stack(n_v), jnp.stack(n_gla)


def setup_inputs(seed: int = 0) -> dict:
    key = jax.random.key(seed)
    ks = iter(jax.random.split(key, 32))
    nrm = lambda shape, s: jax.random.normal(next(ks), shape, jnp.float32) * s
    return {
        "x_prompt": nrm((BATCH, SEQ, D_MODEL), 1.0),
        "x_sample": nrm((DEC_BATCH, DEC_SEQ, D_MODEL), 1.0),
        "state_dn": nrm((N_EVEN, DEC_BATCH, DN_HEADS, DN_DK, DN_DV), 0.1),
        "state_dn_conv": nrm((N_EVEN, DEC_BATCH, DN_CONV - 1, DN_CONV_CH), 1.0),
        "cache_swa_k": nrm((N_EVEN, DEC_BATCH, WINDOW, SW_KV_HEADS, SW_HD), 1.0),
        "cache_swa_v": nrm((N_EVEN, DEC_BATCH, WINDOW, SW_KV_HEADS, SW_HD), 1.0),
        "state_gla": nrm((N_ODD, DEC_BATCH, GLA_HEADS, GLA_DK, GLA_DV), 0.3),
        "norm_mix": 1.0 + nrm((DEPTH, D_MODEL), 0.02),
        "norm_mlp": 1.0 + nrm((DEPTH, D_MODEL), 0.02),
        "norm_final": 1.0 + nrm((D_MODEL,), 0.02),
        "even_w_in": nrm((N_EVEN, D_MODEL, EVEN_IN), D_MODEL ** -0.5),
        "dn_conv_w": nrm((N_EVEN, DN_CONV, DN_CONV_CH), DN_CONV ** -0.5),
        "dn_a_log": jnp.log(jax.random.uniform(next(ks), (N_EVEN, DN_HEADS), jnp.float32, 1.0, 16.0)),
        "dn_dt_bias": nrm((N_EVEN, DN_HEADS), 0.1),
        "dn_norm": 1.0 + nrm((N_EVEN, DN_DV), 0.02),
        "sw_sinks": nrm((N_EVEN, SW_HEADS), 0.5),
        "even_w_out": nrm((N_EVEN, EVEN_MIX, D_MODEL), EVEN_MIX ** -0.5),
        "gla_w_in": nrm((N_ODD, D_MODEL, ODD_IN), D_MODEL ** -0.5),
        "gla_w_gate_up": nrm((N_ODD, GLA_RANK, GLA_QK), GLA_RANK ** -0.5),
        "gla_b_gate": nrm((N_ODD, GLA_QK), 0.1),
        "gla_norm": 1.0 + nrm((N_ODD, GLA_DV), 0.02),
        "gla_w_out": nrm((N_ODD, GLA_V, D_MODEL), GLA_V ** -0.5),
        "mlp_w_up": nrm((DEPTH, D_MODEL, D_FF), D_MODEL ** -0.5),
        "mlp_w_down": nrm((DEPTH, D_FF, D_MODEL), D_FF ** -0.5),
    }


def reference(x_prompt, x_sample, state_dn, state_dn_conv, cache_swa_k, cache_swa_v, state_gla,
              norm_mix, norm_mlp, norm_final,
              even_w_in, dn_conv_w, dn_a_log, dn_dt_bias, dn_norm, sw_sinks, even_w_out,
              gla_w_in, gla_w_gate_up, gla_b_gate, gla_norm, gla_w_out,
              mlp_w_up, mlp_w_down):
    dt = x_prompt.dtype
    weights = (norm_mix, norm_mlp, norm_final,
               even_w_in, dn_conv_w, dn_a_log, dn_dt_bias, dn_norm, sw_sinks, even_w_out,
               gla_w_in, gla_w_gate_up, gla_b_gate, gla_norm, gla_w_out,
               mlp_w_up, mlp_w_down)
    z_dn = jnp.zeros((N_EVEN, BATCH, DN_HEADS, DN_DK, DN_DV), dt)
    z_conv = jnp.zeros((N_EVEN, BATCH, DN_CONV - 1, DN_CONV_CH), dt)
    z_kv = jnp.zeros((N_EVEN, BATCH, WINDOW, SW_KV_HEADS, SW_HD), dt)
    z_gla = jnp.zeros((N_ODD, BATCH, GLA_HEADS, GLA_DK, GLA_DV), dt)
    y_prompt, p_dn, p_conv, p_k, p_v, p_gla = trunk(x_prompt, 0, z_dn, z_conv, z_kv, z_kv, z_gla, *weights)
    y_sample, s_dn, s_conv, s_k, s_v, s_gla = trunk(x_sample, PAST_LEN, state_dn, state_dn_conv,
                                                    cache_swa_k, cache_swa_v, state_gla, *weights)
    return (y_prompt, y_sample, p_dn, p_conv, p_k, p_v, p_gla, s_dn, s_conv, s_k, s_v, s_gla)
```

```cpp
#include <hip/hip_runtime.h>
#include <hip/hip_cooperative_groups.h>
#include <cstdio>
#include <cstdint>
namespace cg = cooperative_groups;
#ifndef MK_LAUNCH_PER_PHASE
#define MK_LAUNCH_PER_PHASE 0
#endif
namespace pg8 {
#define PG8_LAS __attribute__((address_space(3)))
typedef unsigned short bf16_t;
typedef short bf16x8 __attribute__((ext_vector_type(8)));
typedef float f32x4 __attribute__((ext_vector_type(4)));
typedef unsigned u32x4 __attribute__((ext_vector_type(4)));
constexpr int BM = 256, BK = 64, HALF = 128, HTB = HALF * BK * 2  , STAGE_BYTES = 8 * HTB, NXCD = 8, WGM = 8;

__host__ __device__ __forceinline__ int lds_byte(int r, int c) { const int st = (r >> 4) * 2 + (c >> 5), rr = r & 15, cc = c & 31, ob = rr * 64 + cc * 2; return st * 1024 + (ob ^ (((ob >> 9) & 1) << 5)); }
__host__ __device__ __forceinline__ void stage_rc(int b, int& R, int& C) { const int st = b / 1024, sb = b % 1024, swz = sb ^ (((sb >> 9) & 1) << 5); R = (st >> 1) * 16 + swz / 64; C = (st & 1) * 32 + (swz % 64) / 2; }
__host__ __device__ __forceinline__ int perm32(int rho) { const int n = rho >> 4, i = rho & 15; return 8 * (i >> 2) + 4 * n + (i & 3); }

struct Unit { int pm, pn; };
struct Gemm { const bf16_t* A; const bf16_t* Bt; int M, N, K; };

struct StaticOrder {
    int nM, nN, nwg, G, c;
    __host__ __device__ void init(int M, int N, int G_, int c_) { nM = M / BM; nN = N / BM; nwg = nM * nN; G = G_; c = c_; }
    __host__ __device__ bool next(int i, Unit& u) const {
        const long L = (long)i * G + c; if (L >= nwg) return false;
        int wgid = (int)L; { const int q = nwg / NXCD, r = nwg % NXCD, xcd = wgid % NXCD, off = wgid / NXCD; wgid = (xcd < r ? xcd * (q + 1) : r * (q + 1) + (xcd - r) * q) + off; }
        const int nig = WGM * nN, gid = wgid / nig, fm = gid * WGM, gsz = (nM - fm) < WGM ? (nM - fm) : WGM;
        u.pm = fm + ((wgid % nig) % gsz); u.pn = (wgid % nig) / gsz; return true;
    }
    __device__ __forceinline__ void a_ready(const Unit&) const {}
    __device__ __forceinline__ void done(const Unit&) const {}
};

__device__ __forceinline__ unsigned cvt_pk_bf16(float lo, float hi) { unsigned r; asm volatile("v_cvt_pk_bf16_f32 %0, %1, %2" : "=v"(r) : "v"(lo), "v"(hi)); return r; }
typedef float f32x2 __attribute__((ext_vector_type(2)));
template <int ACT> struct EpiBf16 {
    static constexpr bool PERM = true, AFTER_DRAIN = false;
    bf16_t* O; int ldc;
    __device__ __forceinline__ void operator()(const f32x4 (&acc)[2][2][4][2], const Unit& u, int wr, int wc, int fr, int fq) const {
        const int row0 = u.pm * BM + wr * 64 + fr; const int col0 = u.pn * BM + wc * 32 + 8 * fq;
#pragma unroll
        for (int ai = 0; ai < 2; ++ai)
#pragma unroll
            for (int m = 0; m < 4; ++m) { bf16_t* rowp = O + (size_t)(row0 + ai * HALF + m * 16) * ldc + col0;
#pragma unroll
                for (int bj = 0; bj < 2; ++bj) { f32x4 v0 = acc[ai][bj][m][0], v1 = acc[ai][bj][m][1];
                    if (ACT == 2) {
#pragma unroll
                        for (int j = 0; j < 4; ++j) { float a = v0[j] > 0.f ? v0[j] : 0.f; v0[j] = a * a; float b = v1[j] > 0.f ? v1[j] : 0.f; v1[j] = b * b; } }
                    u32x4 w; w.x = cvt_pk_bf16(v0[0], v0[1]); w.y = cvt_pk_bf16(v0[2], v0[3]); w.z = cvt_pk_bf16(v1[0], v1[1]); w.w = cvt_pk_bf16(v1[2], v1[3]);
                    *(u32x4*)(rowp + bj * HALF) = w; } }
    }
};
struct EpiRes {
    static constexpr bool PERM = false, AFTER_DRAIN = false;
    float* X; int ldc; float sgn;
    __device__ __forceinline__ void operator()(const f32x4 (&acc)[2][2][4][2], const Unit& u, int wr, int wc, int fr, int fq) const {
        const int col0 = u.pn * BM + wc * 32 + 4 * fq;
#pragma unroll
        for (int ai = 0; ai < 2; ++ai) {
            float* base = X + (size_t)(u.pm * BM + ai * HALF + wr * 64 + fr) * ldc + col0;
            f32x4 r[4][2][2];
#pragma unroll
            for (int m = 0; m < 4; ++m)
#pragma unroll
                for (int bj = 0; bj < 2; ++bj)
#pragma unroll
                    for (int n = 0; n < 2; ++n) r[m][bj][n] = *(const f32x4*)(base + (size_t)(m * 16) * ldc + bj * HALF + n * 16);
            asm volatile("" ::: "memory");
#pragma unroll
            for (int m = 0; m < 4; ++m)
#pragma unroll
                for (int bj = 0; bj < 2; ++bj)
#pragma unroll
                    for (int n = 0; n < 2; ++n) *(f32x4*)(base + (size_t)(m * 16) * ldc + bj * HALF + n * 16) = r[m][bj][n] + acc[ai][bj][m][n] * sgn;
            asm volatile("" ::: "memory");
        }
    }
};
template <class Epi, class Sched, bool ALIGN_EPI = false, bool SP2 = false>
__device__ __forceinline__ void gemm_phase(PG8_LAS unsigned char* lds, const Gemm g, const Sched& S, const Epi& E) {
    int tid = threadIdx.x; asm volatile("" : "+v"(tid)); const int wid = __builtin_amdgcn_readfirstlane(tid >> 6), lane = tid & 63, wr = wid >> 2, wc = wid & 3, fr = lane & 15, fq = lane >> 4;
    const int K = g.K, nt = K / BK;
    unsigned voffA[2], voffB[2];
#pragma unroll
    for (int i = 0; i < 2; ++i) { int R, C; stage_rc(tid * 16 + i * 8192, R, C); const int Rb = Epi::PERM ? ((R & ~31) + perm32(R & 31)) : R;
        voffA[i] = (unsigned)(R * K + C) * 2u; voffB[i] = (unsigned)(Rb * K + C) * 2u; }
    const size_t kstep = (size_t)(BK * 2);
    const size_t hstep = (size_t)HALF * K * 2;
    const size_t tstep = 2 * hstep;
    const unsigned ldsw = (unsigned)wid * 1024u;
    const int aoff = lds_byte(wr * 64 + fr, fq * 8), boff = lds_byte(wc * 32 + fr, fq * 8);
#define PG8_SA(b, h) (((b) * 2 + (h)) * HTB)
#define PG8_SB(b, h) ((4 + (b) * 2 + (h)) * HTB)
#define PG8_STAGE(bufoff, gbase, voff) do { _Pragma("unroll") for (int _i = 0; _i < 2; ++_i) \
        __builtin_amdgcn_global_load_lds((const unsigned*)((const char*)(gbase) + (voff)[_i]), (PG8_LAS unsigned*)(lds + (bufoff) + ldsw + _i * 8192), 16, 0, 0); } while (0)
#define PG8_LDA(dst, b, h) do { _Pragma("unroll") for (int m = 0; m < 4; ++m) _Pragma("unroll") for (int k = 0; k < 2; ++k) dst[m][k] = *(const PG8_LAS bf16x8*)(lds + PG8_SA(b, h) + aoff + m * 2048 + k * 1024); } while (0)
#define PG8_LDB(dst, b, h) do { _Pragma("unroll") for (int n = 0; n < 2; ++n) _Pragma("unroll") for (int k = 0; k < 2; ++k) dst[n][k] = *(const PG8_LAS bf16x8*)(lds + PG8_SB(b, h) + boff + n * 2048 + k * 1024); } while (0)
#define PG8_MMA(ai, bj, At, Bt) do { __builtin_amdgcn_s_setprio(1); _Pragma("unroll") for (int m = 0; m < 4; ++m) _Pragma("unroll") for (int n = 0; n < 2; ++n) _Pragma("unroll") for (int k = 0; k < 2; ++k) \
        acc[ai][bj][m][n] = __builtin_amdgcn_mfma_f32_16x16x32_bf16(Bt[n][k], At[m][k], acc[ai][bj][m][n], 0, 0, 0); __builtin_amdgcn_s_setprio(0); } while (0)
#define PG8_WAIT_V(n) asm volatile("s_waitcnt vmcnt(" #n ")" ::: "memory")
#define PG8_WAIT_L(n) asm volatile("s_waitcnt lgkmcnt(" #n ")" ::: "memory")
#define PG8_BAR __builtin_amdgcn_s_barrier()
#define PG8_SCHED __builtin_amdgcn_sched_barrier(0)
    Unit cur, nxt; int ui = 0;
    if (!S.next(0, cur)) return;
    f32x4 acc[2][2][4][2];
#pragma unroll
    for (int a = 0; a < 2; ++a)
#pragma unroll
        for (int b = 0; b < 2; ++b)
#pragma unroll
            for (int m = 0; m < 4; ++m)
#pragma unroll
                for (int n = 0; n < 2; ++n) acc[a][b][m][n] = (f32x4){0.f, 0.f, 0.f, 0.f};
    bf16x8 At[4][2], B0[2][2], B1[2][2];
    const char* cA = (const char*)g.A + (size_t)cur.pm * tstep; const char* cB = (const char*)g.Bt + (size_t)cur.pn * tstep;
    S.a_ready(cur);
    if constexpr (SP2) {
        PG8_STAGE(PG8_SB(0, 0), cB, voffB); PG8_STAGE(PG8_SB(0, 1), cB + hstep, voffB); PG8_STAGE(PG8_SA(0, 0), cA, voffA); PG8_STAGE(PG8_SA(0, 1), cA + hstep, voffA);
        if (wr == 1) PG8_BAR;
        PG8_WAIT_V(2); PG8_BAR;
        PG8_STAGE(PG8_SB(1, 0), cB + kstep, voffB); PG8_STAGE(PG8_SA(1, 0), cA + kstep, voffA); PG8_STAGE(PG8_SB(1, 1), cB + hstep + kstep, voffB);
        PG8_WAIT_V(6); PG8_BAR;
    } else {
        PG8_STAGE(PG8_SB(0, 0), cB, voffB); PG8_STAGE(PG8_SA(0, 0), cA, voffA); PG8_STAGE(PG8_SB(0, 1), cB + hstep, voffB); PG8_STAGE(PG8_SA(0, 1), cA + hstep, voffA);
        if (wr == 1) PG8_BAR;
        PG8_WAIT_V(4); PG8_BAR;
        PG8_STAGE(PG8_SB(1, 0), cB + kstep, voffB); PG8_STAGE(PG8_SA(1, 0), cA + kstep, voffA); PG8_STAGE(PG8_SB(1, 1), cB + hstep + kstep, voffB);
        PG8_WAIT_V(6); PG8_BAR;
    }
    for (;;) {
        const bool has_next = S.next(ui + 1, nxt);
        const char* nA = has_next ? (const char*)g.A + (size_t)nxt.pm * tstep : cA; const char* nB = has_next ? (const char*)g.Bt + (size_t)nxt.pn * tstep : cB;
        for (int t = 0; t < nt; t += 2) {
            const bool last = (t == nt - 2);
            const char* a1 = cA + (size_t)(t + 1) * kstep;
            const char* a2 = last ? nA : cA + (size_t)(t + 2) * kstep; const char* b2 = last ? nB : cB + (size_t)(t + 2) * kstep;
            const char* a3 = a2 + kstep; const char* b3 = b2 + kstep;
            if (last && has_next) S.a_ready(nxt);
            if constexpr (SP2) {
            PG8_LDB(B0, 0, 0); PG8_LDB(B1, 0, 1); PG8_SCHED; PG8_LDA(At, 0, 0); PG8_STAGE(PG8_SA(1, 1), a1 + hstep, voffA);
            PG8_WAIT_V(8); PG8_WAIT_L(0); PG8_BAR; PG8_MMA(0, 0, At, B0); PG8_MMA(0, 1, At, B1); PG8_BAR; PG8_SCHED;
            PG8_LDA(At, 0, 1); PG8_STAGE(PG8_SB(0, 0), b2, voffB); PG8_STAGE(PG8_SB(0, 1), b2 + hstep, voffB); PG8_STAGE(PG8_SA(0, 0), a2, voffA);
            PG8_WAIT_V(8); PG8_WAIT_L(0); PG8_BAR; PG8_MMA(1, 0, At, B0); PG8_MMA(1, 1, At, B1); PG8_BAR; PG8_SCHED;
            PG8_LDB(B0, 1, 0); PG8_LDB(B1, 1, 1); PG8_SCHED; PG8_LDA(At, 1, 0); PG8_STAGE(PG8_SA(0, 1), a2 + hstep, voffA);
            PG8_WAIT_V(8); PG8_WAIT_L(0); PG8_BAR; PG8_MMA(0, 0, At, B0); PG8_MMA(0, 1, At, B1); PG8_BAR; PG8_SCHED;
            PG8_LDA(At, 1, 1); PG8_STAGE(PG8_SB(1, 0), b3, voffB); PG8_STAGE(PG8_SB(1, 1), b3 + hstep, voffB); PG8_STAGE(PG8_SA(1, 0), a3, voffA);
            PG8_WAIT_V(8); PG8_WAIT_L(0); PG8_BAR; PG8_MMA(1, 0, At, B0); PG8_MMA(1, 1, At, B1); PG8_BAR; PG8_SCHED;
            } else {
            PG8_LDB(B0, 0, 0); PG8_SCHED; PG8_LDA(At, 0, 0); PG8_STAGE(PG8_SA(1, 1), a1 + hstep, voffA);
            PG8_WAIT_L(8); PG8_BAR; PG8_WAIT_L(0); PG8_MMA(0, 0, At, B0); PG8_BAR; PG8_SCHED;
            PG8_LDB(B1, 0, 1); PG8_STAGE(PG8_SB(0, 0), b2, voffB);
            PG8_BAR; PG8_WAIT_L(0); PG8_MMA(0, 1, At, B1); PG8_BAR;
            PG8_LDA(At, 0, 1); PG8_STAGE(PG8_SA(0, 0), a2, voffA);
            PG8_BAR; PG8_WAIT_L(0); PG8_MMA(1, 0, At, B0); PG8_BAR; PG8_SCHED;
            PG8_STAGE(PG8_SB(0, 1), b2 + hstep, voffB);
            PG8_WAIT_V(6); PG8_BAR; PG8_MMA(1, 1, At, B1); PG8_BAR;
            PG8_LDB(B0, 1, 0); PG8_SCHED; PG8_LDA(At, 1, 0); PG8_STAGE(PG8_SA(0, 1), a2 + hstep, voffA);
            PG8_WAIT_L(8); PG8_BAR; PG8_WAIT_L(0); PG8_MMA(0, 0, At, B0); PG8_BAR; PG8_SCHED;
            PG8_LDB(B1, 1, 1); PG8_STAGE(PG8_SB(1, 0), b3, voffB);
            PG8_BAR; PG8_WAIT_L(0); PG8_MMA(0, 1, At, B1); PG8_BAR;
            PG8_LDA(At, 1, 1); PG8_STAGE(PG8_SA(1, 0), a3, voffA);
            PG8_BAR; PG8_WAIT_L(0); PG8_MMA(1, 0, At, B0); PG8_BAR; PG8_SCHED;
            PG8_STAGE(PG8_SB(1, 1), b3 + hstep, voffB);
            PG8_WAIT_V(6); PG8_BAR; PG8_MMA(1, 1, At, B1); PG8_BAR;
            }
        }
        if constexpr (ALIGN_EPI) { if (wr == 0) PG8_BAR; }
        if constexpr (!Epi::AFTER_DRAIN) { E(acc, cur, wr, wc, fr, fq); S.done(cur); }
        if (!has_next) break;
#pragma unroll
        for (int a = 0; a < 2; ++a)
#pragma unroll
            for (int b = 0; b < 2; ++b)
#pragma unroll
                for (int m = 0; m < 4; ++m)
#pragma unroll
                    for (int n = 0; n < 2; ++n) acc[a][b][m][n] = (f32x4){0.f, 0.f, 0.f, 0.f};
        cur = nxt; cA = nA; cB = nB; ++ui;
        if constexpr (ALIGN_EPI) { if (wr == 1) PG8_BAR; }
    }
    PG8_WAIT_V(0);
    if constexpr (!ALIGN_EPI) { if (wr == 0) PG8_BAR; }
    PG8_BAR;
    if constexpr (Epi::AFTER_DRAIN) { E.fused(acc, cur, wr, wc, fr, fq, lds, wid, lane); S.done(cur); }
#undef PG8_SA
#undef PG8_SB
#undef PG8_STAGE
#undef PG8_LDA
#undef PG8_LDB
#undef PG8_MMA
#undef PG8_WAIT_V
#undef PG8_WAIT_L
#undef PG8_BAR
#undef PG8_SCHED
}
}
typedef unsigned short bf16;
typedef short bf16x8 __attribute__((ext_vector_type(8)));
typedef float f32x4 __attribute__((ext_vector_type(4)));
typedef float f32x2v __attribute__((ext_vector_type(2)));
typedef unsigned u32x4 __attribute__((ext_vector_type(4)));
typedef unsigned u32x2 __attribute__((ext_vector_type(2)));

constexpr int DM = 1024, SEQ = 8192, MPR = 16384, MSA = 128, MREAL = 16512, MPAD = 16640, FF = 4096;
constexpr int NPE = 3072, NPO = 3328, NE_IN = 2824, NO_IN = 3088;
constexpr float EPS = 1e-6f;
constexpr size_t MiB = 1u << 20;
constexpr size_t WS_WEI = 1 * MiB;
constexpr size_t WS_WEO = WS_WEI + 12 * MiB;
constexpr size_t WS_WGI = WS_WEO + 4 * MiB;
constexpr size_t WS_WGO = WS_WGI + 13 * MiB;
constexpr size_t WS_WUP = WS_WGO + 4 * MiB;
constexpr size_t WS_WDN = WS_WUP + 32 * MiB;
constexpr size_t WS_X   = WS_WDN + 32 * MiB;
constexpr size_t WS_HB  = WS_X + 65 * MiB;
constexpr size_t WS_MIX = WS_HB + 33 * MiB;
constexpr size_t WS_BIG = WS_MIX + 33 * MiB;
constexpr size_t WS_SCR = WS_BIG + 106 * MiB;
constexpr size_t SC_DN_W = WS_SCR, SC_DN_QE = SC_DN_W + 16 * MiB, SC_DN_KT = SC_DN_QE + 16 * MiB, SC_DN_AT = SC_DN_KT + 16 * MiB,
                 SC_DN_U = SC_DN_AT + 8 * MiB, SC_DN_EGL = SC_DN_U + 16 * MiB, SC_DN_O = SC_DN_EGL + 1 * MiB;
constexpr size_t SC_GL_US = WS_SCR, SC_GL_QT = SC_GL_US + 64 * MiB, SC_GL_OI = SC_GL_QT + 16 * MiB, SC_GL_EGL = SC_GL_OI + 32 * MiB;
constexpr size_t SC_DN_VN = SC_DN_O + 32 * MiB;
constexpr size_t WS_END = WS_SCR + 122 * MiB;
constexpr size_t O_Y = 0, O_PDN = 16908288, O_PCONV = 17170432, O_PK = 17188864, O_PV = 17254400, O_PGLA = 17319936,
                 O_SDN = 17844224, O_SCONV = 34621440, O_SK = 35801088, O_SV = 39995392, O_SGLA = 44189696;
constexpr int LDS_BYTES = 147456;
constexpr int NPH = 37;

struct Args { const float* in[24]; float* out; unsigned char* ws; int ph_lo, ph_hi; };

typedef __bf16 bf16x2_t __attribute__((ext_vector_type(2)));
__device__ __forceinline__ unsigned pk2(float lo, float hi) { bf16x2_t v; v.x = (__bf16)lo; v.y = (__bf16)hi; return __builtin_bit_cast(unsigned, v); }
__device__ __forceinline__ unsigned f2bf(float f) { return pk2(f, 0.f) & 0xffffu; }
__device__ __forceinline__ float bf2f(unsigned h) { return __uint_as_float(h << 16); }

__device__ __forceinline__ float bflo(unsigned u) { return __uint_as_float(u << 16); }
__device__ __forceinline__ float bfhi(unsigned u) { return __uint_as_float(u & 0xffff0000u); }
__device__ __forceinline__ f32x4 mfma16(bf16x8 a, bf16x8 b, f32x4 c) { return __builtin_amdgcn_mfma_f32_16x16x32_bf16(a, b, c, 0, 0, 0); }
__device__ __forceinline__ float opq(float x) { asm volatile("" : "+v"(x)); return x; }
__device__ __forceinline__ float siluf(float x) { return x * __builtin_amdgcn_rcpf(1.f + __expf(-x)); }
#define DPPF(v, ctrl) __int_as_float(__builtin_amdgcn_update_dpp(0, __float_as_int(v), ctrl, 0xf, 0xf, false))
__device__ __forceinline__ float sum16(float v) { v += DPPF(v, 0xB1); v += DPPF(v, 0x4E); v += DPPF(v, 0x141); v += DPPF(v, 0x140); return v; }
__device__ __forceinline__ float max16(float v) { v = fmaxf(v, DPPF(v, 0xB1)); v = fmaxf(v, DPPF(v, 0x4E)); v = fmaxf(v, DPPF(v, 0x141)); v = fmaxf(v, DPPF(v, 0x140)); return v; }
__device__ __forceinline__ float wave_sum(float v) { v = sum16(v); v += __shfl_xor(v, 16); v += __shfl_xor(v, 32); return v; }
__device__ __forceinline__ float wave_max(float v) { v = max16(v); v = fmaxf(v, __shfl_xor(v, 16)); v = fmaxf(v, __shfl_xor(v, 32)); return v; }
#define LDSWAIT() asm volatile("s_waitcnt lgkmcnt(0)" ::: "memory")
#define BAR_LDS() do { asm volatile("s_waitcnt lgkmcnt(0)" ::: "memory"); __builtin_amdgcn_s_barrier(); asm volatile("" ::: "memory"); } while (0)
__device__ __forceinline__ void unpack8(u32x4 w, float (&f)[8]) { f[0] = bflo(w.x); f[1] = bfhi(w.x); f[2] = bflo(w.y); f[3] = bfhi(w.y); f[4] = bflo(w.z); f[5] = bfhi(w.z); f[6] = bflo(w.w); f[7] = bfhi(w.w); }
__device__ __forceinline__ u32x4 pack8(const float (&f)[8]) { u32x4 w; w.x = pk2(f[0], f[1]); w.y = pk2(f[2], f[3]); w.z = pk2(f[4], f[5]); w.w = pk2(f[6], f[7]); return w; }

__device__ __forceinline__ void transpose_w(const float* __restrict__ W, int K, int N, int Npad, bf16* __restrict__ WT, float* scr, int gw, int ngw, int lane) {
    const int nblk = Npad / 64, nitems = (K / 64) * nblk;
    for (int it = gw; it < nitems; it += ngw) {
        const int kb = it / nblk, nb = it % nblk, k0 = 64 * kb, n0 = 64 * nb;
        const int n = n0 + lane;
        float v[64];
#pragma unroll
        for (int kk = 0; kk < 64; ++kk) v[kk] = (n < N) ? W[(size_t)(k0 + kk) * N + n] : 0.f;
#pragma unroll
        for (int kk = 0; kk < 64; ++kk) scr[kk * 65 + lane] = v[kk];
        LDSWAIT();
        const int c = lane & 7;
#pragma unroll
        for (int j = 0; j < 8; ++j) { const int nl = (lane >> 3) + 8 * j; const float* s = scr + (8 * c) * 65 + nl;
            u32x4 o; o.x = pk2(s[0 * 65], s[1 * 65]); o.y = pk2(s[2 * 65], s[3 * 65]); o.z = pk2(s[4 * 65], s[5 * 65]); o.w = pk2(s[6 * 65], s[7 * 65]);
            *(u32x4*)(WT + (size_t)(n0 + nl) * K + k0 + 8 * c) = o; }
        LDSWAIT();
    }
}
__device__ __forceinline__ void norm_row(const f32x4 (&v)[4], const float* g, bf16* hrow, float* yrow, int lane) {
    float s = 0.f;
#pragma unroll
    for (int j = 0; j < 4; ++j) s += (v[j].x * v[j].x + v[j].y * v[j].y) + (v[j].z * v[j].z + v[j].w * v[j].w);
    const float rstd = rsqrtf(wave_sum(s) * (1.f / DM) + EPS);
#pragma unroll
    for (int j = 0; j < 4; ++j) { const f32x4 gg = *(const f32x4*)(g + 4 * lane + 256 * j); const f32x4 o = v[j] * rstd * gg;
        if (hrow) { u32x2 w; w.x = pk2(o.x, o.y); w.y = pk2(o.z, o.w); *(u32x2*)(hrow + 4 * lane + 256 * j) = w; }
        else *(f32x4*)(yrow + 4 * lane + 256 * j) = o; }
}
__device__ __forceinline__ void norm_phase(const float* __restrict__ X, const float* g, bf16* __restrict__ HB, float* __restrict__ Y, int gw, int ngw, int lane) {
    for (int m0 = gw; m0 < MREAL; m0 += 8 * ngw) {
        f32x4 v[8][4];
#pragma unroll
        for (int r = 0; r < 8; ++r) { const int m = m0 + r * ngw; const int mm = m < MREAL ? m : m0;
#pragma unroll
            for (int j = 0; j < 4; ++j) v[r][j] = *(const f32x4*)(X + (size_t)mm * DM + 4 * lane + 256 * j); }
#pragma unroll
        for (int r = 0; r < 8; ++r) { const int m = m0 + r * ngw;
            if (m < MREAL) norm_row(v[r], g, HB ? HB + (size_t)m * DM : nullptr, Y ? Y + (size_t)m * DM : nullptr, lane); }
    }
}

__device__ __forceinline__ void dn_stepA(int tid, int unit, unsigned char* lds, const bf16* PROJ, const float* conv_w, const float* a_log, const float* dt_bias,
                                         bf16* W_, bf16* QE_, bf16* KT_, bf16* AT_, bf16* U_, float* EGL_) {
    asm volatile("" : "+v"(tid));
    const int lane = tid & 63, wave = tid >> 6, m16 = lane & 15, q4 = lane >> 4;
    const int h = unit & 3, c = (unit >> 2) & 127, b = unit >> 9;
    const int t0 = c * 64; const size_t rowb = (size_t)b * SEQ;
    const size_t ch = (size_t)unit;
    bf16* qs = (bf16*)(lds); bf16* ks = (bf16*)(lds + 17408); bf16* kbs = (bf16*)(lds + 34816);
    bf16* vbT = (bf16*)(lds + 52224); bf16* kbgT = (bf16*)(lds + 70656);
    float* Ms = (float*)(lds + 89088); bf16* Tb = (bf16*)(lds + 105728);
    float* Gs = (float*)(lds + 114944); float* Bs = Gs + 64;
    if (wave == 0) {
        const bf16* pr = PROJ + (rowb + t0 + lane) * NPE;
        const float a = bf2f(pr[2048 + h]), bb = bf2f(pr[2052 + h]);
        const float x = a + dt_bias[h];
        const float sp = x > 20.f ? x : __logf(1.f + __expf(x));
        const float g = -__expf(a_log[h]) * sp;
        float G = g;
#pragma unroll
        for (int o = 1; o < 64; o <<= 1) { const float v = __shfl_up(G, o); if (lane >= o) G += v; }
        Gs[lane] = G; Bs[lane] = __builtin_amdgcn_rcpf(1.f + __expf(-bb));
    }
    __syncthreads();
#pragma unroll 1
    for (int bt = 0; bt < 2; ++bt) {
        u32x4 raw[3][4];
#pragma unroll
        for (int ii = 0; ii < 3; ++ii) {
            const int item = (bt * 3 + ii) * 512 + tid, part = item >> 10, t = (item >> 4) & 63, cg = item & 15;
            const int chn = part * 512 + h * 128 + cg * 8;
#pragma unroll
            for (int tap = 0; tap < 4; ++tap) { const int tt = t0 + t - 3 + tap;
                raw[ii][tap] = tt >= 0 ? *(const u32x4*)(PROJ + (rowb + tt) * NPE + chn) : (u32x4){0u, 0u, 0u, 0u}; }
        }
#pragma unroll
        for (int ii = 0; ii < 3; ++ii) {
            const int item = (bt * 3 + ii) * 512 + tid, part = item >> 10, t = (item >> 4) & 63, cg = item & 15;
            const int chn = part * 512 + h * 128 + cg * 8;
            float acc[8];
#pragma unroll
            for (int j = 0; j < 8; ++j) acc[j] = 0.f;
#pragma unroll
            for (int tap = 0; tap < 4; ++tap) {
                float f[8]; unpack8(raw[ii][tap], f);
                const f32x4 c0 = *(const f32x4*)(conv_w + tap * 1536 + chn), c1 = *(const f32x4*)(conv_w + tap * 1536 + chn + 4);
                acc[0] += f[0] * c0.x; acc[1] += f[1] * c0.y; acc[2] += f[2] * c0.z; acc[3] += f[3] * c0.w;
                acc[4] += f[4] * c1.x; acc[5] += f[5] * c1.y; acc[6] += f[6] * c1.z; acc[7] += f[7] * c1.w;
            }
            float ss = 0.f;
#pragma unroll
            for (int j = 0; j < 8; ++j) { acc[j] = siluf(acc[j]); ss += acc[j] * acc[j]; }
            ss = sum16(ss);
            const float rstd = rsqrtf(ss + EPS);
            const float Gt = Gs[t], bt_ = Bs[t];
            if (part == 0) {
                float o[8], oe[8]; const float sc = rstd * 0.08838834764831845f, eg = __expf(Gt);
#pragma unroll
                for (int j = 0; j < 8; ++j) { o[j] = acc[j] * sc; oe[j] = o[j] * eg; }
                *(u32x4*)(qs + t * 136 + cg * 8) = pack8(o);
                *(u32x4*)(QE_ + ch * 8192 + t * 128 + cg * 8) = pack8(oe);
            } else if (part == 1) {
                float o[8], ob[8]; const float eg = __expf(Gt) * bt_;
#pragma unroll
                for (int j = 0; j < 8; ++j) { o[j] = acc[j] * rstd; ob[j] = o[j] * bt_; }
                *(u32x4*)(ks + t * 136 + cg * 8) = pack8(o);
                *(u32x4*)(kbs + t * 136 + cg * 8) = pack8(ob);
#pragma unroll
                for (int j = 0; j < 8; ++j) kbgT[(cg * 8 + j) * 72 + (((t >> 3) ^ (cg & 7)) << 3) + (t & 7)] = (bf16)f2bf(o[j] * eg);
            } else {
#pragma unroll
                for (int j = 0; j < 8; ++j) vbT[(cg * 8 + j) * 72 + (((t >> 3) ^ (cg & 7)) << 3) + (t & 7)] = (bf16)f2bf(acc[j] * bt_);
            }
        }
    }
    __syncthreads();
    {
        const int d = tid >> 2, tg = tid & 3; const float gl = Gs[63];
#pragma unroll
        for (int half = 0; half < 2; ++half) {
            float o[8];
#pragma unroll
            for (int j = 0; j < 8; ++j) { const int t = tg * 16 + half * 8 + j; o[j] = bf2f(ks[t * 136 + d]) * __expf(gl - Gs[t]); }
            *(u32x4*)(KT_ + ch * 8192 + d * 64 + tg * 16 + half * 8) = pack8(o);
        }
        if (tid == 0) EGL_[ch] = __expf(gl);
    }
    {
        const int which = wave >> 2, mt = wave & 3;
        const bf16* As = which ? kbs : qs;
        bf16x8 aF[4];
#pragma unroll
        for (int k4 = 0; k4 < 4; ++k4) aF[k4] = *(const bf16x8*)(As + (mt * 16 + m16) * 136 + k4 * 32 + q4 * 8);
#pragma unroll
        for (int nt = 0; nt < 4; ++nt) {
            f32x4 acc = {0.f, 0.f, 0.f, 0.f};
            if (nt <= mt) {
#pragma unroll
                for (int k4 = 0; k4 < 4; ++k4) { const bf16x8 bF = *(const bf16x8*)(ks + (nt * 16 + m16) * 136 + k4 * 32 + q4 * 8); acc = mfma16(aF[k4], bF, acc); }
            }
            const int s = nt * 16 + m16; const float Gsv = Gs[s];
#pragma unroll
            for (int i = 0; i < 4; ++i) {
                const int t = mt * 16 + q4 * 4 + i;
                const bool on = which ? (t > s) : (t >= s);
                const float v = on ? acc[i] * __expf(Gs[t] - Gsv) : 0.f;
                if (which) Ms[t * 65 + s] = v; else AT_[ch * 4096 + t * 64 + s] = (bf16)f2bf(v);
            }
        }
    }
    __syncthreads();
    {
        float* Ts = (float*)(lds + 115456);
        if (wave == 0) {
            const int blk = lane >> 4, cc = lane & 15; const float* Mb = Ms + (blk * 16) * 65 + blk * 16;
            float tc[16];
#pragma unroll
            for (int r = 0; r < 16; ++r) {
                float acc = (r == cc) ? 1.f : 0.f;
#pragma unroll
                for (int j = 0; j < r; ++j) acc -= Mb[r * 65 + j] * tc[j];
                tc[r] = acc;
            }
#pragma unroll
            for (int r = 0; r < 16; ++r) Ts[(blk * 16 + r) * 65 + blk * 16 + cc] = tc[r];
        }
        __syncthreads();
#pragma unroll 1
        for (int dd = 1; dd < 4; ++dd) {
            if (wave < 4 - dd) {
                const int j = wave, i = wave + dd;
                f32x4 acc = {0.f, 0.f, 0.f, 0.f};
                for (int k = j; k < i; ++k) {
                    const float* A = Ms + (i * 16) * 65 + k * 16; const float* B = Ts + (k * 16) * 65 + j * 16;
#pragma unroll
                    for (int kk = 0; kk < 4; ++kk) acc = __builtin_amdgcn_mfma_f32_16x16x4f32(A[m16 * 65 + kk * 4 + q4], B[(kk * 4 + q4) * 65 + m16], acc, 0, 0, 0);
                }
                float* Tmp = Ts + (j * 16) * 65 + i * 16;
#pragma unroll
                for (int r = 0; r < 4; ++r) Tmp[(q4 * 4 + r) * 65 + m16] = acc[r];
                LDSWAIT();
                f32x4 acc2 = {0.f, 0.f, 0.f, 0.f};
                { const float* A = Ts + (i * 16) * 65 + i * 16;
#pragma unroll
                  for (int kk = 0; kk < 4; ++kk) acc2 = __builtin_amdgcn_mfma_f32_16x16x4f32(A[m16 * 65 + kk * 4 + q4], Tmp[(kk * 4 + q4) * 65 + m16], acc2, 0, 0, 0); }
                float* Out = Ts + (i * 16) * 65 + j * 16;
#pragma unroll
                for (int r = 0; r < 4; ++r) Out[(q4 * 4 + r) * 65 + m16] = -acc2[r];
            }
            __syncthreads();
        }
        const int t = tid >> 3, s8 = (tid & 7) * 8; float o[8];
#pragma unroll
        for (int j = 0; j < 8; ++j) o[j] = (s8 + j <= t) ? Ts[t * 65 + s8 + j] : 0.f;
        *(u32x4*)(Tb + t * 72 + s8) = pack8(o);
    }
    __syncthreads();
    {
        const bf16* BT = wave < 4 ? vbT : kbgT; bf16* OUT = wave < 4 ? U_ : W_;
        bf16x8 bF[2][2];
#pragma unroll
        for (int n2 = 0; n2 < 2; ++n2)
#pragma unroll
            for (int k2 = 0; k2 < 2; ++k2) { const int rr = ((wave & 3) * 2 + n2) * 16 + m16; bF[n2][k2] = *(const bf16x8*)(BT + rr * 72 + (((k2 * 4 + q4) ^ ((rr >> 3) & 7)) << 3)); }
#pragma unroll
        for (int mt = 0; mt < 4; ++mt) {
            bf16x8 aF[2];
#pragma unroll
            for (int k2 = 0; k2 < 2; ++k2) aF[k2] = *(const bf16x8*)(Tb + (mt * 16 + m16) * 72 + k2 * 32 + q4 * 8);
#pragma unroll
            for (int n2 = 0; n2 < 2; ++n2) {
                f32x4 acc = {0.f, 0.f, 0.f, 0.f};
                u32x2 w;
                if (wave < 4) {
                    acc = mfma16(aF[0], bF[n2][0], acc); acc = mfma16(aF[1], bF[n2][1], acc);
                    w.x = pk2(acc[0], acc[1]); w.y = pk2(acc[2], acc[3]);
                    *(u32x2*)(OUT + ch * 8192 + (((wave & 3) * 2 + n2) * 16 + m16) * 64 + mt * 16 + q4 * 4) = w;
                } else {
                    acc = mfma16(bF[n2][0], aF[0], acc); acc = mfma16(bF[n2][1], aF[1], acc);
                    w.x = pk2(acc[0], acc[1]); w.y = pk2(acc[2], acc[3]);
                    *(u32x2*)(OUT + ch * 8192 + (mt * 16 + m16) * 128 + ((wave & 3) * 2 + n2) * 16 + q4 * 4) = w;
                }
            }
        }
    }
    __syncthreads();
}

__device__ __forceinline__ void dn_stepB(int tid, int item, unsigned char* lds, const bf16* W_, const bf16* KT_, const bf16* U_, const float* EGL_,
                                         bf16* SC_, bf16* VN_, float* state_out) {
    asm volatile("" : "+v"(tid));
    const int lane = tid & 63, wave = tid >> 6, m16 = lane & 15, q4 = lane >> 4;
    const int bh = item & 7, sl = item >> 3, b = bh >> 2, h = bh & 3, e0 = sl * 16;
    bf16* Sb = (bf16*)lds;
    bf16* Vn = (bf16*)(lds + 16 * 136 * 2);
    for (int i = tid; i < 16 * 136 / 2; i += 512) ((unsigned*)Sb)[i] = 0u;
    f32x4 accS = {0.f, 0.f, 0.f, 0.f};
    __syncthreads();
    const bool lo = wave < 4;
    int vz = 0; asm volatile("" : "+v"(vz));
    const bf16* xbase = W_ + ((wave & 3) * 16 + m16) * 128 + q4 * 8;
    const bf16* ubase = U_ + (e0 + m16) * 64 + (wave & 3) * 16 + q4 * 4;
    const bf16* kbase = KT_ + (wave * 16 + m16) * 64 + q4 * 8;
    bf16* scbase = SC_ + (e0 + m16) * 128 + wave * 16 + q4 * 4;
    bf16* vnbase = VN_ + (e0 + m16) * 64 + (wave & 3) * 16 + q4 * 4;
#define DNB_LOAD(cc, xA_, kA_, uC_, egl_) do { const int c_ = (cc) < 128 ? (cc) : 127; const size_t ch_ = (size_t)b * 512 + c_ * 4 + h; \
        if (lo) { _Pragma("unroll") for (int k4 = 0; k4 < 4; ++k4) xA_[k4] = *(const bf16x8*)(xbase + ch_ * 8192 + k4 * 32); uC_ = *(const u32x2*)(ubase + ch_ * 8192); } \
        kA_[0] = *(const bf16x8*)(kbase + ch_ * 8192); kA_[1] = *(const bf16x8*)(kbase + ch_ * 8192 + 32); \
        egl_ = EGL_[ch_ + vz]; } while (0)
#define DNB_STEP(cc, xA_, kA_, uC_, egl_) do { const size_t chs_ = (size_t)b * 512 + (cc) * 4 + h; \
        { u32x2 w; w.x = pk2(accS[0], accS[1]); w.y = pk2(accS[2], accS[3]); *(u32x2*)(scbase + chs_ * 16384) = w; }     \
        if (lo) { f32x4 accX = {0.f, 0.f, 0.f, 0.f}; \
            _Pragma("unroll") for (int k4 = 0; k4 < 4; ++k4) { const bf16x8 sB = *(const bf16x8*)(Sb + m16 * 136 + k4 * 32 + q4 * 8); accX = mfma16(xA_[k4], sB, accX); } \
            u32x2 w; w.x = pk2(bflo(uC_.x) - accX[0], bfhi(uC_.x) - accX[1]); w.y = pk2(bflo(uC_.y) - accX[2], bfhi(uC_.y) - accX[3]); \
            *(u32x2*)(Vn + m16 * 72 + wave * 16 + q4 * 4) = w; *(u32x2*)(vnbase + chs_ * 8192) = w; } \
        BAR_LDS(); \
        const bf16x8 vB0 = *(const bf16x8*)(Vn + m16 * 72 + q4 * 8), vB1 = *(const bf16x8*)(Vn + m16 * 72 + 32 + q4 * 8); \
        accS = accS * egl_; \
        accS = mfma16(kA_[0], vB0, accS); accS = mfma16(kA_[1], vB1, accS); \
        { u32x2 w; w.x = pk2(accS[0], accS[1]); w.y = pk2(accS[2], accS[3]); *(u32x2*)(Sb + m16 * 136 + wave * 16 + q4 * 4) = w; } \
        BAR_LDS(); } while (0)
    bf16x8 xA[4], kA[2]; u32x2 uA; float eglA;
    bf16x8 xB[4], kB[2]; u32x2 uB; float eglB;
    bf16x8 xC[4], kC[2]; u32x2 uC; float eglC;
    bf16x8 xD[4], kD[2]; u32x2 uD; float eglD;
    uA = uB = uC = uD = (u32x2){0u, 0u};
#pragma unroll
    for (int k4 = 0; k4 < 4; ++k4) xA[k4] = xB[k4] = xC[k4] = xD[k4] = (bf16x8){0, 0, 0, 0, 0, 0, 0, 0};
    DNB_LOAD(0, xA, kA, uA, eglA); DNB_LOAD(1, xB, kB, uB, eglB); DNB_LOAD(2, xC, kC, uC, eglC);
#pragma unroll 1
    for (int c = 0; c < 128; c += 4) {
        DNB_LOAD(c + 3, xD, kD, uD, eglD);
        DNB_STEP(c, xA, kA, uA, eglA);
        DNB_LOAD(c + 4, xA, kA, uA, eglA);
        DNB_STEP(c + 1, xB, kB, uB, eglB);
        DNB_LOAD(c + 5, xB, kB, uB, eglB);
        DNB_STEP(c + 2, xC, kC, uC, eglC);
        DNB_LOAD(c + 6, xC, kC, uC, eglC);
        DNB_STEP(c + 3, xD, kD, uD, eglD);
    }
#undef DNB_LOAD
#undef DNB_STEP
    {
        float* sp = state_out + ((size_t)(b * 4 + h) * 128 + wave * 16 + q4 * 4) * 128 + e0 + m16;
#pragma unroll
        for (int i = 0; i < 4; ++i) sp[i * 128] = accS[i];
    }
    __syncthreads();
}

__device__ __forceinline__ void dn_stepC(int tid, int unit, unsigned char* lds, const bf16* __restrict__ PROJ, const bf16* __restrict__ QE_, const bf16* __restrict__ AT_, const bf16* __restrict__ SC_, const bf16* __restrict__ VN_,
                                         const float* dn_norm, bf16* __restrict__ MIX) {
    asm volatile("" : "+v"(tid));
    const int lane = tid & 63, wave = tid >> 6, m16 = lane & 15, q4 = lane >> 4;
    const int h = unit & 3, c = (unit >> 2) & 127, b = unit >> 9;
    const size_t row0 = (size_t)b * SEQ + c * 64; const size_t ch = (size_t)unit;
    float* red = (float*)lds;
    bf16x8 scF[4], vnF[2], qeF[4][4], atF[4][2]; u32x2 zg[4];
#pragma unroll
    for (int k4 = 0; k4 < 4; ++k4) scF[k4] = *(const bf16x8*)(SC_ + ch * 16384 + (wave * 16 + m16) * 128 + k4 * 32 + q4 * 8);
#pragma unroll
    for (int k2 = 0; k2 < 2; ++k2) vnF[k2] = *(const bf16x8*)(VN_ + ch * 8192 + (wave * 16 + m16) * 64 + k2 * 32 + q4 * 8);
#pragma unroll
    for (int mt = 0; mt < 4; ++mt) {
#pragma unroll
        for (int k4 = 0; k4 < 4; ++k4) qeF[mt][k4] = *(const bf16x8*)(QE_ + ch * 8192 + (mt * 16 + m16) * 128 + k4 * 32 + q4 * 8);
#pragma unroll
        for (int k2 = 0; k2 < 2; ++k2) atF[mt][k2] = *(const bf16x8*)(AT_ + ch * 4096 + (mt * 16 + m16) * 64 + k2 * 32 + q4 * 8);
        zg[mt] = *(const u32x2*)(PROJ + (row0 + mt * 16 + m16) * NPE + 1536 + h * 128 + wave * 16 + q4 * 4);
    }
    f32x4 acc[4];
#pragma unroll
    for (int mt = 0; mt < 4; ++mt) {
        f32x4 a = {0.f, 0.f, 0.f, 0.f};
#pragma unroll
        for (int k4 = 0; k4 < 4; ++k4) a = mfma16(scF[k4], qeF[mt][k4], a);
#pragma unroll
        for (int k2 = 0; k2 < 2; ++k2) a = mfma16(vnF[k2], atF[mt][k2], a);
        acc[mt] = a;
        float ss = (a[0] * a[0] + a[1] * a[1]) + (a[2] * a[2] + a[3] * a[3]);
        ss += __shfl_xor(ss, 16); ss += __shfl_xor(ss, 32);
        if (q4 == 0) red[wave * 64 + mt * 16 + m16] = ss;
    }
    __syncthreads();
    const f32x4 gn = *(const f32x4*)(dn_norm + wave * 16 + q4 * 4);
#pragma unroll
    for (int mt = 0; mt < 4; ++mt) {
        const int t = mt * 16 + m16; float tot = 0.f;
#pragma unroll
        for (int w = 0; w < 8; ++w) tot += red[w * 64 + t];
        const float rstd = rsqrtf(tot * (1.f / 128.f) + EPS);
        const f32x4 a = acc[mt]; const u32x2 z = zg[mt];
        u32x2 w; w.x = pk2(a[0] * rstd * gn[0] * siluf(bflo(z.x)), a[1] * rstd * gn[1] * siluf(bfhi(z.x)));
        w.y = pk2(a[2] * rstd * gn[2] * siluf(bflo(z.y)), a[3] * rstd * gn[3] * siluf(bfhi(z.y)));
        *(u32x2*)(MIX + (row0 + t) * DM + h * 128 + wave * 16 + q4 * 4) = w;
    }
    __syncthreads();
}

__device__ __forceinline__ void swa_prompt(int tid, int unit, unsigned char* lds, const bf16* PROJ, const float* sinks, bf16* MIX) {
    asm volatile("" : "+v"(tid));
    const int lane = tid & 63, wave = tid >> 6, m16 = lane & 15, q4 = lane >> 4;
    const int qb = unit & 63, kvh = (unit >> 6) & 1, b = unit >> 7;
    const int p0 = qb * 128; const size_t rowb = (size_t)b * SEQ;
    bf16* Ks = (bf16*)lds;
    bf16* VsT = (bf16*)(lds + 39168);
    bf16* Pw = (bf16*)(lds + 75008 + wave * 5376);
    for (int i = 0; i < 4; ++i) {
        const int item = i * 512 + tid, key = item >> 3, dg = item & 7; const int pos = p0 - 128 + key;
        u32x4 kw = {0u, 0u, 0u, 0u}, vw = {0u, 0u, 0u, 0u};
        if (pos >= 0) { const bf16* pr = PROJ + (rowb + pos) * NPE + kvh * 64 + dg * 8; kw = *(const u32x4*)(pr + 2568); vw = *(const u32x4*)(pr + 2696); }
        *(u32x4*)(Ks + key * 72 + dg * 8) = kw;
        VsT[(dg * 8 + 0) * 280 + key] = (bf16)(vw.x & 0xffff); VsT[(dg * 8 + 1) * 280 + key] = (bf16)(vw.x >> 16);
        VsT[(dg * 8 + 2) * 280 + key] = (bf16)(vw.y & 0xffff); VsT[(dg * 8 + 3) * 280 + key] = (bf16)(vw.y >> 16);
        VsT[(dg * 8 + 4) * 280 + key] = (bf16)(vw.z & 0xffff); VsT[(dg * 8 + 5) * 280 + key] = (bf16)(vw.z >> 16);
        VsT[(dg * 8 + 6) * 280 + key] = (bf16)(vw.w & 0xffff); VsT[(dg * 8 + 7) * 280 + key] = (bf16)(vw.w >> 16);
    }
    { unsigned zz = 0u; asm volatile("" : "+v"(zz));
      if (tid < 128) { const int key = 256 + (tid >> 3), dg = tid & 7; *(u32x4*)(Ks + key * 72 + dg * 8) = (u32x4){zz, zz, zz, zz}; } }
    for (int i = tid; i < 64 * 24; i += 512) { const int d = i / 24, kk = 256 + i % 24; VsT[d * 280 + kk] = 0; }
    __syncthreads();
    const int g = wave >> 1, half = wave & 1, head = kvh * 4 + g;
    const float slope = exp2f(-(float)(head + 1)), sink = sinks[head];
#pragma unroll 1
    for (int mt4 = 0; mt4 < 4; ++mt4) {
        const int q0 = half * 64 + mt4 * 16;
        const bf16* qp = PROJ + (rowb + p0 + q0 + m16) * NPE + 2056 + head * 64 + q4 * 8;
        const bf16x8 qA0 = *(const bf16x8*)(qp), qA1 = *(const bf16x8*)(qp + 32);
        float sc[10][4];
#pragma unroll
        for (int kt = 0; kt < 10; ++kt) {
            const int j0 = q0 + kt * 16;
            const bf16x8 kB0 = *(const bf16x8*)(Ks + (j0 + m16) * 72 + q4 * 8), kB1 = *(const bf16x8*)(Ks + (j0 + m16) * 72 + 32 + q4 * 8);
            f32x4 acc = {0.f, 0.f, 0.f, 0.f};
            acc = mfma16(qA0, kB0, acc); acc = mfma16(qA1, kB1, acc);
            const int j = j0 + m16; const int pos = p0 - 128 + j;
#pragma unroll
            for (int i = 0; i < 4; ++i) { const int rel = q0 + q4 * 4 + i + 128 - j; const bool valid = rel >= 0 && rel < 128 && pos >= 0;
                sc[kt][i] = valid ? acc[i] * 0.125f - slope * (float)rel : -1e30f; }
        }
        float inv[4], mx[4];
#pragma unroll
        for (int i = 0; i < 4; ++i) {
            float m = sc[0][i];
#pragma unroll
            for (int kt = 1; kt < 10; ++kt) m = fmaxf(m, sc[kt][i]);
            m = fmaxf(max16(m), sink); mx[i] = m;
            float s = 0.f;
#pragma unroll
            for (int kt = 0; kt < 10; ++kt) { sc[kt][i] = __expf(sc[kt][i] - m); s += sc[kt][i]; }
            s = sum16(s) + __expf(sink - m);
            inv[i] = __builtin_amdgcn_rcpf(s);
        }
#pragma unroll
        for (int kt = 0; kt < 10; ++kt)
#pragma unroll
            for (int i = 0; i < 4; ++i) Pw[(q4 * 4 + i) * 168 + kt * 16 + m16] = (bf16)f2bf(sc[kt][i] * inv[i]);
        LDSWAIT();
        bf16x8 pA[5];
#pragma unroll
        for (int k5 = 0; k5 < 5; ++k5) pA[k5] = *(const bf16x8*)(Pw + m16 * 168 + k5 * 32 + q4 * 8);
#pragma unroll
        for (int nt = 0; nt < 4; ++nt) {
            f32x4 acc = {0.f, 0.f, 0.f, 0.f};
#pragma unroll
            for (int k5 = 0; k5 < 5; ++k5) { const bf16x8 vB = *(const bf16x8*)(VsT + (nt * 16 + m16) * 280 + q0 + k5 * 32 + q4 * 8); acc = mfma16(vB, pA[k5], acc); }
            u32x2 w; w.x = pk2(acc[0], acc[1]); w.y = pk2(acc[2], acc[3]);
            *(u32x2*)(MIX + (rowb + p0 + q0 + m16) * DM + 512 + head * 64 + nt * 16 + q4 * 4) = w;
        }
        LDSWAIT();
    }
    __syncthreads();
}

__device__ __forceinline__ void sample_even(int tid, int s, int el, unsigned char* lds, const bf16* PROJ, const float* state_dn, const float* state_conv, const float* cache_k, const float* cache_v,
                                            const float* conv_w, const float* a_log, const float* dt_bias, const float* dn_norm, const float* sinks, bf16* MIX, float* out) {
    asm volatile("" : "+v"(tid));
    const int lane = tid & 63, wave = tid >> 6;
    const size_t row = (size_t)MPR + s; const bf16* pr = PROJ + row * NPE;
    float* cv = (float*)lds;
    float* gsm = cv + 1536;
    float* red = gsm + 16;
    float* qsw = red + 16;
    float* knew = qsw + 512;
    float* vnew = knew + 128;
    float* scs = vnew + 128;
    {
        const float* cb = state_conv + ((size_t)el * MSA + s) * 3 * 1536;
        float* ob = out + O_SCONV + ((size_t)el * MSA + s) * 3 * 1536;
#pragma unroll
        for (int r = 0; r < 3; ++r) {
            const int chn = tid + r * 512;
            const float x3 = bf2f(pr[chn]), b0 = cb[chn], b1 = cb[1536 + chn], b2 = cb[3072 + chn];
            const float v = b0 * conv_w[chn] + b1 * conv_w[1536 + chn] + b2 * conv_w[3072 + chn] + x3 * conv_w[4608 + chn];
            cv[chn] = siluf(v);
            ob[chn] = b1; ob[1536 + chn] = b2; ob[3072 + chn] = x3;
        }
        qsw[tid] = bf2f(pr[2056 + tid]);
        if (tid < 128) { knew[tid] = bf2f(pr[2568 + tid]); vnew[tid] = bf2f(pr[2696 + tid]); }
        if (tid < 4) {
            const float a = bf2f(pr[2048 + tid]), bb = bf2f(pr[2052 + tid]);
            const float x = a + dt_bias[tid]; const float sp = x > 20.f ? x : __logf(1.f + __expf(x));
            gsm[tid] = __expf(-__expf(a_log[tid]) * sp); gsm[4 + tid] = __builtin_amdgcn_rcpf(1.f + __expf(-bb));
        }
    }
    __syncthreads();
    {
        const float a = cv[wave * 128 + lane], bq = cv[wave * 128 + 64 + lane];
        const float ss = wave_sum(a * a + bq * bq);
        const float sc = rsqrtf(ss + EPS) * (wave < 4 ? 0.08838834764831845f : 1.f);
        cv[wave * 128 + lane] = a * sc; cv[wave * 128 + 64 + lane] = bq * sc;
    }
    __syncthreads();
    if (wave < 4) { const float v = cv[wave * 128 + lane] * cv[512 + wave * 128 + lane] + cv[wave * 128 + 64 + lane] * cv[512 + wave * 128 + 64 + lane]; const float t_ = wave_sum(v); if (lane == 0) gsm[8 + wave] = t_; }
    __syncthreads();
#pragma unroll 1
    for (int p = 0; p < 2; ++p) {
        const int hl = tid >> 8, h = p * 2 + hl, dg = (tid >> 5) & 7, e4 = (tid & 31) * 4;
        const float* __restrict__ S = state_dn + (((size_t)el * MSA + s) * 4 + h) * 16384 + (size_t)(dg * 16) * 128 + e4;
        float* __restrict__ So = out + O_SDN + (((size_t)el * MSA + s) * 4 + h) * 16384 + (size_t)(dg * 16) * 128 + e4;
        const float* qh = cv + h * 128 + dg * 16; const float* kh = cv + 512 + h * 128 + dg * 16;
        float* part = vnew + 128 + 1024;
        f32x4 sv[16];
#pragma unroll
        for (int d = 0; d < 16; ++d) sv[d] = *(const f32x4*)(S + d * 128);
        f32x4 r = {0.f, 0.f, 0.f, 0.f}, qS = {0.f, 0.f, 0.f, 0.f};
#pragma unroll
        for (int d = 0; d < 16; ++d) { r += sv[d] * kh[d]; qS += sv[d] * qh[d]; }
        *(f32x4*)(part + ((hl * 8 + dg) * 128 + e4) * 2) = r; *(f32x4*)(part + ((hl * 8 + dg) * 128 + e4) * 2 + 4) = qS;
        __syncthreads();
        f32x4 rt = {0.f, 0.f, 0.f, 0.f}, qt = {0.f, 0.f, 0.f, 0.f};
#pragma unroll
        for (int g2 = 0; g2 < 8; ++g2) { rt += *(const f32x4*)(part + ((hl * 8 + g2) * 128 + e4) * 2); qt += *(const f32x4*)(part + ((hl * 8 + g2) * 128 + e4) * 2 + 4); }
        const float eg = gsm[h], beta = gsm[4 + h], qk = gsm[8 + h];
        const f32x4 vv4 = *(const f32x4*)(cv + 1024 + h * 128 + e4);
        const f32x4 vn = (vv4 - rt * eg) * beta;
        const f32x4 o = qt * eg + vn * qk;
#pragma unroll
        for (int d = 0; d < 16; ++d) *(f32x4*)(So + d * 128) = sv[d] * eg + vn * kh[d];
        float ss = (o.x * o.x + o.y * o.y) + (o.z * o.z + o.w * o.w);
        ss += __shfl_xor(ss, 1); ss += __shfl_xor(ss, 2); ss += __shfl_xor(ss, 4); ss += __shfl_xor(ss, 8); ss += __shfl_xor(ss, 16);
        const float rstd = rsqrtf(ss * (1.f / 128.f) + EPS);
        if (dg == 0) {
            const u32x2 zw = *(const u32x2*)(pr + 1536 + h * 128 + e4);
            const f32x4 nn = *(const f32x4*)(dn_norm + e4);
            u32x2 w; w.x = pk2(o.x * rstd * nn.x * siluf(bflo(zw.x)), o.y * rstd * nn.y * siluf(bfhi(zw.x)));
            w.y = pk2(o.z * rstd * nn.z * siluf(bflo(zw.y)), o.w * rstd * nn.w * siluf(bfhi(zw.y)));
            *(u32x2*)(MIX + row * DM + h * 128 + e4) = w;
        }
        __syncthreads();
    }
    {
        const float* ck = cache_k + ((size_t)el * MSA + s) * 16384; const float* cvv = cache_v + ((size_t)el * MSA + s) * 16384;
        const int head = tid >> 6, jj = tid & 63, kvh = head >> 2;
        const float slope = exp2f(-(float)(head + 1)); const float c125 = opq(0.125f);
#pragma unroll
        for (int r = 0; r < 2; ++r) {
            const int ci = jj + r * 64;
            float dot = 0.f;
            if (ci < 127) { const float* kp = ck + (ci + 1) * 128 + kvh * 64;
#pragma unroll
                for (int d4 = 0; d4 < 16; ++d4) { const f32x4 kv = *(const f32x4*)(kp + d4 * 4); const float* q = qsw + head * 64 + d4 * 4; dot += kv.x * q[0] + kv.y * q[1] + kv.z * q[2] + kv.w * q[3]; }
            } else {
#pragma unroll
                for (int d = 0; d < 64; ++d) dot += knew[kvh * 64 + d] * qsw[head * 64 + d];
            }
            scs[head * 128 + ci] = dot * c125 - slope * (float)(127 - ci);
        }
        __syncthreads();
        {
            const float sink = sinks[wave];
            const float v0 = scs[wave * 128 + lane], v1 = scs[wave * 128 + 64 + lane];
            const float m = fmaxf(wave_max(fmaxf(v0, v1)), sink);
            const float p0 = __expf(v0 - m), p1 = __expf(v1 - m);
            const float den = wave_sum(p0 + p1) + __expf(sink - m);
            scs[wave * 128 + lane] = p0 / den; scs[wave * 128 + 64 + lane] = p1 / den;
        }
        __syncthreads();
        {
            const int d = tid & 63; float o = 0.f;
#pragma unroll 8
            for (int ci = 0; ci < 127; ++ci) o += scs[head * 128 + ci] * cvv[(ci + 1) * 128 + kvh * 64 + d];
            o += scs[head * 128 + 127] * vnew[kvh * 64 + d];
            MIX[row * DM + 512 + head * 64 + d] = (bf16)f2bf(o);
        }
        float* __restrict__ ok = out + O_SK + ((size_t)el * MSA + s) * 16384; float* __restrict__ ov = out + O_SV + ((size_t)el * MSA + s) * 16384;
        f32x4 ck4[8], cv4[8];
#pragma unroll
        for (int i = 0; i < 8; ++i) { const int i4 = (i * 512 + tid) * 4; const bool past = i4 < 127 * 128;
            ck4[i] = past ? *(const f32x4*)(ck + i4 + 128) : *(const f32x4*)(knew + (i4 & 127));
            cv4[i] = past ? *(const f32x4*)(cvv + i4 + 128) : *(const f32x4*)(vnew + (i4 & 127)); }
#pragma unroll
        for (int i = 0; i < 8; ++i) { const int i4 = (i * 512 + tid) * 4; *(f32x4*)(ok + i4) = ck4[i]; *(f32x4*)(ov + i4) = cv4[i]; }
    }
    __syncthreads();
}
__device__ __forceinline__ void prompt_misc(int tid, int u, int el, const bf16* PROJ, float* out) {
    asm volatile("" : "+v"(tid));
    const int b = u & 1, which = u >> 1;
    float* o = out + (which ? O_PV : O_PK) + ((size_t)el * 2 + b) * 16384;
    for (int i = tid; i < 16384; i += 512) { const int j = i >> 7, rem = i & 127; o[i] = bf2f(PROJ[((size_t)b * SEQ + 8064 + j) * NPE + (which ? 2696 : 2568) + rem]); }
    if (which == 0) { float* oc = out + O_PCONV + ((size_t)el * 2 + b) * 4608;
        for (int i = tid; i < 4608; i += 512) { const int r = i / 1536, chn = i % 1536; oc[i] = bf2f(PROJ[((size_t)b * SEQ + 8189 + r) * NPE + chn]); } }
}

__device__ __forceinline__ void sample_odd(int tid, int s, int ol, unsigned char* lds, const bf16* PROJ, const float* state_gla, const float* Wg, const float* bg, const float* gla_norm, bf16* MIX, float* out) {
    asm volatile("" : "+v"(tid));
    const int lane = tid & 63, wave = tid >> 6;
    const size_t row = (size_t)MPR + s; const bf16* pr = PROJ + row * NPO;
    float* qv = (float*)lds; float* kv = qv + 512; float* egs = kv + 512; float* vv = egs + 512; float* red = vv + 1024;
    {
        float x = bg[tid];
#pragma unroll
        for (int j = 0; j < 16; ++j) x += bf2f(pr[3072 + j]) * Wg[j * 512 + tid];
        const float ls = fminf(x, 0.f) - __logf(1.f + __expf(-fabsf(x)));
        egs[tid] = __expf(ls * (1.f / 16.f));
        qv[tid] = bf2f(pr[tid]) * 0.08838834764831845f; kv[tid] = bf2f(pr[512 + tid]);
        vv[tid] = bf2f(pr[1024 + tid]); vv[tid + 512] = bf2f(pr[1536 + tid]);
    }
    __syncthreads();
    {
        const int h = tid >> 7, dg = (tid >> 6) & 1, e4 = (tid & 63) * 4;
        const float* __restrict__ S = state_gla + (((size_t)ol * MSA + s) * 4 + h) * 32768 + (size_t)(dg * 64) * 256 + e4;
        float* __restrict__ So = out + O_SGLA + (((size_t)ol * MSA + s) * 4 + h) * 32768 + (size_t)(dg * 64) * 256 + e4;
        const f32x4 v4 = *(const f32x4*)(vv + h * 256 + e4);
        const float* kd = kv + h * 128 + dg * 64; const float* ed = egs + h * 128 + dg * 64; const float* qd = qv + h * 128 + dg * 64;
        float* part = red + 16;
        f32x4 o = {0.f, 0.f, 0.f, 0.f};
#pragma unroll 1
        for (int d0 = 0; d0 < 64; d0 += 16) {
            f32x4 sv[16];
#pragma unroll
            for (int d = 0; d < 16; ++d) sv[d] = *(const f32x4*)(S + (d0 + d) * 256);
#pragma unroll
            for (int d = 0; d < 16; ++d) { const f32x4 n = sv[d] * ed[d0 + d] + v4 * kd[d0 + d]; *(f32x4*)(So + (d0 + d) * 256) = n; o += n * qd[d0 + d]; }
        }
        *(f32x4*)(part + (h * 2 + dg) * 256 + e4) = o;
        __syncthreads();
        const f32x4 ot = *(const f32x4*)(part + (h * 2) * 256 + e4) + *(const f32x4*)(part + (h * 2 + 1) * 256 + e4);
        const float ss = wave_sum((ot.x * ot.x + ot.y * ot.y) + (ot.z * ot.z + ot.w * ot.w));
        const float rstd = rsqrtf(ss * (1.f / 256.f) + EPS);
        if (dg == 0) {
            const u32x2 rw = *(const u32x2*)(pr + 2048 + h * 256 + e4);
            const f32x4 nn = *(const f32x4*)(gla_norm + e4);
            u32x2 w; w.x = pk2(ot.x * rstd * nn.x * siluf(bflo(rw.x)), ot.y * rstd * nn.y * siluf(bfhi(rw.x)));
            w.y = pk2(ot.z * rstd * nn.z * siluf(bflo(rw.y)), ot.w * rstd * nn.w * siluf(bfhi(rw.y)));
            *(u32x2*)(MIX + row * DM + h * 256 + e4) = w;
        }
    }
    __syncthreads();
}

__device__ __forceinline__ void gla_stepA(int tid, int unit, unsigned char* lds, const bf16* PROJ, const float* Wg, const float* bg, bf16* US_, bf16* QT_, bf16* OI, float* EGL_) {
    asm volatile("" : "+v"(tid));
    const int lane = tid & 63, wave = tid >> 6, m16 = lane & 15, q4 = lane >> 4;
    const int h = unit & 3, c = (unit >> 2) & 127, b = unit >> 9;
    const size_t row0 = (size_t)b * SEQ + c * 64; const size_t ch = (size_t)unit;
    float* Gs = (float*)lds;
    bf16* qs = (bf16*)(lds + 32768); bf16* ks = (bf16*)(lds + 50176);
    bf16* kT = (bf16*)(lds + 67584);
    bf16* vT = (bf16*)(lds + 86016);
    bf16* as = (bf16*)(lds + 122880);
    float* qt = (float*)(lds + 132096);
    float* gdl = (float*)(lds + 134144);
    u32x4 rq[4], rv[4];
    float wg[16];
    const unsigned short gd0 = PROJ[(row0 + (tid >> 4)) * NPO + 3072 + (tid & 15)], gd1 = PROJ[(row0 + 32 + (tid >> 4)) * NPO + 3072 + (tid & 15)];
#pragma unroll
    for (int j = 0; j < 16; ++j) wg[j] = Wg[j * 512 + h * 128 + (tid & 127)];
#pragma unroll
    for (int i = 0; i < 4; ++i) {
        const int item = i * 512 + tid, part = item >> 10, t = (item >> 4) & 63, cg = item & 15;
        rq[i] = *(const u32x4*)(PROJ + (row0 + t) * NPO + part * 512 + h * 128 + cg * 8);
        const int t2 = item >> 5, eg8 = item & 31;
        rv[i] = *(const u32x4*)(PROJ + (row0 + t2) * NPO + 1024 + h * 256 + eg8 * 8);
    }
    gdl[tid] = bf2f(gd0); gdl[tid + 512] = bf2f(gd1);
    __syncthreads();
    {
        const int d = tid & 127, tq = tid >> 7, col = h * 128 + d;
        const float bgc = bg[col]; float run = 0.f;
        float cum[16];
#pragma unroll
        for (int tt = 0; tt < 16; ++tt) {
            const int t = tq * 16 + tt; float x = bgc;
            const f32x4 gq0 = *(const f32x4*)(gdl + t * 16), gq1 = *(const f32x4*)(gdl + t * 16 + 4), gq2 = *(const f32x4*)(gdl + t * 16 + 8), gq3 = *(const f32x4*)(gdl + t * 16 + 12);
            x += gq0.x * wg[0] + gq0.y * wg[1] + gq0.z * wg[2] + gq0.w * wg[3];
            x += gq1.x * wg[4] + gq1.y * wg[5] + gq1.z * wg[6] + gq1.w * wg[7];
            x += gq2.x * wg[8] + gq2.y * wg[9] + gq2.z * wg[10] + gq2.w * wg[11];
            x += gq3.x * wg[12] + gq3.y * wg[13] + gq3.z * wg[14] + gq3.w * wg[15];
            const float ls = fminf(x, 0.f) - __logf(1.f + __expf(-fabsf(x)));
            run += ls * (1.f / 16.f);
            cum[tt] = run;
        }
        qt[tq * 128 + d] = run;
        __syncthreads();
        float off = 0.f;
#pragma unroll
        for (int q = 0; q < 3; ++q) off += (q < tq) ? qt[q * 128 + d] : 0.f;
#pragma unroll
        for (int tt = 0; tt < 16; ++tt) Gs[(tq * 16 + tt) * 128 + d] = cum[tt] + off;
    }
    __syncthreads();
    {
#pragma unroll
        for (int i = 0; i < 4; ++i) {
            const int item = i * 512 + tid, part = item >> 10, t = (item >> 4) & 63, cg = item & 15;
            float f[8]; unpack8(rq[i], f);
            float o[8];
            const f32x4 g0 = *(const f32x4*)(Gs + t * 128 + cg * 8), g1 = *(const f32x4*)(Gs + t * 128 + cg * 8 + 4), l0 = *(const f32x4*)(Gs + 63 * 128 + cg * 8), l1 = *(const f32x4*)(Gs + 63 * 128 + cg * 8 + 4);
            const float dls[8] = {g0.x - l0.x, g0.y - l0.y, g0.z - l0.z, g0.w - l0.w, g1.x - l1.x, g1.y - l1.y, g1.z - l1.z, g1.w - l1.w};
#pragma unroll
            for (int j = 0; j < 8; ++j) { const float dl = dls[j]; o[j] = part == 0 ? f[j] * 0.08838834764831845f * __expf(dl) : f[j] * __expf(-dl); }
            const u32x4 w = pack8(o);
            if (part == 0) { *(u32x4*)(qs + t * 136 + cg * 8) = w; *(u32x4*)(QT_ + ch * 8192 + t * 128 + cg * 8) = w; }
            else { *(u32x4*)(ks + t * 136 + cg * 8) = w;
#pragma unroll
                for (int j = 0; j < 8; ++j) kT[(cg * 8 + j) * 72 + (((t >> 3) ^ (cg & 7)) << 3) + (t & 7)] = (bf16)f2bf(o[j]); }
        }
#pragma unroll
        for (int i = 0; i < 4; ++i) {
            const int item = i * 512 + tid, t = item >> 5, eg8 = item & 31;
            const u32x4 w = rv[i];
            bf16* vp = vT + (eg8 * 8) * 72 + (((t >> 3) ^ (eg8 & 7)) << 3) + (t & 7);
            vp[0] = (bf16)(w.x & 0xffff); vp[72] = (bf16)(w.x >> 16); vp[144] = (bf16)(w.y & 0xffff); vp[216] = (bf16)(w.y >> 16);
            vp[288] = (bf16)(w.z & 0xffff); vp[360] = (bf16)(w.z >> 16); vp[432] = (bf16)(w.w & 0xffff); vp[504] = (bf16)(w.w >> 16);
        }
    }
    if (tid < 128) EGL_[ch * 128 + tid] = __expf(Gs[63 * 128 + tid]);
    __syncthreads();
    {
        const int mt = wave >> 1;
        bf16x8 aF[4];
#pragma unroll
        for (int k4 = 0; k4 < 4; ++k4) aF[k4] = *(const bf16x8*)(qs + (mt * 16 + m16) * 136 + k4 * 32 + q4 * 8);
#pragma unroll
        for (int n2 = 0; n2 < 2; ++n2) {
            const int nt = (wave & 1) * 2 + n2;
            f32x4 acc = {0.f, 0.f, 0.f, 0.f};
            if (nt <= mt) {
#pragma unroll
                for (int k4 = 0; k4 < 4; ++k4) { const bf16x8 bF = *(const bf16x8*)(ks + (nt * 16 + m16) * 136 + k4 * 32 + q4 * 8); acc = mfma16(aF[k4], bF, acc); }
            }
            const int s = nt * 16 + m16;
#pragma unroll
            for (int i = 0; i < 4; ++i) { const int t = mt * 16 + q4 * 4 + i; as[t * 72 + s] = (bf16)f2bf(t >= s ? acc[i] : 0.f); }
        }
    }
    {
        bf16x8 aF[2];
#pragma unroll
        for (int k2 = 0; k2 < 2; ++k2) { const int rr = wave * 16 + m16; aF[k2] = *(const bf16x8*)(kT + rr * 72 + (((k2 * 4 + q4) ^ ((rr >> 3) & 7)) << 3)); }
#pragma unroll 4
        for (int nt = 0; nt < 16; ++nt) {
            f32x4 acc = {0.f, 0.f, 0.f, 0.f};
#pragma unroll
            for (int k2 = 0; k2 < 2; ++k2) { const int rr = nt * 16 + m16; const bf16x8 bF = *(const bf16x8*)(vT + rr * 72 + (((k2 * 4 + q4) ^ ((rr >> 3) & 7)) << 3)); acc = mfma16(aF[k2], bF, acc); }
            u32x2 w; w.x = pk2(acc[0], acc[1]); w.y = pk2(acc[2], acc[3]);
            *(u32x2*)(US_ + ch * 32768 + (nt * 16 + m16) * 128 + wave * 16 + q4 * 4) = w;
        }
    }
    __syncthreads();
    {
        bf16x8 bF[2][2];
#pragma unroll
        for (int n2 = 0; n2 < 2; ++n2)
#pragma unroll
            for (int k2 = 0; k2 < 2; ++k2) { const int rr = (wave * 2 + n2) * 16 + m16; bF[n2][k2] = *(const bf16x8*)(vT + rr * 72 + (((k2 * 4 + q4) ^ ((rr >> 3) & 7)) << 3)); }
#pragma unroll
        for (int mt = 0; mt < 4; ++mt) {
            bf16x8 aF[2];
#pragma unroll
            for (int k2 = 0; k2 < 2; ++k2) aF[k2] = *(const bf16x8*)(as + (mt * 16 + m16) * 72 + k2 * 32 + q4 * 8);
#pragma unroll
            for (int n2 = 0; n2 < 2; ++n2) {
                f32x4 acc = {0.f, 0.f, 0.f, 0.f};
                acc = mfma16(bF[n2][0], aF[0], acc); acc = mfma16(bF[n2][1], aF[1], acc);
                u32x2 w; w.x = pk2(acc[0], acc[1]); w.y = pk2(acc[2], acc[3]);
                ((u32x2*)OI)[(((ch * 8 + wave) * 4 + mt) * 2 + n2) * 64 + lane] = w;
            }
        }
    }
    __syncthreads();
}

__device__ __forceinline__ void gla_scan(bf16* US_, const float* __restrict__ EGL_, float* __restrict__ state_out, int gtid, int ngt) {
    for (int idx = gtid; idx < 131072; idx += ngt) {
        const int dp = idx & 63, e = (idx >> 6) & 255, bh = idx >> 14, b = bh >> 2, h = bh & 3;
        float s0 = 0.f, s1 = 0.f;
        unsigned* p = (unsigned*)(US_ + ((size_t)b * 512 + h) * 32768 + e * 128 + dp * 2);
        const float* eg = EGL_ + ((size_t)b * 512 + h) * 128 + dp * 2;
        constexpr size_t PS = (size_t)4 * 32768 / 2, GS = (size_t)4 * 128;
        unsigned ua[8], ub[8]; f32x2v ga[8], gb[8];
#define GSC_LOAD(c0, u_, g_) do { _Pragma("unroll") for (int k = 0; k < 8; ++k) { const int cc = (c0) + k < 128 ? (c0) + k : 127; u_[k] = p[cc * PS]; g_[k] = *(const f32x2v*)(eg + cc * GS); } } while (0)
#define GSC_PROC(c0, u_, g_) do { _Pragma("unroll") for (int k = 0; k < 8; ++k) { s0 *= g_[k].x; s1 *= g_[k].y; p[((c0) + k) * PS] = pk2(s0, s1); s0 += bflo(u_[k]); s1 += bfhi(u_[k]); } } while (0)
        GSC_LOAD(0, ua, ga);
#pragma unroll 1
        for (int c0 = 0; c0 < 128; c0 += 16) {
            GSC_LOAD(c0 + 8, ub, gb);
            GSC_PROC(c0, ua, ga);
            GSC_LOAD(c0 + 16, ua, ga);
            GSC_PROC(c0 + 8, ub, gb);
        }
#undef GSC_LOAD
#undef GSC_PROC
        float* so = state_out + ((size_t)(b * 4 + h) * 128 + dp * 2) * 256 + e;
        so[0] = s0; so[256] = s1;
    }
}

__device__ __forceinline__ void gla_stepC(int tid, int unit, unsigned char* lds, const bf16* __restrict__ PROJ, const bf16* __restrict__ US_, const bf16* __restrict__ QT_, const bf16* __restrict__ OI, const float* gla_norm, bf16* __restrict__ MIX) {
    asm volatile("" : "+v"(tid));
    const int lane = tid & 63, wave = tid >> 6, m16 = lane & 15, q4 = lane >> 4;
    const int h = unit & 3, c = (unit >> 2) & 127, b = unit >> 9;
    const size_t row0 = (size_t)b * SEQ + c * 64; const size_t ch = (size_t)unit;
    float* red = (float*)lds;
    bf16x8 sB[2][4], aF[4][4]; u32x2 oi[4][2], rg[4][2];
#pragma unroll
    for (int n2 = 0; n2 < 2; ++n2)
#pragma unroll
        for (int k4 = 0; k4 < 4; ++k4) sB[n2][k4] = *(const bf16x8*)(US_ + ch * 32768 + ((wave * 2 + n2) * 16 + m16) * 128 + k4 * 32 + q4 * 8);
#pragma unroll
    for (int mt = 0; mt < 4; ++mt) {
#pragma unroll
        for (int k4 = 0; k4 < 4; ++k4) aF[mt][k4] = *(const bf16x8*)(QT_ + ch * 8192 + (mt * 16 + m16) * 128 + k4 * 32 + q4 * 8);
#pragma unroll
        for (int n2 = 0; n2 < 2; ++n2) { oi[mt][n2] = ((const u32x2*)OI)[(((ch * 8 + wave) * 4 + mt) * 2 + n2) * 64 + lane];
            rg[mt][n2] = *(const u32x2*)(PROJ + (row0 + mt * 16 + m16) * NPO + 2048 + h * 256 + (wave * 2 + n2) * 16 + q4 * 4); }
    }
    f32x4 acc[4][2];
#pragma unroll
    for (int mt = 0; mt < 4; ++mt) {
        float ss = 0.f;
#pragma unroll
        for (int n2 = 0; n2 < 2; ++n2) {
            f32x4 a = {bflo(oi[mt][n2].x), bfhi(oi[mt][n2].x), bflo(oi[mt][n2].y), bfhi(oi[mt][n2].y)};
#pragma unroll
            for (int k4 = 0; k4 < 4; ++k4) a = mfma16(sB[n2][k4], aF[mt][k4], a);
            acc[mt][n2] = a;
            ss += (a[0] * a[0] + a[1] * a[1]) + (a[2] * a[2] + a[3] * a[3]);
        }
        ss += __shfl_xor(ss, 16); ss += __shfl_xor(ss, 32);
        if (q4 == 0) red[wave * 64 + mt * 16 + m16] = ss;
    }
    __syncthreads();
    f32x4 gn[2];
#pragma unroll
    for (int n2 = 0; n2 < 2; ++n2) gn[n2] = *(const f32x4*)(gla_norm + (wave * 2 + n2) * 16 + q4 * 4);
#pragma unroll
    for (int mt = 0; mt < 4; ++mt) {
        const int t = mt * 16 + m16; float tot = 0.f;
#pragma unroll
        for (int w = 0; w < 8; ++w) tot += red[w * 64 + t];
        const float rstd = rsqrtf(tot * (1.f / 256.f) + EPS);
#pragma unroll
        for (int n2 = 0; n2 < 2; ++n2) {
            const f32x4 a = acc[mt][n2]; const u32x2 r = rg[mt][n2];
            u32x2 w; w.x = pk2(a[0] * rstd * gn[n2][0] * siluf(bflo(r.x)), a[1] * rstd * gn[n2][1] * siluf(bfhi(r.x)));
            w.y = pk2(a[2] * rstd * gn[n2][2] * siluf(bflo(r.y)), a[3] * rstd * gn[n2][3] * siluf(bfhi(r.y)));
            *(u32x2*)(MIX + (row0 + t) * DM + h * 256 + (wave * 2 + n2) * 16 + q4 * 4) = w;
        }
    }
    __syncthreads();
}

template <int MODE>
__device__ __forceinline__ void skinny_unit(int tid, const bf16* A, const bf16* Bt, int K, int ld, size_t row0, int col0, void* C, int ldc, float sgn = 1.f) {
    asm volatile("" : "+v"(tid));
    const int lane = tid & 63, wave = tid >> 6, m16 = lane & 15, q4 = lane >> 4;
    const bf16* ap = A + (row0 + wave * 16 + m16) * ld + q4 * 8;
    const bf16* bp = Bt + (size_t)(col0 + m16) * ld + q4 * 8;
    f32x4 acc0 = {0.f, 0.f, 0.f, 0.f}, acc1 = {0.f, 0.f, 0.f, 0.f};
#pragma unroll 1
    for (int k = 0; k < K; k += 256) {
        bf16x8 av[8], bv[8];
#pragma unroll
        for (int j = 0; j < 8; ++j) { av[j] = *(const bf16x8*)(ap + k + j * 32); bv[j] = *(const bf16x8*)(bp + k + j * 32); }
#pragma unroll
        for (int j = 0; j < 8; j += 2) { acc0 = mfma16(av[j], bv[j], acc0); acc1 = mfma16(av[j + 1], bv[j + 1], acc1); }
    }
    const f32x4 acc = acc0 + acc1;
    const size_t r = row0 + wave * 16 + q4 * 4; const int c = col0 + m16;
#pragma unroll
    for (int i = 0; i < 4; ++i) {
        if (MODE == 3) { atomicAdd((float*)C + (r + i) * ldc + c, acc[i] * sgn); }
        else { float v = acc[i]; if (MODE == 2) { v = v > 0.f ? v : 0.f; v = v * v; } ((bf16*)C)[(r + i) * ldc + c] = (bf16)f2bf(v); }
    }
}

__device__ __forceinline__ void skinny_res(int tid, int unit, unsigned char* lds, const bf16* __restrict__ A, const bf16* __restrict__ Bt, int K, float* __restrict__ X) {
    asm volatile("" : "+v"(tid));
    const int lane = tid & 63, wave = tid >> 6, m16 = lane & 15, q4 = lane >> 4;
    const int rg = unit >> 6, ct = unit & 63, rt = wave & 1, ksl = wave >> 1, Ks = K >> 2;
    const bf16* ap = A + ((size_t)MPR + rg * 32 + rt * 16 + m16) * K + ksl * Ks + q4 * 8;
    const bf16* bp = Bt + (size_t)(ct * 16 + m16) * K + ksl * Ks + q4 * 8;
    f32x4 acc0 = {0.f, 0.f, 0.f, 0.f}, acc1 = {0.f, 0.f, 0.f, 0.f};
#pragma unroll 1
    for (int k = 0; k < Ks; k += 256) {
        bf16x8 av[8], bv[8];
#pragma unroll
        for (int j = 0; j < 8; ++j) { av[j] = *(const bf16x8*)(ap + k + j * 32); bv[j] = *(const bf16x8*)(bp + k + j * 32); }
#pragma unroll
        for (int j = 0; j < 8; j += 2) { acc0 = mfma16(av[j], bv[j], acc0); acc1 = mfma16(av[j + 1], bv[j + 1], acc1); }
    }
    f32x4* red = (f32x4*)lds;
    red[wave * 64 + lane] = acc0 + acc1;
    __syncthreads();
    if (ksl == 0) {
        const f32x4 t = (red[rt * 64 + lane] + red[(2 + rt) * 64 + lane]) + (red[(4 + rt) * 64 + lane] + red[(6 + rt) * 64 + lane]);
        float* xp = X + ((size_t)MPR + rg * 32 + rt * 16 + q4 * 4) * DM + ct * 16 + m16;
#pragma unroll
        for (int i = 0; i < 4; ++i) xp[i * DM] += t[i];
    }
    __syncthreads();
}

#define LAS __attribute__((address_space(3)))
#define XB_TMO      128
#define XB_XCNT(j)  (256  + 64 * (j))
#define XB_XSUB(j)  (1280 + 64 * (j))
#define XB_XGEN(j)  (2304 + 64 * (j))
#define XB_TOP      3328
#define XB_TOPGEN   3392
#define XCD_BAR_WORDS 3456
#define XB_SPIN_CAP (1u << 18)

__device__ __forceinline__ unsigned xb_ld(unsigned* p)              { return __hip_atomic_load(p, __ATOMIC_RELAXED, __HIP_MEMORY_SCOPE_AGENT); }
__device__ __forceinline__ unsigned xb_add(unsigned* p, unsigned v) { return __hip_atomic_fetch_add(p, v, __ATOMIC_RELAXED, __HIP_MEMORY_SCOPE_AGENT); }
__device__ __forceinline__ unsigned xb_xcc_id() { return (unsigned)__builtin_amdgcn_s_getreg((3 << 11) | 20) & 0xFu; }
#define XB_SPIN(cond, bar) do { unsigned _sp = 0; while (cond) { __builtin_amdgcn_s_sleep(1); \
    if ((++_sp & 255u) == 0u) { if (xb_ld(&(bar)[XB_TMO])) break; if (_sp > XB_SPIN_CAP) { atomicAdd(&(bar)[XB_TMO], 1u); break; } } } } while (0)

struct XcdBarrier {
    unsigned* bar; unsigned x;
    volatile LAS unsigned* st;
};

__device__ __forceinline__ XcdBarrier xcd_barrier_post(unsigned* bar, volatile LAS unsigned* st) {
    XcdBarrier b; b.bar = bar; b.x = xb_xcc_id(); b.st = st;
    if (threadIdx.x == 0) (void)xb_add(&bar[XB_XCNT(b.x)], 1u);
    return b;
}
__device__ __forceinline__ void xcd_barrier_complete(unsigned* bar, unsigned x, unsigned& nloc, unsigned& nx) {
    const unsigned G = gridDim.x * gridDim.y * gridDim.z;
    unsigned sum, cnt, mine, sp = 0u;
    for (;;) {
        sum = 0u; cnt = 0u; mine = 0u;
#pragma unroll
        for (unsigned j = 0; j < 16; ++j) { const unsigned c = xb_ld(&bar[XB_XCNT(j)]); sum += c; cnt += (c > 0u) ? 1u : 0u; mine = (j == x) ? c : mine; }
        if (sum == G) break;
        __builtin_amdgcn_s_sleep(1);
        if ((++sp & 255u) == 0u) { if (xb_ld(&bar[XB_TMO])) break; if (sp > XB_SPIN_CAP) { atomicAdd(&bar[XB_TMO], 1u); break; } }
    }
    nloc = mine > 0u ? mine : 1u; nx = cnt > 0u ? cnt : 1u;
}

__device__ __forceinline__ void xcd_barrier(const XcdBarrier& b) {
    asm volatile("s_waitcnt vmcnt(0)" ::: "memory");
    __syncthreads();
    if (threadIdx.x == 0) {
        unsigned* bar = b.bar;
        __builtin_amdgcn_s_waitcnt(0);
        unsigned nloc = b.st[0], nx = b.st[1];
        if (nloc == 0u) { xcd_barrier_complete(bar, b.x, nloc, nx); b.st[0] = nloc; b.st[1] = nx; }
        const unsigned old = xb_add(&bar[XB_XSUB(b.x)], 1u);
        const unsigned gen = old / nloc;
        if (old + 1u == (gen + 1u) * nloc) {
            __builtin_amdgcn_fence(__ATOMIC_RELEASE, "agent");
            asm volatile("s_waitcnt vmcnt(0)" ::: "memory");
            const unsigned og = xb_add(&bar[XB_TOP], 1u);
            const unsigned tg = og / nx;
            if (og + 1u == (tg + 1u) * nx) xb_add(&bar[XB_TOPGEN], 1u);
            else XB_SPIN(xb_ld(&bar[XB_TOPGEN]) == tg, bar);
            __builtin_amdgcn_fence(__ATOMIC_ACQUIRE, "agent");
            xb_add(&bar[XB_XGEN(b.x)], 1u);
            asm volatile("s_waitcnt vmcnt(0)" ::: "memory");
        } else {
            XB_SPIN(xb_ld(&bar[XB_XGEN(b.x)]) == gen, bar);
            __builtin_amdgcn_fence(__ATOMIC_ACQUIRE, "agent");
            asm volatile("s_waitcnt vmcnt(0)" ::: "memory");
        }
    }
    __syncthreads();
}

#ifndef PROBE_ID
#define PROBE_ID 0
#endif
constexpr size_t WS_TAB = 4096, WS_BAR = 16384;
constexpr int LDS_BARW = 147392;
__global__ void __launch_bounds__(512, 2) mega_fwd(Args a) {
    extern __shared__ __attribute__((aligned(16))) unsigned char lds[];
    const bool coop = (a.ph_hi - a.ph_lo) > 1;
    if (threadIdx.x < 4) ((LAS unsigned*)((LAS unsigned char*)lds + LDS_BARW))[threadIdx.x] = 0u;
    __syncthreads();
    XcdBarrier xbar; xbar.bar = (unsigned*)(a.ws + WS_BAR); xbar.x = 0; xbar.st = nullptr;
    if (coop) xbar = xcd_barrier_post((unsigned*)(a.ws + WS_BAR), (volatile LAS unsigned*)((LAS unsigned char*)lds + LDS_BARW));
#if PROBE_ID
    bool repeated = false; int repcnt = 0; unsigned donemask = 0u;
#endif
#pragma unroll 1
    for (int ph = a.ph_lo; ph < a.ph_hi; ++ph) {
        int tid = threadIdx.x; asm volatile("" : "+v"(tid));
        int bid = blockIdx.x; asm volatile("" : "+s"(bid));
        unsigned char* ws = a.ws; asm volatile("" : "+s"(ws));
        float* outp = a.out; asm volatile("" : "+s"(outp));
        const int lane = tid & 63, wave = tid >> 6;
        const int G = gridDim.x;
        const int gw = bid * 8 + wave, ngw = G * 8;
        bf16* WEI = (bf16*)(ws + WS_WEI); bf16* WEO = (bf16*)(ws + WS_WEO); bf16* WGI = (bf16*)(ws + WS_WGI); bf16* WGO = (bf16*)(ws + WS_WGO);
        bf16* WUP = (bf16*)(ws + WS_WUP); bf16* WDN = (bf16*)(ws + WS_WDN);
        float* X = (float*)(ws + WS_X); bf16* HB = (bf16*)(ws + WS_HB); bf16* MIX = (bf16*)(ws + WS_MIX);
        bf16* PROJ = (bf16*)(ws + WS_BIG); bf16* HID = (bf16*)(ws + WS_BIG);
        const float* const* in = (const float* const*)(ws + WS_TAB);
        if (ph == 0) {
            if (bid == 0 && tid == 0) { const float** tw = (const float**)(ws + WS_TAB);
#pragma unroll
                for (int k = 0; k < 24; ++k) tw[k] = a.in[k]; }
            float* scr = (float*)(lds + wave * 16640);
            transpose_w(a.in[10], DM, NE_IN, NPE, WEI, scr, gw, ngw, lane);
            transpose_w(a.in[16], DM, DM, DM, WEO, scr, gw, ngw, lane);
            transpose_w(a.in[22], DM, FF, FF, WUP, scr, gw, ngw, lane);
            transpose_w(a.in[23], FF, DM, DM, WDN, scr, gw, ngw, lane);
            for (int m = gw; m < MPAD; m += ngw) {
                f32x4 v[4];
                const float* src = m < MPR ? a.in[0] + (size_t)m * DM : (m < MREAL ? a.in[1] + (size_t)(m - MPR) * DM : nullptr);
#pragma unroll
                for (int j = 0; j < 4; ++j) { v[j] = src ? *(const f32x4*)(src + 4 * lane + 256 * j) : (f32x4){0.f, 0.f, 0.f, 0.f}; *(f32x4*)(X + (size_t)m * DM + 4 * lane + 256 * j) = v[j]; }
                norm_row(v, a.in[7], HB + (size_t)m * DM, nullptr, lane);
                if (m >= MREAL) {
#pragma unroll
                    for (int j = 0; j < 4; ++j) { u32x2 z = {0u, 0u}; *(u32x2*)(MIX + (size_t)m * DM + 4 * lane + 256 * j) = z; }
                }
            }
        } else {
            const int l = (ph - 1) / 9, sp = (ph - 1) % 9, even = !(l & 1), li = l >> 1;
            if (sp == 0) {
                const bf16* Bt = even ? WEI + (size_t)li * NPE * DM : WGI + (size_t)li * NPO * DM; const int ldp = even ? NPE : NPO;
                pg8::Gemm g{HB, Bt, MPR, 3072, DM};
                pg8::StaticOrder S; S.init(g.M, g.N, G, bid);
                pg8::EpiBf16<0> E{PROJ, ldp};
                pg8::gemm_phase<pg8::EpiBf16<0>, pg8::StaticOrder, true, true>((PG8_LAS unsigned char*)lds, g, S, E);
                const int nts = even ? 177 : 193, nsk = even ? nts : nts + 128;
                for (int u = bid; u < nsk; u += G) {
                    if (u < nts) skinny_unit<0>(tid, HB, Bt, DM, DM, (size_t)MPR, u * 16, PROJ, ldp);
                    else skinny_unit<0>(tid, HB, Bt, DM, DM, (size_t)(u - nts) * 128, 3072, PROJ, ldp);
                }
            } else if (sp == 1) {
                if (even) {
                    const float* cw = in[11] + (size_t)li * 4 * 1536; const float* al = in[12] + li * 4; const float* dtb = in[13] + li * 4;
                    for (int u = bid; u < 1024; u += G)
                        dn_stepA(tid, u, lds, PROJ, cw, al, dtb,
                                 (bf16*)(ws + SC_DN_W), (bf16*)(ws + SC_DN_QE), (bf16*)(ws + SC_DN_KT), (bf16*)(ws + SC_DN_AT), (bf16*)(ws + SC_DN_U), (float*)(ws + SC_DN_EGL));
                } else {
                    const float* wg = in[18] + (size_t)li * 16 * 512; const float* bgp = in[19] + li * 512;
                    for (int u = bid; u < 1024; u += G)
                        gla_stepA(tid, u, lds, PROJ, wg, bgp, (bf16*)(ws + SC_GL_US), (bf16*)(ws + SC_GL_QT), (bf16*)(ws + SC_GL_OI), (float*)(ws + SC_GL_EGL));
                }
            } else if (sp == 2) {
                if (even) {
                    const int nb = G > 64 ? 64 : G;
#if PROBE_ID == 12
                    if (!repeated)
#endif
                    if (bid < nb) { for (int it = bid; it < 64; it += nb)
                        dn_stepB(tid, it, lds, (const bf16*)(ws + SC_DN_W), (const bf16*)(ws + SC_DN_KT), (const bf16*)(ws + SC_DN_U),
                                 (const float*)(ws + SC_DN_EGL), (bf16*)(ws + SC_DN_O), (bf16*)(ws + SC_DN_VN), outp + O_PDN + (size_t)li * 2 * 4 * 16384); }
                    const int ob = G > 64 ? bid - 64 : bid, on = G > 64 ? G - 64 : G;
#if PROBE_ID == 11
                    if (!repeated)
#endif
                    if (ob >= 0) {
                        const float* sdn = in[2]; const float* scv = in[3]; const float* ckp = in[4]; const float* cvp = in[5];
                        const float* cw = in[11] + (size_t)li * 4 * 1536; const float* al = in[12] + li * 4; const float* dtb = in[13] + li * 4;
                        const float* dnn = in[14] + li * 128; const float* snk = in[15] + li * 8;
                        for (int u = ob; u < 256 + MSA + 4; u += on) {
                            if (u < 256) swa_prompt(tid, u, lds, PROJ, snk, MIX);
                            else if (u < 256 + MSA) sample_even(tid, u - 256, li, lds, PROJ, sdn, scv, ckp, cvp, cw, al, dtb, dnn, snk, MIX, outp);
                            else prompt_misc(tid, u - 256 - MSA, li, PROJ, outp);
                        }
                        if (l == 0) {
                            float* scr = (float*)(lds + wave * 16640);
                            const int gw2 = ob * 8 + wave, ngw2 = on * 8;
                            transpose_w(in[17], DM, NO_IN, NPO, WGI, scr, gw2, ngw2, lane);
                            transpose_w(in[21], DM, DM, DM, WGO, scr, gw2, ngw2, lane);
                            transpose_w(in[22] + (size_t)1 * DM * FF, DM, FF, FF, WUP + (size_t)1 * FF * DM, scr, gw2, ngw2, lane);
                            transpose_w(in[23] + (size_t)1 * FF * DM, FF, DM, DM, WDN + (size_t)1 * DM * FF, scr, gw2, ngw2, lane);
                            transpose_w(in[10] + (size_t)DM * NE_IN, DM, NE_IN, NPE, WEI + (size_t)NPE * DM, scr, gw2, ngw2, lane);
                            transpose_w(in[16] + (size_t)DM * DM, DM, DM, DM, WEO + (size_t)DM * DM, scr, gw2, ngw2, lane);
                            transpose_w(in[22] + (size_t)2 * DM * FF, DM, FF, FF, WUP + (size_t)2 * FF * DM, scr, gw2, ngw2, lane);
                            transpose_w(in[23] + (size_t)2 * FF * DM, FF, DM, DM, WDN + (size_t)2 * DM * FF, scr, gw2, ngw2, lane);
                            transpose_w(in[17] + (size_t)DM * NO_IN, DM, NO_IN, NPO, WGI + (size_t)NPO * DM, scr, gw2, ngw2, lane);
                            transpose_w(in[21] + (size_t)DM * DM, DM, DM, DM, WGO + (size_t)DM * DM, scr, gw2, ngw2, lane);
                            transpose_w(in[22] + (size_t)3 * DM * FF, DM, FF, FF, WUP + (size_t)3 * FF * DM, scr, gw2, ngw2, lane);
                            transpose_w(in[23] + (size_t)3 * FF * DM, FF, DM, DM, WDN + (size_t)3 * DM * FF, scr, gw2, ngw2, lane);
                            __syncthreads();
                        }
                    }
                } else {
                    const int nsc = G >= 2 ? G / 2 : G;
                    if (bid < nsc) gla_scan((bf16*)(ws + SC_GL_US), (const float*)(ws + SC_GL_EGL), outp + O_PGLA + (size_t)li * 2 * 4 * 32768, bid * 512 + tid, nsc * 512);
                    if (G < 2 || bid >= nsc) {
                        const float* wg = in[18] + (size_t)li * 16 * 512; const float* bgp = in[19] + li * 512; const float* gn = in[20] + li * 256; const float* sg = in[6];
                        const int ob = G >= 2 ? bid - nsc : 0, on = G >= 2 ? G - nsc : 1;
                        for (int u = ob; u < MSA; u += on) sample_odd(tid, u, li, lds, PROJ, sg, wg, bgp, gn, MIX, outp);
                    }
                }
            } else if (sp == 3) {
                if (even) { const float* dnn = in[14] + li * 128;
                    for (int u = bid; u < 1024; u += G) dn_stepC(tid, u, lds, PROJ, (const bf16*)(ws + SC_DN_QE), (const bf16*)(ws + SC_DN_AT), (const bf16*)(ws + SC_DN_O), (const bf16*)(ws + SC_DN_VN), dnn, MIX); }
                else { const float* gn = in[20] + li * 256;
                    for (int u = bid; u < 1024; u += G) gla_stepC(tid, u, lds, PROJ, (const bf16*)(ws + SC_GL_US), (const bf16*)(ws + SC_GL_QT), (const bf16*)(ws + SC_GL_OI), gn, MIX); }
            } else if (sp == 4 || sp == 7) {
                pg8::Gemm g{sp == 4 ? MIX : HID, sp == 4 ? (even ? WEO : WGO) + (size_t)li * DM * DM : WDN + (size_t)l * DM * FF, MPR, DM, sp == 4 ? DM : FF};
                pg8::StaticOrder S; S.init(g.M, g.N, G, bid);
#if PROBE_ID == 13 || PROBE_ID == 14
                const float sgn = (repcnt == 1) ? -1.f : 1.f;
#else
                const float sgn = 1.f;
#endif
                pg8::EpiRes E{X, DM, sgn};
                pg8::gemm_phase<pg8::EpiRes, pg8::StaticOrder, true, true>((PG8_LAS unsigned char*)lds, g, S, E);
                for (int u = bid; u < 256; u += G) skinny_res(tid, u, lds, g.A, g.Bt, g.K, X);
            } else if (sp == 5) {
                norm_phase(X, in[8] + l * DM, HB, nullptr, gw, ngw, lane);
            } else if (sp == 6) {
                pg8::Gemm g{HB, WUP + (size_t)l * FF * DM, MPR, FF, DM};
                pg8::StaticOrder S; S.init(g.M, g.N, G, bid);
                pg8::EpiBf16<2> E{HID, FF};
                pg8::gemm_phase<pg8::EpiBf16<2>, pg8::StaticOrder, true, true>((PG8_LAS unsigned char*)lds, g, S, E);
                for (int u = bid; u < 256; u += G) skinny_unit<2>(tid, g.A, g.Bt, DM, DM, (size_t)MPR, u * 16, HID, FF);
            } else {
                if (l < 3) norm_phase(X, in[7] + (l + 1) * DM, HB, nullptr, gw, ngw, lane);
                else norm_phase(X, in[9], nullptr, outp + O_Y, gw, ngw, lane);
            }
        }
#if PROBE_ID
        if (coop) {
            const int l_ = (ph - 1) / 9, sp_ = (ph - 1) % 9, ev_ = !(l_ & 1);
            bool rp = false;
            if (PROBE_ID == 1) xcd_barrier(xbar);
            if (PROBE_ID == 2 && ph == 0) rp = true;
            if (ph > 0) {
                if (PROBE_ID == 3 && ev_ && sp_ == 1) rp = true;
                if ((PROBE_ID == 4 || PROBE_ID == 11 || PROBE_ID == 12) && ev_ && sp_ == 2) rp = true;
                if (PROBE_ID == 5 && !ev_ && sp_ == 1) rp = true;
                if (PROBE_ID == 6 && sp_ == 0) rp = true;
                if (PROBE_ID == 7 && sp_ == 6) rp = true;
                if (PROBE_ID == 8 && !ev_ && sp_ == 3) rp = true;
                if (PROBE_ID == 9 && (sp_ == 5 || sp_ == 8)) rp = true;
                if (PROBE_ID == 10 && ev_ && sp_ == 3) rp = true;
            }
            if ((PROBE_ID == 13 && ph > 0 && sp_ == 4) || (PROBE_ID == 14 && ph > 0 && sp_ == 7)) { if (repcnt < 2) { ++repcnt; --ph; xcd_barrier(xbar); continue; } repcnt = 0; }
            if (PROBE_ID == 15 && ph > 0 && !ev_ && sp_ == 2 && !((donemask >> l_) & 1u)) { donemask |= 1u << l_; ph -= 2; xcd_barrier(xbar); continue; }
            if (rp && !repeated) { repeated = true; --ph; xcd_barrier(xbar); continue; }
            repeated = false;
        }
#endif
        if (ph + 1 < a.ph_hi) { if (coop) xcd_barrier(xbar); }
    }
}

extern "C" void kernel_launch(void* const* d_in, const int* in_sizes, int n_in, void* d_out, int out_size, void* d_ws, size_t ws_size, hipStream_t stream) {
    static int grid = 0;
    if (grid == 0) {
        int dev = 0, cus = 0, per_cu = 0;
        hipGetDevice(&dev);
        hipDeviceGetAttribute(&cus, hipDeviceAttributeMultiprocessorCount, dev);
        hipFuncSetAttribute((const void*)mega_fwd, hipFuncAttributeMaxDynamicSharedMemorySize, LDS_BYTES);
        hipOccupancyMaxActiveBlocksPerMultiprocessor(&per_cu, (const void*)mega_fwd, 512, LDS_BYTES);
        if (per_cu < 1) { fprintf(stderr, "kernel_launch: occupancy query says %d blocks/CU\n", per_cu); per_cu = 1; }
        grid = cus * (per_cu > 1 ? 1 : per_cu);
        if (ws_size < WS_END) { fprintf(stderr, "kernel_launch: workspace too small: %zu < %zu\n", ws_size, (size_t)WS_END); grid = -1; }
        if (n_in != 24) { fprintf(stderr, "kernel_launch: expected 24 inputs, got %d\n", n_in); grid = -1; }
    }
    if (grid < 0) return;
    Args a{};
    for (int i = 0; i < 24; ++i) a.in[i] = (const float*)d_in[i];
    a.out = (float*)d_out; a.ws = (unsigned char*)d_ws;
#if MK_LAUNCH_PER_PHASE
    for (int ph = 0; ph < NPH; ++ph) { a.ph_lo = ph; a.ph_hi = ph + 1; hipLaunchKernelGGL(mega_fwd, dim3(grid), dim3(512), LDS_BYTES, stream, a); }
#else
    a.ph_lo = 0; a.ph_hi = NPH;
    if (hipMemsetAsync((char*)d_ws + WS_BAR, 0, 16384, stream) != hipSuccess) { fprintf(stderr, "kernel_launch: memset of barrier words failed\n"); return; }
    void* args[] = {&a};
    hipError_t e = hipLaunchCooperativeKernel((const void*)mega_fwd, dim3(grid), dim3(512), args, LDS_BYTES, stream);
    if (e != hipSuccess) fprintf(stderr, "cooperative launch failed: %s (grid %d)\n", hipGetErrorString(e), grid);
#endif
}
```

```cpp
#include <hip/hip_runtime.h>
#include <hip/hip_cooperative_groups.h>
#include <cstdio>
#include <cstdint>
namespace cg = cooperative_groups;
#ifndef MK_LAUNCH_PER_PHASE
#define MK_LAUNCH_PER_PHASE 0
#endif
namespace pg8 {
#define PG8_LAS __attribute__((address_space(3)))
typedef unsigned short bf16_t;
typedef short bf16x8 __attribute__((ext_vector_type(8)));
typedef float f32x4 __attribute__((ext_vector_type(4)));
typedef unsigned u32x4 __attribute__((ext_vector_type(4)));
constexpr int BM = 256, BK = 64, HALF = 128, HTB = HALF * BK * 2  , STAGE_BYTES = 8 * HTB, NXCD = 8, WGM = 8;

__host__ __device__ __forceinline__ int lds_byte(int r, int c) { const int st = (r >> 4) * 2 + (c >> 5), rr = r & 15, cc = c & 31, ob = rr * 64 + cc * 2; return st * 1024 + (ob ^ (((ob >> 9) & 1) << 5)); }
__host__ __device__ __forceinline__ void stage_rc(int b, int& R, int& C) { const int st = b / 1024, sb = b % 1024, swz = sb ^ (((sb >> 9) & 1) << 5); R = (st >> 1) * 16 + swz / 64; C = (st & 1) * 32 + (swz % 64) / 2; }
__host__ __device__ __forceinline__ int perm32(int rho) { const int n = rho >> 4, i = rho & 15; return 8 * (i >> 2) + 4 * n + (i & 3); }

struct Unit { int pm, pn; };
struct Gemm { const bf16_t* A; const bf16_t* Bt; int M, N, K; };

struct StaticOrder {
    int nM, nN, nwg, G, c;
    __host__ __device__ void init(int M, int N, int G_, int c_) { nM = M / BM; nN = N / BM; nwg = nM * nN; G = G_; c = c_; }
    __host__ __device__ bool next(int i, Unit& u) const {
        const long L = (long)i * G + c; if (L >= nwg) return false;
        int wgid = (int)L; { const int q = nwg / NXCD, r = nwg % NXCD, xcd = wgid % NXCD, off = wgid / NXCD; wgid = (xcd < r ? xcd * (q + 1) : r * (q + 1) + (xcd - r) * q) + off; }
        const int nig = WGM * nN, gid = wgid / nig, fm = gid * WGM, gsz = (nM - fm) < WGM ? (nM - fm) : WGM;
        u.pm = fm + ((wgid % nig) % gsz); u.pn = (wgid % nig) / gsz; return true;
    }
    __device__ __forceinline__ void a_ready(const Unit&) const {}
    __device__ __forceinline__ void done(const Unit&) const {}
};

__device__ __forceinline__ unsigned cvt_pk_bf16(float lo, float hi) { unsigned r; asm volatile("v_cvt_pk_bf16_f32 %0, %1, %2" : "=v"(r) : "v"(lo), "v"(hi)); return r; }
typedef float f32x2 __attribute__((ext_vector_type(2)));
template <int ACT> struct EpiBf16 {
    static constexpr bool PERM = true, AFTER_DRAIN = false;
    bf16_t* O; int ldc;
    __device__ __forceinline__ void operator()(const f32x4 (&acc)[2][2][4][2], const Unit& u, int wr, int wc, int fr, int fq) const {
        const int row0 = u.pm * BM + wr * 64 + fr; const int col0 = u.pn * BM + wc * 32 + 8 * fq;
#pragma unroll
        for (int ai = 0; ai < 2; ++ai)
#pragma unroll
            for (int m = 0; m < 4; ++m) { bf16_t* rowp = O + (size_t)(row0 + ai * HALF + m * 16) * ldc + col0;
#pragma unroll
                for (int bj = 0; bj < 2; ++bj) { f32x4 v0 = acc[ai][bj][m][0], v1 = acc[ai][bj][m][1];
                    if (ACT == 2) {
#pragma unroll
                        for (int j = 0; j < 4; ++j) { float a = v0[j] > 0.f ? v0[j] : 0.f; v0[j] = a * a; float b = v1[j] > 0.f ? v1[j] : 0.f; v1[j] = b * b; } }
                    u32x4 w; w.x = cvt_pk_bf16(v0[0], v0[1]); w.y = cvt_pk_bf16(v0[2], v0[3]); w.z = cvt_pk_bf16(v1[0], v1[1]); w.w = cvt_pk_bf16(v1[2], v1[3]);
                    *(u32x4*)(rowp + bj * HALF) = w; } }
    }
};
struct EpiRes {
    static constexpr bool PERM = false, AFTER_DRAIN = false;
    float* X; int ldc; float sgn; const float* R;
    __device__ __forceinline__ void operator()(const f32x4 (&acc)[2][2][4][2], const Unit& u, int wr, int wc, int fr, int fq) const {
        const int col0 = u.pn * BM + wc * 32 + 4 * fq;
#pragma unroll
        for (int ai = 0; ai < 2; ++ai) {
            float* base = X + (size_t)(u.pm * BM + ai * HALF + wr * 64 + fr) * ldc + col0; const float* rbase = R + (size_t)(u.pm * BM + ai * HALF + wr * 64 + fr) * ldc + col0;
            f32x4 r[4][2][2];
#pragma unroll
            for (int m = 0; m < 4; ++m)
#pragma unroll
                for (int bj = 0; bj < 2; ++bj)
#pragma unroll
                    for (int n = 0; n < 2; ++n) r[m][bj][n] = *(const f32x4*)(rbase + (size_t)(m * 16) * ldc + bj * HALF + n * 16);
            asm volatile("" ::: "memory");
#pragma unroll
            for (int m = 0; m < 4; ++m)
#pragma unroll
                for (int bj = 0; bj < 2; ++bj)
#pragma unroll
                    for (int n = 0; n < 2; ++n) *(f32x4*)(base + (size_t)(m * 16) * ldc + bj * HALF + n * 16) = r[m][bj][n] + acc[ai][bj][m][n] * sgn;
            asm volatile("" ::: "memory");
        }
    }
};
template <class Epi, class Sched, bool ALIGN_EPI = false, bool SP2 = false>
__device__ __forceinline__ void gemm_phase(PG8_LAS unsigned char* lds, const Gemm g, const Sched& S, const Epi& E) {
    int tid = threadIdx.x; asm volatile("" : "+v"(tid)); const int wid = __builtin_amdgcn_readfirstlane(tid >> 6), lane = tid & 63, wr = wid >> 2, wc = wid & 3, fr = lane & 15, fq = lane >> 4;
    const int K = g.K, nt = K / BK;
    unsigned voffA[2], voffB[2];
#pragma unroll
    for (int i = 0; i < 2; ++i) { int R, C; stage_rc(tid * 16 + i * 8192, R, C); const int Rb = Epi::PERM ? ((R & ~31) + perm32(R & 31)) : R;
        voffA[i] = (unsigned)(R * K + C) * 2u; voffB[i] = (unsigned)(Rb * K + C) * 2u; }
    const size_t kstep = (size_t)(BK * 2);
    const size_t hstep = (size_t)HALF * K * 2;
    const size_t tstep = 2 * hstep;
    const unsigned ldsw = (unsigned)wid * 1024u;
    const int aoff = lds_byte(wr * 64 + fr, fq * 8), boff = lds_byte(wc * 32 + fr, fq * 8);
#define PG8_SA(b, h) (((b) * 2 + (h)) * HTB)
#define PG8_SB(b, h) ((4 + (b) * 2 + (h)) * HTB)
#define PG8_STAGE(bufoff, gbase, voff) do { _Pragma("unroll") for (int _i = 0; _i < 2; ++_i) \
        __builtin_amdgcn_global_load_lds((const unsigned*)((const char*)(gbase) + (voff)[_i]), (PG8_LAS unsigned*)(lds + (bufoff) + ldsw + _i * 8192), 16, 0, 0); } while (0)
#define PG8_LDA(dst, b, h) do { _Pragma("unroll") for (int m = 0; m < 4; ++m) _Pragma("unroll") for (int k = 0; k < 2; ++k) dst[m][k] = *(const PG8_LAS bf16x8*)(lds + PG8_SA(b, h) + aoff + m * 2048 + k * 1024); } while (0)
#define PG8_LDB(dst, b, h) do { _Pragma("unroll") for (int n = 0; n < 2; ++n) _Pragma("unroll") for (int k = 0; k < 2; ++k) dst[n][k] = *(const PG8_LAS bf16x8*)(lds + PG8_SB(b, h) + boff + n * 2048 + k * 1024); } while (0)
#define PG8_MMA(ai, bj, At, Bt) do { __builtin_amdgcn_s_setprio(1); _Pragma("unroll") for (int m = 0; m < 4; ++m) _Pragma("unroll") for (int n = 0; n < 2; ++n) _Pragma("unroll") for (int k = 0; k < 2; ++k) \
        acc[ai][bj][m][n] = __builtin_amdgcn_mfma_f32_16x16x32_bf16(Bt[n][k], At[m][k], acc[ai][bj][m][n], 0, 0, 0); __builtin_amdgcn_s_setprio(0); } while (0)
#define PG8_WAIT_V(n) asm volatile("s_waitcnt vmcnt(" #n ")" ::: "memory")
#define PG8_WAIT_L(n) asm volatile("s_waitcnt lgkmcnt(" #n ")" ::: "memory")
#define PG8_BAR __builtin_amdgcn_s_barrier()
#define PG8_SCHED __builtin_amdgcn_sched_barrier(0)
    Unit cur, nxt; int ui = 0;
    if (!S.next(0, cur)) return;
    f32x4 acc[2][2][4][2];
#pragma unroll
    for (int a = 0; a < 2; ++a)
#pragma unroll
        for (int b = 0; b < 2; ++b)
#pragma unroll
            for (int m = 0; m < 4; ++m)
#pragma unroll
                for (int n = 0; n < 2; ++n) acc[a][b][m][n] = (f32x4){0.f, 0.f, 0.f, 0.f};
    bf16x8 At[4][2], B0[2][2], B1[2][2];
    const char* cA = (const char*)g.A + (size_t)cur.pm * tstep; const char* cB = (const char*)g.Bt + (size_t)cur.pn * tstep;
    S.a_ready(cur);
    if constexpr (SP2) {
        PG8_STAGE(PG8_SB(0, 0), cB, voffB); PG8_STAGE(PG8_SB(0, 1), cB + hstep, voffB); PG8_STAGE(PG8_SA(0, 0), cA, voffA); PG8_STAGE(PG8_SA(0, 1), cA + hstep, voffA);
        if (wr == 1) PG8_BAR;
        PG8_WAIT_V(2); PG8_BAR;
        PG8_STAGE(PG8_SB(1, 0), cB + kstep, voffB); PG8_STAGE(PG8_SA(1, 0), cA + kstep, voffA); PG8_STAGE(PG8_SB(1, 1), cB + hstep + kstep, voffB);
        PG8_WAIT_V(6); PG8_BAR;
    } else {
        PG8_STAGE(PG8_SB(0, 0), cB, voffB); PG8_STAGE(PG8_SA(0, 0), cA, voffA); PG8_STAGE(PG8_SB(0, 1), cB + hstep, voffB); PG8_STAGE(PG8_SA(0, 1), cA + hstep, voffA);
        if (wr == 1) PG8_BAR;
        PG8_WAIT_V(4); PG8_BAR;
        PG8_STAGE(PG8_SB(1, 0), cB + kstep, voffB); PG8_STAGE(PG8_SA(1, 0), cA + kstep, voffA); PG8_STAGE(PG8_SB(1, 1), cB + hstep + kstep, voffB);
        PG8_WAIT_V(6); PG8_BAR;
    }
    for (;;) {
        const bool has_next = S.next(ui + 1, nxt);
        const char* nA = has_next ? (const char*)g.A + (size_t)nxt.pm * tstep : cA; const char* nB = has_next ? (const char*)g.Bt + (size_t)nxt.pn * tstep : cB;
        for (int t = 0; t < nt; t += 2) {
            const bool last = (t == nt - 2);
            const char* a1 = cA + (size_t)(t + 1) * kstep;
            const char* a2 = last ? nA : cA + (size_t)(t + 2) * kstep; const char* b2 = last ? nB : cB + (size_t)(t + 2) * kstep;
            const char* a3 = a2 + kstep; const char* b3 = b2 + kstep;
            if (last && has_next) S.a_ready(nxt);
            if constexpr (SP2) {
            PG8_LDB(B0, 0, 0); PG8_LDB(B1, 0, 1); PG8_SCHED; PG8_LDA(At, 0, 0); PG8_STAGE(PG8_SA(1, 1), a1 + hstep, voffA);
            PG8_WAIT_V(8); PG8_WAIT_L(0); PG8_BAR; PG8_MMA(0, 0, At, B0); PG8_MMA(0, 1, At, B1); PG8_BAR; PG8_SCHED;
            PG8_LDA(At, 0, 1); PG8_STAGE(PG8_SB(0, 0), b2, voffB); PG8_STAGE(PG8_SB(0, 1), b2 + hstep, voffB); PG8_STAGE(PG8_SA(0, 0), a2, voffA);
            PG8_WAIT_V(8); PG8_WAIT_L(0); PG8_BAR; PG8_MMA(1, 0, At, B0); PG8_MMA(1, 1, At, B1); PG8_BAR; PG8_SCHED;
            PG8_LDB(B0, 1, 0); PG8_LDB(B1, 1, 1); PG8_SCHED; PG8_LDA(At, 1, 0); PG8_STAGE(PG8_SA(0, 1), a2 + hstep, voffA);
            PG8_WAIT_V(8); PG8_WAIT_L(0); PG8_BAR; PG8_MMA(0, 0, At, B0); PG8_MMA(0, 1, At, B1); PG8_BAR; PG8_SCHED;
            PG8_LDA(At, 1, 1); PG8_STAGE(PG8_SB(1, 0), b3, voffB); PG8_STAGE(PG8_SB(1, 1), b3 + hstep, voffB); PG8_STAGE(PG8_SA(1, 0), a3, voffA);
            PG8_WAIT_V(8); PG8_WAIT_L(0); PG8_BAR; PG8_MMA(1, 0, At, B0); PG8_MMA(1, 1, At, B1); PG8_BAR; PG8_SCHED;
            } else {
            PG8_LDB(B0, 0, 0); PG8_SCHED; PG8_LDA(At, 0, 0); PG8_STAGE(PG8_SA(1, 1), a1 + hstep, voffA);
            PG8_WAIT_L(8); PG8_BAR; PG8_WAIT_L(0); PG8_MMA(0, 0, At, B0); PG8_BAR; PG8_SCHED;
            PG8_LDB(B1, 0, 1); PG8_STAGE(PG8_SB(0, 0), b2, voffB);
            PG8_BAR; PG8_WAIT_L(0); PG8_MMA(0, 1, At, B1); PG8_BAR;
            PG8_LDA(At, 0, 1); PG8_STAGE(PG8_SA(0, 0), a2, voffA);
            PG8_BAR; PG8_WAIT_L(0); PG8_MMA(1, 0, At, B0); PG8_BAR; PG8_SCHED;
            PG8_STAGE(PG8_SB(0, 1), b2 + hstep, voffB);
            PG8_WAIT_V(6); PG8_BAR; PG8_MMA(1, 1, At, B1); PG8_BAR;
            PG8_LDB(B0, 1, 0); PG8_SCHED; PG8_LDA(At, 1, 0); PG8_STAGE(PG8_SA(0, 1), a2 + hstep, voffA);
            PG8_WAIT_L(8); PG8_BAR; PG8_WAIT_L(0); PG8_MMA(0, 0, At, B0); PG8_BAR; PG8_SCHED;
            PG8_LDB(B1, 1, 1); PG8_STAGE(PG8_SB(1, 0), b3, voffB);
            PG8_BAR; PG8_WAIT_L(0); PG8_MMA(0, 1, At, B1); PG8_BAR;
            PG8_LDA(At, 1, 1); PG8_STAGE(PG8_SA(1, 0), a3, voffA);
            PG8_BAR; PG8_WAIT_L(0); PG8_MMA(1, 0, At, B0); PG8_BAR; PG8_SCHED;
            PG8_STAGE(PG8_SB(1, 1), b3 + hstep, voffB);
            PG8_WAIT_V(6); PG8_BAR; PG8_MMA(1, 1, At, B1); PG8_BAR;
            }
        }
        if constexpr (ALIGN_EPI) { if (wr == 0) PG8_BAR; }
        if constexpr (!Epi::AFTER_DRAIN) { E(acc, cur, wr, wc, fr, fq); S.done(cur); }
        if (!has_next) break;
#pragma unroll
        for (int a = 0; a < 2; ++a)
#pragma unroll
            for (int b = 0; b < 2; ++b)
#pragma unroll
                for (int m = 0; m < 4; ++m)
#pragma unroll
                    for (int n = 0; n < 2; ++n) acc[a][b][m][n] = (f32x4){0.f, 0.f, 0.f, 0.f};
        cur = nxt; cA = nA; cB = nB; ++ui;
        if constexpr (ALIGN_EPI) { if (wr == 1) PG8_BAR; }
    }
    PG8_WAIT_V(0);
    if constexpr (!ALIGN_EPI) { if (wr == 0) PG8_BAR; }
    PG8_BAR;
    if constexpr (Epi::AFTER_DRAIN) { E.fused(acc, cur, wr, wc, fr, fq, lds, wid, lane); S.done(cur); }
#undef PG8_SA
#undef PG8_SB
#undef PG8_STAGE
#undef PG8_LDA
#undef PG8_LDB
#undef PG8_MMA
#undef PG8_WAIT_V
#undef PG8_WAIT_L
#undef PG8_BAR
#undef PG8_SCHED
}
}
typedef unsigned short bf16;
typedef short bf16x8 __attribute__((ext_vector_type(8)));
typedef float f32x4 __attribute__((ext_vector_type(4)));
typedef float f32x2v __attribute__((ext_vector_type(2)));
typedef unsigned u32x4 __attribute__((ext_vector_type(4)));
typedef unsigned u32x2 __attribute__((ext_vector_type(2)));

constexpr int DM = 1024, SEQ = 8192, MPR = 16384, MSA = 128, MREAL = 16512, MPAD = 16640, FF = 4096;
constexpr int NPE = 3072, NPO = 3328, NE_IN = 2824, NO_IN = 3088;
constexpr float EPS = 1e-6f;
constexpr size_t MiB = 1u << 20;
constexpr size_t WS_WEI = 1 * MiB;
constexpr size_t WS_WEO = WS_WEI + 12 * MiB;
constexpr size_t WS_WGI = WS_WEO + 4 * MiB;
constexpr size_t WS_WGO = WS_WGI + 13 * MiB;
constexpr size_t WS_WUP = WS_WGO + 4 * MiB;
constexpr size_t WS_WDN = WS_WUP + 32 * MiB;
constexpr size_t WS_X   = WS_WDN + 32 * MiB;
constexpr size_t WS_HB  = WS_X + 65 * MiB;
constexpr size_t WS_MIX = WS_HB + 33 * MiB;
constexpr size_t WS_BIG = WS_MIX + 33 * MiB;
constexpr size_t WS_SCR = WS_BIG + 106 * MiB;
constexpr size_t SC_DN_W = WS_SCR, SC_DN_QE = SC_DN_W + 16 * MiB, SC_DN_KT = SC_DN_QE + 16 * MiB, SC_DN_AT = SC_DN_KT + 16 * MiB,
                 SC_DN_U = SC_DN_AT + 8 * MiB, SC_DN_EGL = SC_DN_U + 16 * MiB, SC_DN_O = SC_DN_EGL + 1 * MiB;
constexpr size_t SC_GL_US = WS_SCR, SC_GL_QT = SC_GL_US + 64 * MiB, SC_GL_OI = SC_GL_QT + 16 * MiB, SC_GL_EGL = SC_GL_OI + 32 * MiB;
constexpr size_t SC_DN_VN = SC_DN_O + 32 * MiB;
constexpr size_t WS_END = WS_SCR + 122 * MiB;
constexpr size_t O_Y = 0, O_PDN = 16908288, O_PCONV = 17170432, O_PK = 17188864, O_PV = 17254400, O_PGLA = 17319936,
                 O_SDN = 17844224, O_SCONV = 34621440, O_SK = 35801088, O_SV = 39995392, O_SGLA = 44189696;
constexpr int LDS_BYTES = 147456;
constexpr int NPH = 37;

struct Args { const float* in[24]; float* out; unsigned char* ws; int ph_lo, ph_hi; };

typedef __bf16 bf16x2_t __attribute__((ext_vector_type(2)));
__device__ __forceinline__ unsigned pk2(float lo, float hi) { bf16x2_t v; v.x = (__bf16)lo; v.y = (__bf16)hi; return __builtin_bit_cast(unsigned, v); }
__device__ __forceinline__ unsigned f2bf(float f) { return pk2(f, 0.f) & 0xffffu; }
__device__ __forceinline__ float bf2f(unsigned h) { return __uint_as_float(h << 16); }

__device__ __forceinline__ float bflo(unsigned u) { return __uint_as_float(u << 16); }
__device__ __forceinline__ float bfhi(unsigned u) { return __uint_as_float(u & 0xffff0000u); }
__device__ __forceinline__ f32x4 mfma16(bf16x8 a, bf16x8 b, f32x4 c) { return __builtin_amdgcn_mfma_f32_16x16x32_bf16(a, b, c, 0, 0, 0); }
__device__ __forceinline__ float opq(float x) { asm volatile("" : "+v"(x)); return x; }
__device__ __forceinline__ float siluf(float x) { return x * __builtin_amdgcn_rcpf(1.f + __expf(-x)); }
#define DPPF(v, ctrl) __int_as_float(__builtin_amdgcn_update_dpp(0, __float_as_int(v), ctrl, 0xf, 0xf, false))
__device__ __forceinline__ float sum16(float v) { v += DPPF(v, 0xB1); v += DPPF(v, 0x4E); v += DPPF(v, 0x141); v += DPPF(v, 0x140); return v; }
__device__ __forceinline__ float max16(float v) { v = fmaxf(v, DPPF(v, 0xB1)); v = fmaxf(v, DPPF(v, 0x4E)); v = fmaxf(v, DPPF(v, 0x141)); v = fmaxf(v, DPPF(v, 0x140)); return v; }
__device__ __forceinline__ float wave_sum(float v) { v = sum16(v); v += __shfl_xor(v, 16); v += __shfl_xor(v, 32); return v; }
__device__ __forceinline__ float wave_max(float v) { v = max16(v); v = fmaxf(v, __shfl_xor(v, 16)); v = fmaxf(v, __shfl_xor(v, 32)); return v; }
#define LDSWAIT() asm volatile("s_waitcnt lgkmcnt(0)" ::: "memory")
#define BAR_LDS() do { asm volatile("s_waitcnt lgkmcnt(0)" ::: "memory"); __builtin_amdgcn_s_barrier(); asm volatile("" ::: "memory"); } while (0)
__device__ __forceinline__ void unpack8(u32x4 w, float (&f)[8]) { f[0] = bflo(w.x); f[1] = bfhi(w.x); f[2] = bflo(w.y); f[3] = bfhi(w.y); f[4] = bflo(w.z); f[5] = bfhi(w.z); f[6] = bflo(w.w); f[7] = bfhi(w.w); }
__device__ __forceinline__ u32x4 pack8(const float (&f)[8]) { u32x4 w; w.x = pk2(f[0], f[1]); w.y = pk2(f[2], f[3]); w.z = pk2(f[4], f[5]); w.w = pk2(f[6], f[7]); return w; }

__device__ __forceinline__ void transpose_w(const float* __restrict__ W, int K, int N, int Npad, bf16* __restrict__ WT, float* scr, int gw, int ngw, int lane) {
    const int nblk = Npad / 64, nitems = (K / 64) * nblk;
    for (int it = gw; it < nitems; it += ngw) {
        const int kb = it / nblk, nb = it % nblk, k0 = 64 * kb, n0 = 64 * nb;
        const int n = n0 + lane;
        float v[64];
#pragma unroll
        for (int kk = 0; kk < 64; ++kk) v[kk] = (n < N) ? W[(size_t)(k0 + kk) * N + n] : 0.f;
#pragma unroll
        for (int kk = 0; kk < 64; ++kk) scr[kk * 65 + lane] = v[kk];
        LDSWAIT();
        const int c = lane & 7;
#pragma unroll
        for (int j = 0; j < 8; ++j) { const int nl = (lane >> 3) + 8 * j; const float* s = scr + (8 * c) * 65 + nl;
            u32x4 o; o.x = pk2(s[0 * 65], s[1 * 65]); o.y = pk2(s[2 * 65], s[3 * 65]); o.z = pk2(s[4 * 65], s[5 * 65]); o.w = pk2(s[6 * 65], s[7 * 65]);
            *(u32x4*)(WT + (size_t)(n0 + nl) * K + k0 + 8 * c) = o; }
        LDSWAIT();
    }
}
__device__ __forceinline__ void norm_row(const f32x4 (&v)[4], const float* g, bf16* hrow, float* yrow, int lane) {
    float s = 0.f;
#pragma unroll
    for (int j = 0; j < 4; ++j) s += (v[j].x * v[j].x + v[j].y * v[j].y) + (v[j].z * v[j].z + v[j].w * v[j].w);
    const float rstd = rsqrtf(wave_sum(s) * (1.f / DM) + EPS);
#pragma unroll
    for (int j = 0; j < 4; ++j) { const f32x4 gg = *(const f32x4*)(g + 4 * lane + 256 * j); const f32x4 o = v[j] * rstd * gg;
        if (hrow) { u32x2 w; w.x = pk2(o.x, o.y); w.y = pk2(o.z, o.w); *(u32x2*)(hrow + 4 * lane + 256 * j) = w; }
        else *(f32x4*)(yrow + 4 * lane + 256 * j) = o; }
}
__device__ __forceinline__ void norm_phase(const float* __restrict__ X, const float* g, bf16* __restrict__ HB, float* __restrict__ Y, int gw, int ngw, int lane) {
    for (int m0 = gw; m0 < MREAL; m0 += 4 * ngw) {
        f32x4 v[4][4];
#pragma unroll
        for (int r = 0; r < 4; ++r) { const int m = m0 + r * ngw; const int mm = m < MREAL ? m : m0;
#pragma unroll
            for (int j = 0; j < 4; ++j) v[r][j] = *(const f32x4*)(X + (size_t)mm * DM + 4 * lane + 256 * j); }
#pragma unroll
        for (int r = 0; r < 4; ++r) { const int m = m0 + r * ngw;
            if (m < MREAL) norm_row(v[r], g, HB ? HB + (size_t)m * DM : nullptr, Y ? Y + (size_t)m * DM : nullptr, lane); }
    }
}

__device__ __forceinline__ void dn_stepA(int tid, int unit, unsigned char* lds, const bf16* PROJ, const float* conv_w, const float* a_log, const float* dt_bias,
                                         bf16* W_, bf16* QE_, bf16* KT_, bf16* AT_, bf16* U_, float* EGL_) {
    asm volatile("" : "+v"(tid));
    const int lane = tid & 63, wave = tid >> 6, m16 = lane & 15, q4 = lane >> 4;
    const int h = unit & 3, c = (unit >> 2) & 127, b = unit >> 9;
    const int t0 = c * 64; const size_t rowb = (size_t)b * SEQ;
    const size_t ch = (size_t)unit;
    bf16* qs = (bf16*)(lds); bf16* ks = (bf16*)(lds + 17408); bf16* kbs = (bf16*)(lds + 34816);
    bf16* vbT = (bf16*)(lds + 52224); bf16* kbgT = (bf16*)(lds + 70656);
    float* Ms = (float*)(lds + 89088); bf16* Tb = (bf16*)(lds + 105728);
    float* Gs = (float*)(lds + 114944); float* Bs = Gs + 64;
    if (wave == 0) {
        const bf16* pr = PROJ + (rowb + t0 + lane) * NPE;
        const float a = bf2f(pr[2048 + h]), bb = bf2f(pr[2052 + h]);
        const float x = a + dt_bias[h];
        const float sp = x > 20.f ? x : __logf(1.f + __expf(x));
        const float g = -__expf(a_log[h]) * sp;
        float G = g;
#pragma unroll
        for (int o = 1; o < 64; o <<= 1) { const float v = __shfl_up(G, o); if (lane >= o) G += v; }
        Gs[lane] = G; Bs[lane] = __builtin_amdgcn_rcpf(1.f + __expf(-bb));
    }
    __syncthreads();
#pragma unroll 1
    for (int bt = 0; bt < 2; ++bt) {
        u32x4 raw[3][4];
#pragma unroll
        for (int ii = 0; ii < 3; ++ii) {
            const int item = (bt * 3 + ii) * 512 + tid, part = item >> 10, t = (item >> 4) & 63, cg = item & 15;
            const int chn = part * 512 + h * 128 + cg * 8;
#pragma unroll
            for (int tap = 0; tap < 4; ++tap) { const int tt = t0 + t - 3 + tap;
                raw[ii][tap] = tt >= 0 ? *(const u32x4*)(PROJ + (rowb + tt) * NPE + chn) : (u32x4){0u, 0u, 0u, 0u}; }
        }
#pragma unroll
        for (int ii = 0; ii < 3; ++ii) {
            const int item = (bt * 3 + ii) * 512 + tid, part = item >> 10, t = (item >> 4) & 63, cg = item & 15;
            const int chn = part * 512 + h * 128 + cg * 8;
            float acc[8];
#pragma unroll
            for (int j = 0; j < 8; ++j) acc[j] = 0.f;
#pragma unroll
            for (int tap = 0; tap < 4; ++tap) {
                float f[8]; unpack8(raw[ii][tap], f);
                const f32x4 c0 = *(const f32x4*)(conv_w + tap * 1536 + chn), c1 = *(const f32x4*)(conv_w + tap * 1536 + chn + 4);
                acc[0] += f[0] * c0.x; acc[1] += f[1] * c0.y; acc[2] += f[2] * c0.z; acc[3] += f[3] * c0.w;
                acc[4] += f[4] * c1.x; acc[5] += f[5] * c1.y; acc[6] += f[6] * c1.z; acc[7] += f[7] * c1.w;
            }
            float ss = 0.f;
#pragma unroll
            for (int j = 0; j < 8; ++j) { acc[j] = siluf(acc[j]); ss += acc[j] * acc[j]; }
            ss = sum16(ss);
            const float rstd = rsqrtf(ss + EPS);
            const float Gt = Gs[t], bt_ = Bs[t];
            if (part == 0) {
                float o[8], oe[8]; const float sc = rstd * 0.08838834764831845f, eg = __expf(Gt);
#pragma unroll
                for (int j = 0; j < 8; ++j) { o[j] = acc[j] * sc; oe[j] = o[j] * eg; }
                *(u32x4*)(qs + t * 136 + cg * 8) = pack8(o);
                *(u32x4*)(QE_ + ch * 8192 + t * 128 + cg * 8) = pack8(oe);
            } else if (part == 1) {
                float o[8], ob[8]; const float eg = __expf(Gt) * bt_;
#pragma unroll
                for (int j = 0; j < 8; ++j) { o[j] = acc[j] * rstd; ob[j] = o[j] * bt_; }
                *(u32x4*)(ks + t * 136 + cg * 8) = pack8(o);
                *(u32x4*)(kbs + t * 136 + cg * 8) = pack8(ob);
#pragma unroll
                for (int j = 0; j < 8; ++j) kbgT[(cg * 8 + j) * 72 + (((t >> 3) ^ (cg & 7)) << 3) + (t & 7)] = (bf16)f2bf(o[j] * eg);
            } else {
#pragma unroll
                for (int j = 0; j < 8; ++j) vbT[(cg * 8 + j) * 72 + (((t >> 3) ^ (cg & 7)) << 3) + (t & 7)] = (bf16)f2bf(acc[j] * bt_);
            }
        }
    }
    __syncthreads();
    {
        const int d = tid >> 2, tg = tid & 3; const float gl = Gs[63];
#pragma unroll
        for (int half = 0; half < 2; ++half) {
            float o[8];
#pragma unroll
            for (int j = 0; j < 8; ++j) { const int t = tg * 16 + half * 8 + j; o[j] = bf2f(ks[t * 136 + d]) * __expf(gl - Gs[t]); }
            *(u32x4*)(KT_ + ch * 8192 + d * 64 + tg * 16 + half * 8) = pack8(o);
        }
        if (tid == 0) EGL_[ch] = __expf(gl);
    }
    {
        const int which = wave >> 2, mt = wave & 3;
        const bf16* As = which ? kbs : qs;
        bf16x8 aF[4];
#pragma unroll
        for (int k4 = 0; k4 < 4; ++k4) aF[k4] = *(const bf16x8*)(As + (mt * 16 + m16) * 136 + k4 * 32 + q4 * 8);
#pragma unroll
        for (int nt = 0; nt < 4; ++nt) {
            f32x4 acc = {0.f, 0.f, 0.f, 0.f};
            if (nt <= mt) {
#pragma unroll
                for (int k4 = 0; k4 < 4; ++k4) { const bf16x8 bF = *(const bf16x8*)(ks + (nt * 16 + m16) * 136 + k4 * 32 + q4 * 8); acc = mfma16(aF[k4], bF, acc); }
            }
            const int s = nt * 16 + m16; const float Gsv = Gs[s];
#pragma unroll
            for (int i = 0; i < 4; ++i) {
                const int t = mt * 16 + q4 * 4 + i;
                const bool on = which ? (t > s) : (t >= s);
                const float v = on ? acc[i] * __expf(Gs[t] - Gsv) : 0.f;
                if (which) Ms[t * 65 + s] = v; else AT_[ch * 4096 + t * 64 + s] = (bf16)f2bf(v);
            }
        }
    }
    __syncthreads();
    {
        float* Ts = (float*)(lds + 115456);
        if (wave == 0) {
            const int blk = lane >> 4, cc = lane & 15; const float* Mb = Ms + (blk * 16) * 65 + blk * 16;
            float tc[16];
#pragma unroll
            for (int r = 0; r < 16; ++r) {
                float acc = (r == cc) ? 1.f : 0.f;
#pragma unroll
                for (int j = 0; j < r; ++j) acc -= Mb[r * 65 + j] * tc[j];
                tc[r] = acc;
            }
#pragma unroll
            for (int r = 0; r < 16; ++r) Ts[(blk * 16 + r) * 65 + blk * 16 + cc] = tc[r];
        }
        __syncthreads();
#pragma unroll 1
        for (int dd = 1; dd < 4; ++dd) {
            if (wave < 4 - dd) {
                const int j = wave, i = wave + dd;
                f32x4 acc = {0.f, 0.f, 0.f, 0.f};
                for (int k = j; k < i; ++k) {
                    const float* A = Ms + (i * 16) * 65 + k * 16; const float* B = Ts + (k * 16) * 65 + j * 16;
#pragma unroll
                    for (int kk = 0; kk < 4; ++kk) acc = __builtin_amdgcn_mfma_f32_16x16x4f32(A[m16 * 65 + kk * 4 + q4], B[(kk * 4 + q4) * 65 + m16], acc, 0, 0, 0);
                }
                float* Tmp = Ts + (j * 16) * 65 + i * 16;
#pragma unroll
                for (int r = 0; r < 4; ++r) Tmp[(q4 * 4 + r) * 65 + m16] = acc[r];
                LDSWAIT();
                f32x4 acc2 = {0.f, 0.f, 0.f, 0.f};
                { const float* A = Ts + (i * 16) * 65 + i * 16;
#pragma unroll
                  for (int kk = 0; kk < 4; ++kk) acc2 = __builtin_amdgcn_mfma_f32_16x16x4f32(A[m16 * 65 + kk * 4 + q4], Tmp[(kk * 4 + q4) * 65 + m16], acc2, 0, 0, 0); }
                float* Out = Ts + (i * 16) * 65 + j * 16;
#pragma unroll
                for (int r = 0; r < 4; ++r) Out[(q4 * 4 + r) * 65 + m16] = -acc2[r];
            }
            __syncthreads();
        }
        const int t = tid >> 3, s8 = (tid & 7) * 8; float o[8];
#pragma unroll
        for (int j = 0; j < 8; ++j) o[j] = (s8 + j <= t) ? Ts[t * 65 + s8 + j] : 0.f;
        *(u32x4*)(Tb + t * 72 + s8) = pack8(o);
    }
    __syncthreads();
    {
        const bf16* BT = wave < 4 ? vbT : kbgT; bf16* OUT = wave < 4 ? U_ : W_;
        bf16x8 bF[2][2];
#pragma unroll
        for (int n2 = 0; n2 < 2; ++n2)
#pragma unroll
            for (int k2 = 0; k2 < 2; ++k2) { const int rr = ((wave & 3) * 2 + n2) * 16 + m16; bF[n2][k2] = *(const bf16x8*)(BT + rr * 72 + (((k2 * 4 + q4) ^ ((rr >> 3) & 7)) << 3)); }
#pragma unroll
        for (int mt = 0; mt < 4; ++mt) {
            bf16x8 aF[2];
#pragma unroll
            for (int k2 = 0; k2 < 2; ++k2) aF[k2] = *(const bf16x8*)(Tb + (mt * 16 + m16) * 72 + k2 * 32 + q4 * 8);
#pragma unroll
            for (int n2 = 0; n2 < 2; ++n2) {
                f32x4 acc = {0.f, 0.f, 0.f, 0.f};
                u32x2 w;
                if (wave < 4) {
                    acc = mfma16(aF[0], bF[n2][0], acc); acc = mfma16(aF[1], bF[n2][1], acc);
                    w.x = pk2(acc[0], acc[1]); w.y = pk2(acc[2], acc[3]);
                    *(u32x2*)(OUT + ch * 8192 + (((wave & 3) * 2 + n2) * 16 + m16) * 64 + mt * 16 + q4 * 4) = w;
                } else {
                    acc = mfma16(bF[n2][0], aF[0], acc); acc = mfma16(bF[n2][1], aF[1], acc);
                    w.x = pk2(acc[0], acc[1]); w.y = pk2(acc[2], acc[3]);
                    *(u32x2*)(OUT + ch * 8192 + (mt * 16 + m16) * 128 + ((wave & 3) * 2 + n2) * 16 + q4 * 4) = w;
                }
            }
        }
    }
    __syncthreads();
}

__device__ __forceinline__ void dn_stepB(int tid, int item, unsigned char* lds, const bf16* W_, const bf16* KT_, const bf16* U_, const float* EGL_,
                                         bf16* SC_, bf16* VN_, float* state_out) {
    asm volatile("" : "+v"(tid));
    const int lane = tid & 63, wave = tid >> 6, m16 = lane & 15, q4 = lane >> 4;
    const int bh = item & 7, sl = item >> 3, b = bh >> 2, h = bh & 3, e0 = sl * 16;
    bf16* Sb = (bf16*)lds;
    bf16* Vn = (bf16*)(lds + 16 * 136 * 2);
    for (int i = tid; i < 16 * 136 / 2; i += 512) ((unsigned*)Sb)[i] = 0u;
    f32x4 accS = {0.f, 0.f, 0.f, 0.f};
    __syncthreads();
    const bool lo = wave < 4;
    int vz = 0; asm volatile("" : "+v"(vz));
    const bf16* xbase = W_ + ((wave & 3) * 16 + m16) * 128 + q4 * 8;
    const bf16* ubase = U_ + (e0 + m16) * 64 + (wave & 3) * 16 + q4 * 4;
    const bf16* kbase = KT_ + (wave * 16 + m16) * 64 + q4 * 8;
    bf16* scbase = SC_ + (e0 + m16) * 128 + wave * 16 + q4 * 4;
    bf16* vnbase = VN_ + (e0 + m16) * 64 + (wave & 3) * 16 + q4 * 4;
#define DNB_LOAD(cc, xA_, kA_, uC_, egl_) do { const int c_ = (cc) < 128 ? (cc) : 127; const size_t ch_ = (size_t)b * 512 + c_ * 4 + h; \
        if (lo) { _Pragma("unroll") for (int k4 = 0; k4 < 4; ++k4) xA_[k4] = *(const bf16x8*)(xbase + ch_ * 8192 + k4 * 32); uC_ = *(const u32x2*)(ubase + ch_ * 8192); } \
        kA_[0] = *(const bf16x8*)(kbase + ch_ * 8192); kA_[1] = *(const bf16x8*)(kbase + ch_ * 8192 + 32); \
        egl_ = EGL_[ch_ + vz]; } while (0)
#define DNB_STEP(cc, xA_, kA_, uC_, egl_) do { const size_t chs_ = (size_t)b * 512 + (cc) * 4 + h; \
        { u32x2 w; w.x = pk2(accS[0], accS[1]); w.y = pk2(accS[2], accS[3]); *(u32x2*)(scbase + chs_ * 16384) = w; }     \
        if (lo) { f32x4 accX = {0.f, 0.f, 0.f, 0.f}; \
            _Pragma("unroll") for (int k4 = 0; k4 < 4; ++k4) { const bf16x8 sB = *(const bf16x8*)(Sb + m16 * 136 + k4 * 32 + q4 * 8); accX = mfma16(xA_[k4], sB, accX); } \
            u32x2 w; w.x = pk2(bflo(uC_.x) - accX[0], bfhi(uC_.x) - accX[1]); w.y = pk2(bflo(uC_.y) - accX[2], bfhi(uC_.y) - accX[3]); \
            *(u32x2*)(Vn + m16 * 72 + wave * 16 + q4 * 4) = w; *(u32x2*)(vnbase + chs_ * 8192) = w; } \
        BAR_LDS(); \
        const bf16x8 vB0 = *(const bf16x8*)(Vn + m16 * 72 + q4 * 8), vB1 = *(const bf16x8*)(Vn + m16 * 72 + 32 + q4 * 8); \
        accS = accS * egl_; \
        accS = mfma16(kA_[0], vB0, accS); accS = mfma16(kA_[1], vB1, accS); \
        { u32x2 w; w.x = pk2(accS[0], accS[1]); w.y = pk2(accS[2], accS[3]); *(u32x2*)(Sb + m16 * 136 + wave * 16 + q4 * 4) = w; } \
        BAR_LDS(); } while (0)
    bf16x8 xA[4], kA[2]; u32x2 uA; float eglA;
    bf16x8 xB[4], kB[2]; u32x2 uB; float eglB;
    bf16x8 xC[4], kC[2]; u32x2 uC; float eglC;
    bf16x8 xD[4], kD[2]; u32x2 uD; float eglD;
    uA = uB = uC = uD = (u32x2){0u, 0u};
#pragma unroll
    for (int k4 = 0; k4 < 4; ++k4) xA[k4] = xB[k4] = xC[k4] = xD[k4] = (bf16x8){0, 0, 0, 0, 0, 0, 0, 0};
    DNB_LOAD(0, xA, kA, uA, eglA); DNB_LOAD(1, xB, kB, uB, eglB); DNB_LOAD(2, xC, kC, uC, eglC);
#pragma unroll 1
    for (int c = 0; c < 128; c += 4) {
        DNB_LOAD(c + 3, xD, kD, uD, eglD);
        DNB_STEP(c, xA, kA, uA, eglA);
        DNB_LOAD(c + 4, xA, kA, uA, eglA);
        DNB_STEP(c + 1, xB, kB, uB, eglB);
        DNB_LOAD(c + 5, xB, kB, uB, eglB);
        DNB_STEP(c + 2, xC, kC, uC, eglC);
        DNB_LOAD(c + 6, xC, kC, uC, eglC);
        DNB_STEP(c + 3, xD, kD, uD, eglD);
    }
#undef DNB_LOAD
#undef DNB_STEP
    {
        float* sp = state_out + ((size_t)(b * 4 + h) * 128 + wave * 16 + q4 * 4) * 128 + e0 + m16;
#pragma unroll
        for (int i = 0; i < 4; ++i) sp[i * 128] = accS[i];
    }
    __syncthreads();
}

__device__ __forceinline__ void dn_stepC(int tid, int unit, unsigned char* lds, const bf16* __restrict__ PROJ, const bf16* __restrict__ QE_, const bf16* __restrict__ AT_, const bf16* __restrict__ SC_, const bf16* __restrict__ VN_,
                                         const float* dn_norm, bf16* __restrict__ MIX) {
    asm volatile("" : "+v"(tid));
    const int lane = tid & 63, wave = tid >> 6, m16 = lane & 15, q4 = lane >> 4;
    const int h = unit & 3, c = (unit >> 2) & 127, b = unit >> 9;
    const size_t row0 = (size_t)b * SEQ + c * 64; const size_t ch = (size_t)unit;
    float* red = (float*)lds;
    bf16x8 scF[4], vnF[2], qeF[4][4], atF[4][2]; u32x2 zg[4];
#pragma unroll
    for (int k4 = 0; k4 < 4; ++k4) scF[k4] = *(const bf16x8*)(SC_ + ch * 16384 + (wave * 16 + m16) * 128 + k4 * 32 + q4 * 8);
#pragma unroll
    for (int k2 = 0; k2 < 2; ++k2) vnF[k2] = *(const bf16x8*)(VN_ + ch * 8192 + (wave * 16 + m16) * 64 + k2 * 32 + q4 * 8);
#pragma unroll
    for (int mt = 0; mt < 4; ++mt) {
#pragma unroll
        for (int k4 = 0; k4 < 4; ++k4) qeF[mt][k4] = *(const bf16x8*)(QE_ + ch * 8192 + (mt * 16 + m16) * 128 + k4 * 32 + q4 * 8);
#pragma unroll
        for (int k2 = 0; k2 < 2; ++k2) atF[mt][k2] = *(const bf16x8*)(AT_ + ch * 4096 + (mt * 16 + m16) * 64 + k2 * 32 + q4 * 8);
        zg[mt] = *(const u32x2*)(PROJ + (row0 + mt * 16 + m16) * NPE + 1536 + h * 128 + wave * 16 + q4 * 4);
    }
    f32x4 acc[4];
#pragma unroll
    for (int mt = 0; mt < 4; ++mt) {
        f32x4 a = {0.f, 0.f, 0.f, 0.f};
#pragma unroll
        for (int k4 = 0; k4 < 4; ++k4) a = mfma16(scF[k4], qeF[mt][k4], a);
#pragma unroll
        for (int k2 = 0; k2 < 2; ++k2) a = mfma16(vnF[k2], atF[mt][k2], a);
        acc[mt] = a;
        float ss = (a[0] * a[0] + a[1] * a[1]) + (a[2] * a[2] + a[3] * a[3]);
        ss += __shfl_xor(ss, 16); ss += __shfl_xor(ss, 32);
        if (q4 == 0) red[wave * 64 + mt * 16 + m16] = ss;
    }
    __syncthreads();
    const f32x4 gn = *(const f32x4*)(dn_norm + wave * 16 + q4 * 4);
#pragma unroll
    for (int mt = 0; mt < 4; ++mt) {
        const int t = mt * 16 + m16; float tot = 0.f;
#pragma unroll
        for (int w = 0; w < 8; ++w) tot += red[w * 64 + t];
        const float rstd = rsqrtf(tot * (1.f / 128.f) + EPS);
        const f32x4 a = acc[mt]; const u32x2 z = zg[mt];
        u32x2 w; w.x = pk2(a[0] * rstd * gn[0] * siluf(bflo(z.x)), a[1] * rstd * gn[1] * siluf(bfhi(z.x)));
        w.y = pk2(a[2] * rstd * gn[2] * siluf(bflo(z.y)), a[3] * rstd * gn[3] * siluf(bfhi(z.y)));
        *(u32x2*)(MIX + (row0 + t) * DM + h * 128 + wave * 16 + q4 * 4) = w;
    }
    __syncthreads();
}

__device__ __forceinline__ void swa_prompt(int tid, int unit, unsigned char* lds, const bf16* PROJ, const float* sinks, bf16* MIX) {
    asm volatile("" : "+v"(tid));
    const int lane = tid & 63, wave = tid >> 6, m16 = lane & 15, q4 = lane >> 4;
    const int qb = unit & 63, kvh = (unit >> 6) & 1, b = unit >> 7;
    const int p0 = qb * 128; const size_t rowb = (size_t)b * SEQ;
    bf16* Ks = (bf16*)lds;
    bf16* VsT = (bf16*)(lds + 39168);
    bf16* Pw = (bf16*)(lds + 75008 + wave * 5376);
    for (int i = 0; i < 4; ++i) {
        const int item = i * 512 + tid, key = item >> 3, dg = item & 7; const int pos = p0 - 128 + key;
        u32x4 kw = {0u, 0u, 0u, 0u}, vw = {0u, 0u, 0u, 0u};
        if (pos >= 0) { const bf16* pr = PROJ + (rowb + pos) * NPE + kvh * 64 + dg * 8; kw = *(const u32x4*)(pr + 2568); vw = *(const u32x4*)(pr + 2696); }
        *(u32x4*)(Ks + key * 72 + dg * 8) = kw;
        VsT[(dg * 8 + 0) * 280 + key] = (bf16)(vw.x & 0xffff); VsT[(dg * 8 + 1) * 280 + key] = (bf16)(vw.x >> 16);
        VsT[(dg * 8 + 2) * 280 + key] = (bf16)(vw.y & 0xffff); VsT[(dg * 8 + 3) * 280 + key] = (bf16)(vw.y >> 16);
        VsT[(dg * 8 + 4) * 280 + key] = (bf16)(vw.z & 0xffff); VsT[(dg * 8 + 5) * 280 + key] = (bf16)(vw.z >> 16);
        VsT[(dg * 8 + 6) * 280 + key] = (bf16)(vw.w & 0xffff); VsT[(dg * 8 + 7) * 280 + key] = (bf16)(vw.w >> 16);
    }
    { unsigned zz = 0u; asm volatile("" : "+v"(zz));
      if (tid < 128) { const int key = 256 + (tid >> 3), dg = tid & 7; *(u32x4*)(Ks + key * 72 + dg * 8) = (u32x4){zz, zz, zz, zz}; } }
    for (int i = tid; i < 64 * 24; i += 512) { const int d = i / 24, kk = 256 + i % 24; VsT[d * 280 + kk] = 0; }
    __syncthreads();
    const int g = wave >> 1, half = wave & 1, head = kvh * 4 + g;
    const float slope = exp2f(-(float)(head + 1)), sink = sinks[head];
#pragma unroll 1
    for (int mt4 = 0; mt4 < 4; ++mt4) {
        const int q0 = half * 64 + mt4 * 16;
        const bf16* qp = PROJ + (rowb + p0 + q0 + m16) * NPE + 2056 + head * 64 + q4 * 8;
        const bf16x8 qA0 = *(const bf16x8*)(qp), qA1 = *(const bf16x8*)(qp + 32);
        float sc[10][4];
#pragma unroll
        for (int kt = 0; kt < 10; ++kt) {
            const int j0 = q0 + kt * 16;
            const bf16x8 kB0 = *(const bf16x8*)(Ks + (j0 + m16) * 72 + q4 * 8), kB1 = *(const bf16x8*)(Ks + (j0 + m16) * 72 + 32 + q4 * 8);
            f32x4 acc = {0.f, 0.f, 0.f, 0.f};
            acc = mfma16(qA0, kB0, acc); acc = mfma16(qA1, kB1, acc);
            const int j = j0 + m16; const int pos = p0 - 128 + j;
#pragma unroll
            for (int i = 0; i < 4; ++i) { const int rel = q0 + q4 * 4 + i + 128 - j; const bool valid = rel >= 0 && rel < 128 && pos >= 0;
                sc[kt][i] = valid ? acc[i] * 0.125f - slope * (float)rel : -1e30f; }
        }
        float inv[4], mx[4];
#pragma unroll
        for (int i = 0; i < 4; ++i) {
            float m = sc[0][i];
#pragma unroll
            for (int kt = 1; kt < 10; ++kt) m = fmaxf(m, sc[kt][i]);
            m = fmaxf(max16(m), sink); mx[i] = m;
            float s = 0.f;
#pragma unroll
            for (int kt = 0; kt < 10; ++kt) { sc[kt][i] = __expf(sc[kt][i] - m); s += sc[kt][i]; }
            s = sum16(s) + __expf(sink - m);
            inv[i] = __builtin_amdgcn_rcpf(s);
        }
#pragma unroll
        for (int kt = 0; kt < 10; ++kt)
#pragma unroll
            for (int i = 0; i < 4; ++i) Pw[(q4 * 4 + i) * 168 + kt * 16 + m16] = (bf16)f2bf(sc[kt][i] * inv[i]);
        LDSWAIT();
        bf16x8 pA[5];
#pragma unroll
        for (int k5 = 0; k5 < 5; ++k5) pA[k5] = *(const bf16x8*)(Pw + m16 * 168 + k5 * 32 + q4 * 8);
#pragma unroll
        for (int nt = 0; nt < 4; ++nt) {
            f32x4 acc = {0.f, 0.f, 0.f, 0.f};
#pragma unroll
            for (int k5 = 0; k5 < 5; ++k5) { const bf16x8 vB = *(const bf16x8*)(VsT + (nt * 16 + m16) * 280 + q0 + k5 * 32 + q4 * 8); acc = mfma16(vB, pA[k5], acc); }
            u32x2 w; w.x = pk2(acc[0], acc[1]); w.y = pk2(acc[2], acc[3]);
            *(u32x2*)(MIX + (rowb + p0 + q0 + m16) * DM + 512 + head * 64 + nt * 16 + q4 * 4) = w;
        }
        LDSWAIT();
    }
    __syncthreads();
}

__device__ __forceinline__ void sample_even(int tid, int s, int el, unsigned char* lds, const bf16* PROJ, const float* state_dn, const float* state_conv, const float* cache_k, const float* cache_v,
                                            const float* conv_w, const float* a_log, const float* dt_bias, const float* dn_norm, const float* sinks, bf16* MIX, float* out) {
    asm volatile("" : "+v"(tid));
    const int lane = tid & 63, wave = tid >> 6;
    const size_t row = (size_t)MPR + s; const bf16* pr = PROJ + row * NPE;
    float* cv = (float*)lds;
    float* gsm = cv + 1536;
    float* red = gsm + 16;
    float* qsw = red + 16;
    float* knew = qsw + 512;
    float* vnew = knew + 128;
    float* scs = vnew + 128;
    {
        const float* cb = state_conv + ((size_t)el * MSA + s) * 3 * 1536;
        float* ob = out + O_SCONV + ((size_t)el * MSA + s) * 3 * 1536;
#pragma unroll
        for (int r = 0; r < 3; ++r) {
            const int chn = tid + r * 512;
            const float x3 = bf2f(pr[chn]), b0 = cb[chn], b1 = cb[1536 + chn], b2 = cb[3072 + chn];
            const float v = b0 * conv_w[chn] + b1 * conv_w[1536 + chn] + b2 * conv_w[3072 + chn] + x3 * conv_w[4608 + chn];
            cv[chn] = siluf(v);
            ob[chn] = b1; ob[1536 + chn] = b2; ob[3072 + chn] = x3;
        }
        qsw[tid] = bf2f(pr[2056 + tid]);
        if (tid < 128) { knew[tid] = bf2f(pr[2568 + tid]); vnew[tid] = bf2f(pr[2696 + tid]); }
        if (tid < 4) {
            const float a = bf2f(pr[2048 + tid]), bb = bf2f(pr[2052 + tid]);
            const float x = a + dt_bias[tid]; const float sp = x > 20.f ? x : __logf(1.f + __expf(x));
            gsm[tid] = __expf(-__expf(a_log[tid]) * sp); gsm[4 + tid] = __builtin_amdgcn_rcpf(1.f + __expf(-bb));
        }
    }
    __syncthreads();
    {
        const float a = cv[wave * 128 + lane], bq = cv[wave * 128 + 64 + lane];
        const float ss = wave_sum(a * a + bq * bq);
        const float sc = rsqrtf(ss + EPS) * (wave < 4 ? 0.08838834764831845f : 1.f);
        cv[wave * 128 + lane] = a * sc; cv[wave * 128 + 64 + lane] = bq * sc;
    }
    __syncthreads();
    if (wave < 4) { const float v = cv[wave * 128 + lane] * cv[512 + wave * 128 + lane] + cv[wave * 128 + 64 + lane] * cv[512 + wave * 128 + 64 + lane]; const float t_ = wave_sum(v); if (lane == 0) gsm[8 + wave] = t_; }
    __syncthreads();
#pragma unroll 1
    for (int p = 0; p < 2; ++p) {
        const int hl = tid >> 8, h = p * 2 + hl, dg = (tid >> 5) & 7, e4 = (tid & 31) * 4;
        const float* __restrict__ S = state_dn + (((size_t)el * MSA + s) * 4 + h) * 16384 + (size_t)(dg * 16) * 128 + e4;
        float* __restrict__ So = out + O_SDN + (((size_t)el * MSA + s) * 4 + h) * 16384 + (size_t)(dg * 16) * 128 + e4;
        const float* qh = cv + h * 128 + dg * 16; const float* kh = cv + 512 + h * 128 + dg * 16;
        float* part = vnew + 128 + 1024;
        f32x4 sv[16];
#pragma unroll
        for (int d = 0; d < 16; ++d) sv[d] = *(const f32x4*)(S + d * 128);
        f32x4 r = {0.f, 0.f, 0.f, 0.f}, qS = {0.f, 0.f, 0.f, 0.f};
#pragma unroll
        for (int d = 0; d < 16; ++d) { r += sv[d] * kh[d]; qS += sv[d] * qh[d]; }
        *(f32x4*)(part + ((hl * 8 + dg) * 128 + e4) * 2) = r; *(f32x4*)(part + ((hl * 8 + dg) * 128 + e4) * 2 + 4) = qS;
        __syncthreads();
        f32x4 rt = {0.f, 0.f, 0.f, 0.f}, qt = {0.f, 0.f, 0.f, 0.f};
#pragma unroll
        for (int g2 = 0; g2 < 8; ++g2) { rt += *(const f32x4*)(part + ((hl * 8 + g2) * 128 + e4) * 2); qt += *(const f32x4*)(part + ((hl * 8 + g2) * 128 + e4) * 2 + 4); }
        const float eg = gsm[h], beta = gsm[4 + h], qk = gsm[8 + h];
        const f32x4 vv4 = *(const f32x4*)(cv + 1024 + h * 128 + e4);
        const f32x4 vn = (vv4 - rt * eg) * beta;
        const f32x4 o = qt * eg + vn * qk;
#pragma unroll
        for (int d = 0; d < 16; ++d) *(f32x4*)(So + d * 128) = sv[d] * eg + vn * kh[d];
        float ss = (o.x * o.x + o.y * o.y) + (o.z * o.z + o.w * o.w);
        ss += __shfl_xor(ss, 1); ss += __shfl_xor(ss, 2); ss += __shfl_xor(ss, 4); ss += __shfl_xor(ss, 8); ss += __shfl_xor(ss, 16);
        const float rstd = rsqrtf(ss * (1.f / 128.f) + EPS);
        if (dg == 0) {
            const u32x2 zw = *(const u32x2*)(pr + 1536 + h * 128 + e4);
            const f32x4 nn = *(const f32x4*)(dn_norm + e4);
            u32x2 w; w.x = pk2(o.x * rstd * nn.x * siluf(bflo(zw.x)), o.y * rstd * nn.y * siluf(bfhi(zw.x)));
            w.y = pk2(o.z * rstd * nn.z * siluf(bflo(zw.y)), o.w * rstd * nn.w * siluf(bfhi(zw.y)));
            *(u32x2*)(MIX + row * DM + h * 128 + e4) = w;
        }
        __syncthreads();
    }
    {
        const float* ck = cache_k + ((size_t)el * MSA + s) * 16384; const float* cvv = cache_v + ((size_t)el * MSA + s) * 16384;
        const int head = tid >> 6, jj = tid & 63, kvh = head >> 2;
        const float slope = exp2f(-(float)(head + 1)); const float c125 = opq(0.125f);
#pragma unroll
        for (int r = 0; r < 2; ++r) {
            const int ci = jj + r * 64;
            float dot = 0.f;
            if (ci < 127) { const float* kp = ck + (ci + 1) * 128 + kvh * 64;
#pragma unroll
                for (int d4 = 0; d4 < 16; ++d4) { const f32x4 kv = *(const f32x4*)(kp + d4 * 4); const float* q = qsw + head * 64 + d4 * 4; dot += kv.x * q[0] + kv.y * q[1] + kv.z * q[2] + kv.w * q[3]; }
            } else {
#pragma unroll
                for (int d = 0; d < 64; ++d) dot += knew[kvh * 64 + d] * qsw[head * 64 + d];
            }
            scs[head * 128 + ci] = dot * c125 - slope * (float)(127 - ci);
        }
        __syncthreads();
        {
            const float sink = sinks[wave];
            const float v0 = scs[wave * 128 + lane], v1 = scs[wave * 128 + 64 + lane];
            const float m = fmaxf(wave_max(fmaxf(v0, v1)), sink);
            const float p0 = __expf(v0 - m), p1 = __expf(v1 - m);
            const float den = wave_sum(p0 + p1) + __expf(sink - m);
            scs[wave * 128 + lane] = p0 / den; scs[wave * 128 + 64 + lane] = p1 / den;
        }
        __syncthreads();
        {
            const int d = tid & 63; float o = 0.f;
#pragma unroll 8
            for (int ci = 0; ci < 127; ++ci) o += scs[head * 128 + ci] * cvv[(ci + 1) * 128 + kvh * 64 + d];
            o += scs[head * 128 + 127] * vnew[kvh * 64 + d];
            MIX[row * DM + 512 + head * 64 + d] = (bf16)f2bf(o);
        }
        float* __restrict__ ok = out + O_SK + ((size_t)el * MSA + s) * 16384; float* __restrict__ ov = out + O_SV + ((size_t)el * MSA + s) * 16384;
        f32x4 ck4[8], cv4[8];
#pragma unroll
        for (int i = 0; i < 8; ++i) { const int i4 = (i * 512 + tid) * 4; const bool past = i4 < 127 * 128;
            ck4[i] = past ? *(const f32x4*)(ck + i4 + 128) : *(const f32x4*)(knew + (i4 & 127));
            cv4[i] = past ? *(const f32x4*)(cvv + i4 + 128) : *(const f32x4*)(vnew + (i4 & 127)); }
#pragma unroll
        for (int i = 0; i < 8; ++i) { const int i4 = (i * 512 + tid) * 4; *(f32x4*)(ok + i4) = ck4[i]; *(f32x4*)(ov + i4) = cv4[i]; }
    }
    __syncthreads();
}
__device__ __forceinline__ void prompt_misc(int tid, int u, int el, const bf16* PROJ, float* out) {
    asm volatile("" : "+v"(tid));
    const int b = u & 1, which = u >> 1;
    float* o = out + (which ? O_PV : O_PK) + ((size_t)el * 2 + b) * 16384;
    for (int i = tid; i < 16384; i += 512) { const int j = i >> 7, rem = i & 127; o[i] = bf2f(PROJ[((size_t)b * SEQ + 8064 + j) * NPE + (which ? 2696 : 2568) + rem]); }
    if (which == 0) { float* oc = out + O_PCONV + ((size_t)el * 2 + b) * 4608;
        for (int i = tid; i < 4608; i += 512) { const int r = i / 1536, chn = i % 1536; oc[i] = bf2f(PROJ[((size_t)b * SEQ + 8189 + r) * NPE + chn]); } }
}

__device__ __forceinline__ void sample_odd(int tid, int s, int ol, unsigned char* lds, const bf16* PROJ, const float* state_gla, const float* Wg, const float* bg, const float* gla_norm, bf16* MIX, float* out) {
    asm volatile("" : "+v"(tid));
    const int lane = tid & 63, wave = tid >> 6;
    const size_t row = (size_t)MPR + s; const bf16* pr = PROJ + row * NPO;
    float* qv = (float*)lds; float* kv = qv + 512; float* egs = kv + 512; float* vv = egs + 512; float* red = vv + 1024;
    {
        float x = bg[tid];
#pragma unroll
        for (int j = 0; j < 16; ++j) x += bf2f(pr[3072 + j]) * Wg[j * 512 + tid];
        const float ls = fminf(x, 0.f) - __logf(1.f + __expf(-fabsf(x)));
        egs[tid] = __expf(ls * (1.f / 16.f));
        qv[tid] = bf2f(pr[tid]) * 0.08838834764831845f; kv[tid] = bf2f(pr[512 + tid]);
        vv[tid] = bf2f(pr[1024 + tid]); vv[tid + 512] = bf2f(pr[1536 + tid]);
    }
    __syncthreads();
    {
        const int h = tid >> 7, dg = (tid >> 6) & 1, e4 = (tid & 63) * 4;
        const float* __restrict__ S = state_gla + (((size_t)ol * MSA + s) * 4 + h) * 32768 + (size_t)(dg * 64) * 256 + e4;
        float* __restrict__ So = out + O_SGLA + (((size_t)ol * MSA + s) * 4 + h) * 32768 + (size_t)(dg * 64) * 256 + e4;
        const f32x4 v4 = *(const f32x4*)(vv + h * 256 + e4);
        const float* kd = kv + h * 128 + dg * 64; const float* ed = egs + h * 128 + dg * 64; const float* qd = qv + h * 128 + dg * 64;
        float* part = red + 16;
        f32x4 o = {0.f, 0.f, 0.f, 0.f};
#pragma unroll 1
        for (int d0 = 0; d0 < 64; d0 += 16) {
            f32x4 sv[16];
#pragma unroll
            for (int d = 0; d < 16; ++d) sv[d] = *(const f32x4*)(S + (d0 + d) * 256);
#pragma unroll
            for (int d = 0; d < 16; ++d) { const f32x4 n = sv[d] * ed[d0 + d] + v4 * kd[d0 + d]; *(f32x4*)(So + (d0 + d) * 256) = n; o += n * qd[d0 + d]; }
        }
        *(f32x4*)(part + (h * 2 + dg) * 256 + e4) = o;
        __syncthreads();
        const f32x4 ot = *(const f32x4*)(part + (h * 2) * 256 + e4) + *(const f32x4*)(part + (h * 2 + 1) * 256 + e4);
        const float ss = wave_sum((ot.x * ot.x + ot.y * ot.y) + (ot.z * ot.z + ot.w * ot.w));
        const float rstd = rsqrtf(ss * (1.f / 256.f) + EPS);
        if (dg == 0) {
            const u32x2 rw = *(const u32x2*)(pr + 2048 + h * 256 + e4);
            const f32x4 nn = *(const f32x4*)(gla_norm + e4);
            u32x2 w; w.x = pk2(ot.x * rstd * nn.x * siluf(bflo(rw.x)), ot.y * rstd * nn.y * siluf(bfhi(rw.x)));
            w.y = pk2(ot.z * rstd * nn.z * siluf(bflo(rw.y)), ot.w * rstd * nn.w * siluf(bfhi(rw.y)));
            *(u32x2*)(MIX + row * DM + h * 256 + e4) = w;
        }
    }
    __syncthreads();
}

__device__ __forceinline__ void gla_stepA(int tid, int unit, unsigned char* lds, const bf16* PROJ, const float* Wg, const float* bg, bf16* US_, bf16* QT_, bf16* OI, float* EGL_) {
    asm volatile("" : "+v"(tid));
    const int lane = tid & 63, wave = tid >> 6, m16 = lane & 15, q4 = lane >> 4;
    const int h = unit & 3, c = (unit >> 2) & 127, b = unit >> 9;
    const size_t row0 = (size_t)b * SEQ + c * 64; const size_t ch = (size_t)unit;
    float* Gs = (float*)lds;
    bf16* qs = (bf16*)(lds + 32768); bf16* ks = (bf16*)(lds + 50176);
    bf16* kT = (bf16*)(lds + 67584);
    bf16* vT = (bf16*)(lds + 86016);
    bf16* as = (bf16*)(lds + 122880);
    float* qt = (float*)(lds + 132096);
    float* gdl = (float*)(lds + 134144);
    u32x4 rq[4], rv[4];
    float wg[16];
    const unsigned short gd0 = PROJ[(row0 + (tid >> 4)) * NPO + 3072 + (tid & 15)], gd1 = PROJ[(row0 + 32 + (tid >> 4)) * NPO + 3072 + (tid & 15)];
#pragma unroll
    for (int j = 0; j < 16; ++j) wg[j] = Wg[j * 512 + h * 128 + (tid & 127)];
#pragma unroll
    for (int i = 0; i < 4; ++i) {
        const int item = i * 512 + tid, part = item >> 10, t = (item >> 4) & 63, cg = item & 15;
        rq[i] = *(const u32x4*)(PROJ + (row0 + t) * NPO + part * 512 + h * 128 + cg * 8);
        const int t2 = item >> 5, eg8 = item & 31;
        rv[i] = *(const u32x4*)(PROJ + (row0 + t2) * NPO + 1024 + h * 256 + eg8 * 8);
    }
    gdl[tid] = bf2f(gd0); gdl[tid + 512] = bf2f(gd1);
    __syncthreads();
    {
        const int d = tid & 127, tq = tid >> 7, col = h * 128 + d;
        const float bgc = bg[col]; float run = 0.f;
        float cum[16];
#pragma unroll
        for (int tt = 0; tt < 16; ++tt) {
            const int t = tq * 16 + tt; float x = bgc;
            const f32x4 gq0 = *(const f32x4*)(gdl + t * 16), gq1 = *(const f32x4*)(gdl + t * 16 + 4), gq2 = *(const f32x4*)(gdl + t * 16 + 8), gq3 = *(const f32x4*)(gdl + t * 16 + 12);
            x += gq0.x * wg[0] + gq0.y * wg[1] + gq0.z * wg[2] + gq0.w * wg[3];
            x += gq1.x * wg[4] + gq1.y * wg[5] + gq1.z * wg[6] + gq1.w * wg[7];
            x += gq2.x * wg[8] + gq2.y * wg[9] + gq2.z * wg[10] + gq2.w * wg[11];
            x += gq3.x * wg[12] + gq3.y * wg[13] + gq3.z * wg[14] + gq3.w * wg[15];
            const float ls = fminf(x, 0.f) - __logf(1.f + __expf(-fabsf(x)));
            run += ls * (1.f / 16.f);
            cum[tt] = run;
        }
        qt[tq * 128 + d] = run;
        __syncthreads();
        float off = 0.f;
#pragma unroll
        for (int q = 0; q < 3; ++q) off += (q < tq) ? qt[q * 128 + d] : 0.f;
#pragma unroll
        for (int tt = 0; tt < 16; ++tt) Gs[(tq * 16 + tt) * 128 + d] = cum[tt] + off;
    }
    __syncthreads();
    {
#pragma unroll
        for (int i = 0; i < 4; ++i) {
            const int item = i * 512 + tid, part = item >> 10, t = (item >> 4) & 63, cg = item & 15;
            float f[8]; unpack8(rq[i], f);
            float o[8];
            const f32x4 g0 = *(const f32x4*)(Gs + t * 128 + cg * 8), g1 = *(const f32x4*)(Gs + t * 128 + cg * 8 + 4), l0 = *(const f32x4*)(Gs + 63 * 128 + cg * 8), l1 = *(const f32x4*)(Gs + 63 * 128 + cg * 8 + 4);
            const float dls[8] = {g0.x - l0.x, g0.y - l0.y, g0.z - l0.z, g0.w - l0.w, g1.x - l1.x, g1.y - l1.y, g1.z - l1.z, g1.w - l1.w};
#pragma unroll
            for (int j = 0; j < 8; ++j) { const float dl = dls[j]; o[j] = part == 0 ? f[j] * 0.08838834764831845f * __expf(dl) : f[j] * __expf(-dl); }
            const u32x4 w = pack8(o);
            if (part == 0) { *(u32x4*)(qs + t * 136 + cg * 8) = w; *(u32x4*)(QT_ + ch * 8192 + t * 128 + cg * 8) = w; }
            else { *(u32x4*)(ks + t * 136 + cg * 8) = w;
#pragma unroll
                for (int j = 0; j < 8; ++j) kT[(cg * 8 + j) * 72 + (((t >> 3) ^ (cg & 7)) << 3) + (t & 7)] = (bf16)f2bf(o[j]); }
        }
#pragma unroll
        for (int i = 0; i < 4; ++i) {
            const int item = i * 512 + tid, t = item >> 5, eg8 = item & 31;
            const u32x4 w = rv[i];
            bf16* vp = vT + (eg8 * 8) * 72 + (((t >> 3) ^ (eg8 & 7)) << 3) + (t & 7);
            vp[0] = (bf16)(w.x & 0xffff); vp[72] = (bf16)(w.x >> 16); vp[144] = (bf16)(w.y & 0xffff); vp[216] = (bf16)(w.y >> 16);
            vp[288] = (bf16)(w.z & 0xffff); vp[360] = (bf16)(w.z >> 16); vp[432] = (bf16)(w.w & 0xffff); vp[504] = (bf16)(w.w >> 16);
        }
    }
    if (tid < 128) EGL_[ch * 128 + tid] = __expf(Gs[63 * 128 + tid]);
    __syncthreads();
    {
        const int mt = wave >> 1;
        bf16x8 aF[4];
#pragma unroll
        for (int k4 = 0; k4 < 4; ++k4) aF[k4] = *(const bf16x8*)(qs + (mt * 16 + m16) * 136 + k4 * 32 + q4 * 8);
#pragma unroll
        for (int n2 = 0; n2 < 2; ++n2) {
            const int nt = (wave & 1) * 2 + n2;
            f32x4 acc = {0.f, 0.f, 0.f, 0.f};
            if (nt <= mt) {
#pragma unroll
                for (int k4 = 0; k4 < 4; ++k4) { const bf16x8 bF = *(const bf16x8*)(ks + (nt * 16 + m16) * 136 + k4 * 32 + q4 * 8); acc = mfma16(aF[k4], bF, acc); }
            }
            const int s = nt * 16 + m16;
#pragma unroll
            for (int i = 0; i < 4; ++i) { const int t = mt * 16 + q4 * 4 + i; as[t * 72 + s] = (bf16)f2bf(t >= s ? acc[i] : 0.f); }
        }
    }
    {
        bf16x8 aF[2];
#pragma unroll
        for (int k2 = 0; k2 < 2; ++k2) { const int rr = wave * 16 + m16; aF[k2] = *(const bf16x8*)(kT + rr * 72 + (((k2 * 4 + q4) ^ ((rr >> 3) & 7)) << 3)); }
#pragma unroll 4
        for (int nt = 0; nt < 16; ++nt) {
            f32x4 acc = {0.f, 0.f, 0.f, 0.f};
#pragma unroll
            for (int k2 = 0; k2 < 2; ++k2) { const int rr = nt * 16 + m16; const bf16x8 bF = *(const bf16x8*)(vT + rr * 72 + (((k2 * 4 + q4) ^ ((rr >> 3) & 7)) << 3)); acc = mfma16(aF[k2], bF, acc); }
            u32x2 w; w.x = pk2(acc[0], acc[1]); w.y = pk2(acc[2], acc[3]);
            *(u32x2*)(US_ + ch * 32768 + (nt * 16 + m16) * 128 + wave * 16 + q4 * 4) = w;
        }
    }
    __syncthreads();
    {
        bf16x8 bF[2][2];
#pragma unroll
        for (int n2 = 0; n2 < 2; ++n2)
#pragma unroll
            for (int k2 = 0; k2 < 2; ++k2) { const int rr = (wave * 2 + n2) * 16 + m16; bF[n2][k2] = *(const bf16x8*)(vT + rr * 72 + (((k2 * 4 + q4) ^ ((rr >> 3) & 7)) << 3)); }
#pragma unroll
        for (int mt = 0; mt < 4; ++mt) {
            bf16x8 aF[2];
#pragma unroll
            for (int k2 = 0; k2 < 2; ++k2) aF[k2] = *(const bf16x8*)(as + (mt * 16 + m16) * 72 + k2 * 32 + q4 * 8);
#pragma unroll
            for (int n2 = 0; n2 < 2; ++n2) {
                f32x4 acc = {0.f, 0.f, 0.f, 0.f};
                acc = mfma16(bF[n2][0], aF[0], acc); acc = mfma16(bF[n2][1], aF[1], acc);
                u32x2 w; w.x = pk2(acc[0], acc[1]); w.y = pk2(acc[2], acc[3]);
                ((u32x2*)OI)[(((ch * 8 + wave) * 4 + mt) * 2 + n2) * 64 + lane] = w;
            }
        }
    }
    __syncthreads();
}

__device__ __forceinline__ void gla_scan(bf16* US_, const float* __restrict__ EGL_, float* __restrict__ state_out, int gtid, int ngt) {
    for (int idx = gtid; idx < 131072; idx += ngt) {
        const int dp = idx & 63, e = (idx >> 6) & 255, bh = idx >> 14, b = bh >> 2, h = bh & 3;
        float s0 = 0.f, s1 = 0.f;
        unsigned* p = (unsigned*)(US_ + ((size_t)b * 512 + h) * 32768 + e * 128 + dp * 2);
        const float* eg = EGL_ + ((size_t)b * 512 + h) * 128 + dp * 2;
        constexpr size_t PS = (size_t)4 * 32768 / 2, GS = (size_t)4 * 128;
        unsigned ua[8], ub[8]; f32x2v ga[8], gb[8];
#define GSC_LOAD(c0, u_, g_) do { _Pragma("unroll") for (int k = 0; k < 8; ++k) { const int cc = (c0) + k < 128 ? (c0) + k : 127; u_[k] = p[cc * PS]; g_[k] = *(const f32x2v*)(eg + cc * GS); } } while (0)
#define GSC_PROC(c0, u_, g_) do { _Pragma("unroll") for (int k = 0; k < 8; ++k) { s0 *= g_[k].x; s1 *= g_[k].y; p[((c0) + k) * PS] = pk2(s0, s1); s0 += bflo(u_[k]); s1 += bfhi(u_[k]); } } while (0)
        GSC_LOAD(0, ua, ga);
#pragma unroll 1
        for (int c0 = 0; c0 < 128; c0 += 16) {
            GSC_LOAD(c0 + 8, ub, gb);
            GSC_PROC(c0, ua, ga);
            GSC_LOAD(c0 + 16, ua, ga);
            GSC_PROC(c0 + 8, ub, gb);
        }
#undef GSC_LOAD
#undef GSC_PROC
        float* so = state_out + ((size_t)(b * 4 + h) * 128 + dp * 2) * 256 + e;
        so[0] = s0; so[256] = s1;
    }
}

__device__ __forceinline__ void gla_stepC(int tid, int unit, unsigned char* lds, const bf16* __restrict__ PROJ, const bf16* __restrict__ US_, const bf16* __restrict__ QT_, const bf16* __restrict__ OI, const float* gla_norm, bf16* __restrict__ MIX) {
    asm volatile("" : "+v"(tid));
    const int lane = tid & 63, wave = tid >> 6, m16 = lane & 15, q4 = lane >> 4;
    const int h = unit & 3, c = (unit >> 2) & 127, b = unit >> 9;
    const size_t row0 = (size_t)b * SEQ + c * 64; const size_t ch = (size_t)unit;
    float* red = (float*)lds;
    bf16x8 sB[2][4], aF[4][4]; u32x2 oi[4][2], rg[4][2];
#pragma unroll
    for (int n2 = 0; n2 < 2; ++n2)
#pragma unroll
        for (int k4 = 0; k4 < 4; ++k4) sB[n2][k4] = *(const bf16x8*)(US_ + ch * 32768 + ((wave * 2 + n2) * 16 + m16) * 128 + k4 * 32 + q4 * 8);
#pragma unroll
    for (int mt = 0; mt < 4; ++mt) {
#pragma unroll
        for (int k4 = 0; k4 < 4; ++k4) aF[mt][k4] = *(const bf16x8*)(QT_ + ch * 8192 + (mt * 16 + m16) * 128 + k4 * 32 + q4 * 8);
#pragma unroll
        for (int n2 = 0; n2 < 2; ++n2) { oi[mt][n2] = ((const u32x2*)OI)[(((ch * 8 + wave) * 4 + mt) * 2 + n2) * 64 + lane];
            rg[mt][n2] = *(const u32x2*)(PROJ + (row0 + mt * 16 + m16) * NPO + 2048 + h * 256 + (wave * 2 + n2) * 16 + q4 * 4); }
    }
    f32x4 acc[4][2];
#pragma unroll
    for (int mt = 0; mt < 4; ++mt) {
        float ss = 0.f;
#pragma unroll
        for (int n2 = 0; n2 < 2; ++n2) {
            f32x4 a = {bflo(oi[mt][n2].x), bfhi(oi[mt][n2].x), bflo(oi[mt][n2].y), bfhi(oi[mt][n2].y)};
#pragma unroll
            for (int k4 = 0; k4 < 4; ++k4) a = mfma16(sB[n2][k4], aF[mt][k4], a);
            acc[mt][n2] = a;
            ss += (a[0] * a[0] + a[1] * a[1]) + (a[2] * a[2] + a[3] * a[3]);
        }
        ss += __shfl_xor(ss, 16); ss += __shfl_xor(ss, 32);
        if (q4 == 0) red[wave * 64 + mt * 16 + m16] = ss;
    }
    __syncthreads();
    f32x4 gn[2];
#pragma unroll
    for (int n2 = 0; n2 < 2; ++n2) gn[n2] = *(const f32x4*)(gla_norm + (wave * 2 + n2) * 16 + q4 * 4);
#pragma unroll
    for (int mt = 0; mt < 4; ++mt) {
        const int t = mt * 16 + m16; float tot = 0.f;
#pragma unroll
        for (int w = 0; w < 8; ++w) tot += red[w * 64 + t];
        const float rstd = rsqrtf(tot * (1.f / 256.f) + EPS);
#pragma unroll
        for (int n2 = 0; n2 < 2; ++n2) {
            const f32x4 a = acc[mt][n2]; const u32x2 r = rg[mt][n2];
            u32x2 w; w.x = pk2(a[0] * rstd * gn[n2][0] * siluf(bflo(r.x)), a[1] * rstd * gn[n2][1] * siluf(bfhi(r.x)));
            w.y = pk2(a[2] * rstd * gn[n2][2] * siluf(bflo(r.y)), a[3] * rstd * gn[n2][3] * siluf(bfhi(r.y)));
            *(u32x2*)(MIX + (row0 + t) * DM + h * 256 + (wave * 2 + n2) * 16 + q4 * 4) = w;
        }
    }
    __syncthreads();
}

template <int MODE>
__device__ __forceinline__ void skinny_unit(int tid, const bf16* A, const bf16* Bt, int K, int ld, size_t row0, int col0, void* C, int ldc, float sgn = 1.f) {
    asm volatile("" : "+v"(tid));
    const int lane = tid & 63, wave = tid >> 6, m16 = lane & 15, q4 = lane >> 4;
    const bf16* ap = A + (row0 + wave * 16 + m16) * ld + q4 * 8;
    const bf16* bp = Bt + (size_t)(col0 + m16) * ld + q4 * 8;
    f32x4 acc0 = {0.f, 0.f, 0.f, 0.f}, acc1 = {0.f, 0.f, 0.f, 0.f};
#pragma unroll 1
    for (int k = 0; k < K; k += 256) {
        bf16x8 av[8], bv[8];
#pragma unroll
        for (int j = 0; j < 8; ++j) { av[j] = *(const bf16x8*)(ap + k + j * 32); bv[j] = *(const bf16x8*)(bp + k + j * 32); }
#pragma unroll
        for (int j = 0; j < 8; j += 2) { acc0 = mfma16(av[j], bv[j], acc0); acc1 = mfma16(av[j + 1], bv[j + 1], acc1); }
    }
    const f32x4 acc = acc0 + acc1;
    const size_t r = row0 + wave * 16 + q4 * 4; const int c = col0 + m16;
#pragma unroll
    for (int i = 0; i < 4; ++i) {
        if (MODE == 3) { atomicAdd((float*)C + (r + i) * ldc + c, acc[i] * sgn); }
        else { float v = acc[i]; if (MODE == 2) { v = v > 0.f ? v : 0.f; v = v * v; } ((bf16*)C)[(r + i) * ldc + c] = (bf16)f2bf(v); }
    }
}

__device__ __forceinline__ void skinny_res(int tid, int unit, unsigned char* lds, const bf16* __restrict__ A, const bf16* __restrict__ Bt, int K, float* __restrict__ X) {
    asm volatile("" : "+v"(tid));
    const int lane = tid & 63, wave = tid >> 6, m16 = lane & 15, q4 = lane >> 4;
    const int rg = unit >> 6, ct = unit & 63, rt = wave & 1, ksl = wave >> 1, Ks = K >> 2;
    const bf16* ap = A + ((size_t)MPR + rg * 32 + rt * 16 + m16) * K + ksl * Ks + q4 * 8;
    const bf16* bp = Bt + (size_t)(ct * 16 + m16) * K + ksl * Ks + q4 * 8;
    f32x4 acc0 = {0.f, 0.f, 0.f, 0.f}, acc1 = {0.f, 0.f, 0.f, 0.f};
#pragma unroll 1
    for (int k = 0; k < Ks; k += 256) {
        bf16x8 av[8], bv[8];
#pragma unroll
        for (int j = 0; j < 8; ++j) { av[j] = *(const bf16x8*)(ap + k + j * 32); bv[j] = *(const bf16x8*)(bp + k + j * 32); }
#pragma unroll
        for (int j = 0; j < 8; j += 2) { acc0 = mfma16(av[j], bv[j], acc0); acc1 = mfma16(av[j + 1], bv[j + 1], acc1); }
    }
    f32x4* red = (f32x4*)lds;
    red[wave * 64 + lane] = acc0 + acc1;
    __syncthreads();
    if (ksl == 0) {
        const f32x4 t = (red[rt * 64 + lane] + red[(2 + rt) * 64 + lane]) + (red[(4 + rt) * 64 + lane] + red[(6 + rt) * 64 + lane]);
        float* xp = X + ((size_t)MPR + rg * 32 + rt * 16 + q4 * 4) * DM + ct * 16 + m16;
#pragma unroll
        for (int i = 0; i < 4; ++i) xp[i * DM] += t[i];
    }
    __syncthreads();
}

#define LAS __attribute__((address_space(3)))
#define XB_TMO      128
#define XB_XCNT(j)  (256  + 64 * (j))
#define XB_XSUB(j)  (1280 + 64 * (j))
#define XB_XGEN(j)  (2304 + 64 * (j))
#define XB_TOP      3328
#define XB_TOPGEN   3392
#define XCD_BAR_WORDS 3456
#define XB_SPIN_CAP (1u << 18)

__device__ __forceinline__ unsigned xb_ld(unsigned* p)              { return __hip_atomic_load(p, __ATOMIC_RELAXED, __HIP_MEMORY_SCOPE_AGENT); }
__device__ __forceinline__ unsigned xb_add(unsigned* p, unsigned v) { return __hip_atomic_fetch_add(p, v, __ATOMIC_RELAXED, __HIP_MEMORY_SCOPE_AGENT); }
__device__ __forceinline__ unsigned xb_xcc_id() { return (unsigned)__builtin_amdgcn_s_getreg((3 << 11) | 20) & 0xFu; }
#define XB_SPIN(cond, bar) do { unsigned _sp = 0; while (cond) { __builtin_amdgcn_s_sleep(1); \
    if ((++_sp & 255u) == 0u) { if (xb_ld(&(bar)[XB_TMO])) break; if (_sp > XB_SPIN_CAP) { atomicAdd(&(bar)[XB_TMO], 1u); break; } } } } while (0)

struct XcdBarrier {
    unsigned* bar; unsigned x;
    volatile LAS unsigned* st;
};

__device__ __forceinline__ XcdBarrier xcd_barrier_post(unsigned* bar, volatile LAS unsigned* st) {
    XcdBarrier b; b.bar = bar; b.x = xb_xcc_id(); b.st = st;
    if (threadIdx.x == 0) (void)xb_add(&bar[XB_XCNT(b.x)], 1u);
    return b;
}
__device__ __forceinline__ void xcd_barrier_complete(unsigned* bar, unsigned x, unsigned& nloc, unsigned& nx) {
    const unsigned G = gridDim.x * gridDim.y * gridDim.z;
    unsigned sum, cnt, mine, sp = 0u;
    for (;;) {
        sum = 0u; cnt = 0u; mine = 0u;
#pragma unroll
        for (unsigned j = 0; j < 16; ++j) { const unsigned c = xb_ld(&bar[XB_XCNT(j)]); sum += c; cnt += (c > 0u) ? 1u : 0u; mine = (j == x) ? c : mine; }
        if (sum == G) break;
        __builtin_amdgcn_s_sleep(1);
        if ((++sp & 255u) == 0u) { if (xb_ld(&bar[XB_TMO])) break; if (sp > XB_SPIN_CAP) { atomicAdd(&bar[XB_TMO], 1u); break; } }
    }
    nloc = mine > 0u ? mine : 1u; nx = cnt > 0u ? cnt : 1u;
}

__device__ __forceinline__ void xcd_barrier(const XcdBarrier& b) {
    asm volatile("s_waitcnt vmcnt(0)" ::: "memory");
    __syncthreads();
    if (threadIdx.x == 0) {
        unsigned* bar = b.bar;
        __builtin_amdgcn_s_waitcnt(0);
        unsigned nloc = b.st[0], nx = b.st[1];
        if (nloc == 0u) { xcd_barrier_complete(bar, b.x, nloc, nx); b.st[0] = nloc; b.st[1] = nx; }
        const unsigned old = xb_add(&bar[XB_XSUB(b.x)], 1u);
        const unsigned gen = old / nloc;
        if (old + 1u == (gen + 1u) * nloc) {
            __builtin_amdgcn_fence(__ATOMIC_RELEASE, "agent");
            asm volatile("s_waitcnt vmcnt(0)" ::: "memory");
            const unsigned og = xb_add(&bar[XB_TOP], 1u);
            const unsigned tg = og / nx;
            if (og + 1u == (tg + 1u) * nx) xb_add(&bar[XB_TOPGEN], 1u);
            else XB_SPIN(xb_ld(&bar[XB_TOPGEN]) == tg, bar);
            __builtin_amdgcn_fence(__ATOMIC_ACQUIRE, "agent");
            xb_add(&bar[XB_XGEN(b.x)], 1u);
            asm volatile("s_waitcnt vmcnt(0)" ::: "memory");
        } else {
            XB_SPIN(xb_ld(&bar[XB_XGEN(b.x)]) == gen, bar);
            __builtin_amdgcn_fence(__ATOMIC_ACQUIRE, "agent");
            asm volatile("s_waitcnt vmcnt(0)" ::: "memory");
        }
    }
    __syncthreads();
}

#ifndef PROBE_ID
#define PROBE_ID 0
#endif
constexpr size_t WS_TAB = 4096, WS_BAR = 16384;
constexpr int LDS_BARW = 147392;
__global__ void __launch_bounds__(512, 2) mega_fwd(Args a) {
    extern __shared__ __attribute__((aligned(16))) unsigned char lds[];
    const bool coop = (a.ph_hi - a.ph_lo) > 1;
    if (threadIdx.x < 4) ((LAS unsigned*)((LAS unsigned char*)lds + LDS_BARW))[threadIdx.x] = 0u;
    __syncthreads();
    XcdBarrier xbar; xbar.bar = (unsigned*)(a.ws + WS_BAR); xbar.x = 0; xbar.st = nullptr;
    if (coop) xbar = xcd_barrier_post((unsigned*)(a.ws + WS_BAR), (volatile LAS unsigned*)((LAS unsigned char*)lds + LDS_BARW));
#if PROBE_ID
    bool repeated = false; int repcnt = 0; unsigned donemask = 0u;
#endif
#pragma unroll 1
    for (int ph = a.ph_lo; ph < a.ph_hi; ++ph) {
        int tid = threadIdx.x; asm volatile("" : "+v"(tid));
        int bid = blockIdx.x; asm volatile("" : "+s"(bid));
        unsigned char* ws = a.ws; asm volatile("" : "+s"(ws));
        float* outp = a.out; asm volatile("" : "+s"(outp));
        const int lane = tid & 63, wave = tid >> 6;
        const int G = gridDim.x;
        const int gw = bid * 8 + wave, ngw = G * 8;
        bf16* WEI = (bf16*)(ws + WS_WEI); bf16* WEO = (bf16*)(ws + WS_WEO); bf16* WGI = (bf16*)(ws + WS_WGI); bf16* WGO = (bf16*)(ws + WS_WGO);
        bf16* WUP = (bf16*)(ws + WS_WUP); bf16* WDN = (bf16*)(ws + WS_WDN);
        float* X = (float*)(ws + WS_X); bf16* HB = (bf16*)(ws + WS_HB); bf16* MIX = (bf16*)(ws + WS_MIX);
        bf16* PROJ = (bf16*)(ws + WS_BIG); bf16* HID = (bf16*)(ws + WS_BIG);
        const float* const* in = (const float* const*)(ws + WS_TAB);
        if (ph == 0) {
            if (bid == 0 && tid == 0) { const float** tw = (const float**)(ws + WS_TAB);
#pragma unroll
                for (int k = 0; k < 24; ++k) tw[k] = a.in[k]; }
            float* scr = (float*)(lds + wave * 16640);
            transpose_w(a.in[10], DM, NE_IN, NPE, WEI, scr, gw, ngw, lane);
            transpose_w(a.in[16], DM, DM, DM, WEO, scr, gw, ngw, lane);
            transpose_w(a.in[22], DM, FF, FF, WUP, scr, gw, ngw, lane);
            transpose_w(a.in[23], FF, DM, DM, WDN, scr, gw, ngw, lane);
            for (int m = gw; m < MPAD; m += ngw) {
                f32x4 v[4];
                const float* src = m < MPR ? a.in[0] + (size_t)m * DM : (m < MREAL ? a.in[1] + (size_t)(m - MPR) * DM : nullptr);
#pragma unroll
                for (int j = 0; j < 4; ++j) { v[j] = src ? *(const f32x4*)(src + 4 * lane + 256 * j) : (f32x4){0.f, 0.f, 0.f, 0.f}; if (m >= MPR) *(f32x4*)(X + (size_t)m * DM + 4 * lane + 256 * j) = v[j]; }
                norm_row(v, a.in[7], HB + (size_t)m * DM, nullptr, lane);
                if (m >= MREAL) {
#pragma unroll
                    for (int j = 0; j < 4; ++j) { u32x2 z = {0u, 0u}; *(u32x2*)(MIX + (size_t)m * DM + 4 * lane + 256 * j) = z; }
                }
            }
        } else {
            const int l = (ph - 1) / 9, sp = (ph - 1) % 9, even = !(l & 1), li = l >> 1;
            if (sp == 0) {
                const bf16* Bt = even ? WEI + (size_t)li * NPE * DM : WGI + (size_t)li * NPO * DM; const int ldp = even ? NPE : NPO;
                pg8::Gemm g{HB, Bt, MPR, 3072, DM};
                pg8::StaticOrder S; S.init(g.M, g.N, G, bid);
                pg8::EpiBf16<0> E{PROJ, ldp};
                pg8::gemm_phase<pg8::EpiBf16<0>, pg8::StaticOrder, true, true>((PG8_LAS unsigned char*)lds, g, S, E);
                const int nts = even ? 177 : 193, nsk = even ? nts : nts + 128;
                for (int u = bid; u < nsk; u += G) {
                    if (u < nts) skinny_unit<0>(tid, HB, Bt, DM, DM, (size_t)MPR, u * 16, PROJ, ldp);
                    else skinny_unit<0>(tid, HB, Bt, DM, DM, (size_t)(u - nts) * 128, 3072, PROJ, ldp);
                }
            } else if (sp == 1) {
                if (even) {
                    const float* cw = in[11] + (size_t)li * 4 * 1536; const float* al = in[12] + li * 4; const float* dtb = in[13] + li * 4;
                    for (int u = bid; u < 1024; u += G)
                        dn_stepA(tid, u, lds, PROJ, cw, al, dtb,
                                 (bf16*)(ws + SC_DN_W), (bf16*)(ws + SC_DN_QE), (bf16*)(ws + SC_DN_KT), (bf16*)(ws + SC_DN_AT), (bf16*)(ws + SC_DN_U), (float*)(ws + SC_DN_EGL));
                } else {
                    const float* wg = in[18] + (size_t)li * 16 * 512; const float* bgp = in[19] + li * 512;
                    for (int u = bid; u < 1024; u += G)
                        gla_stepA(tid, u, lds, PROJ, wg, bgp, (bf16*)(ws + SC_GL_US), (bf16*)(ws + SC_GL_QT), (bf16*)(ws + SC_GL_OI), (float*)(ws + SC_GL_EGL));
                }
            } else if (sp == 2) {
                if (even) {
                    const int nb = G > 64 ? 64 : G;
#if PROBE_ID == 12
                    if (!repeated)
#endif
                    if (bid < nb) { for (int it = bid; it < 64; it += nb)
                        dn_stepB(tid, it, lds, (const bf16*)(ws + SC_DN_W), (const bf16*)(ws + SC_DN_KT), (const bf16*)(ws + SC_DN_U),
                                 (const float*)(ws + SC_DN_EGL), (bf16*)(ws + SC_DN_O), (bf16*)(ws + SC_DN_VN), outp + O_PDN + (size_t)li * 2 * 4 * 16384); }
                    const int ob = G > 64 ? bid - 64 : bid, on = G > 64 ? G - 64 : G;
#if PROBE_ID == 11
                    if (!repeated)
#endif
                    if (ob >= 0) {
                        const float* sdn = in[2]; const float* scv = in[3]; const float* ckp = in[4]; const float* cvp = in[5];
                        const float* cw = in[11] + (size_t)li * 4 * 1536; const float* al = in[12] + li * 4; const float* dtb = in[13] + li * 4;
                        const float* dnn = in[14] + li * 128; const float* snk = in[15] + li * 8;
                        for (int u = ob; u < 256 + MSA + 4; u += on) {
                            if (u < 256) swa_prompt(tid, u, lds, PROJ, snk, MIX);
                            else if (u < 256 + MSA) sample_even(tid, u - 256, li, lds, PROJ, sdn, scv, ckp, cvp, cw, al, dtb, dnn, snk, MIX, outp);
                            else prompt_misc(tid, u - 256 - MSA, li, PROJ, outp);
                        }
                        if (l == 0) {
                            float* scr = (float*)(lds + wave * 16640);
                            const int gw2 = ob * 8 + wave, ngw2 = on * 8;
                            transpose_w(in[17], DM, NO_IN, NPO, WGI, scr, gw2, ngw2, lane);
                            transpose_w(in[21], DM, DM, DM, WGO, scr, gw2, ngw2, lane);
                            transpose_w(in[22] + (size_t)1 * DM * FF, DM, FF, FF, WUP + (size_t)1 * FF * DM, scr, gw2, ngw2, lane);
                            transpose_w(in[23] + (size_t)1 * FF * DM, FF, DM, DM, WDN + (size_t)1 * DM * FF, scr, gw2, ngw2, lane);
                            transpose_w(in[10] + (size_t)DM * NE_IN, DM, NE_IN, NPE, WEI + (size_t)NPE * DM, scr, gw2, ngw2, lane);
                            transpose_w(in[16] + (size_t)DM * DM, DM, DM, DM, WEO + (size_t)DM * DM, scr, gw2, ngw2, lane);
                            transpose_w(in[22] + (size_t)2 * DM * FF, DM, FF, FF, WUP + (size_t)2 * FF * DM, scr, gw2, ngw2, lane);
                            transpose_w(in[23] + (size_t)2 * FF * DM, FF, DM, DM, WDN + (size_t)2 * DM * FF, scr, gw2, ngw2, lane);
                            transpose_w(in[17] + (size_t)DM * NO_IN, DM, NO_IN, NPO, WGI + (size_t)NPO * DM, scr, gw2, ngw2, lane);
                            transpose_w(in[21] + (size_t)DM * DM, DM, DM, DM, WGO + (size_t)DM * DM, scr, gw2, ngw2, lane);
                            transpose_w(in[22] + (size_t)3 * DM * FF, DM, FF, FF, WUP + (size_t)3 * FF * DM, scr, gw2, ngw2, lane);
                            transpose_w(in[23] + (size_t)3 * FF * DM, FF, DM, DM, WDN + (size_t)3 * DM * FF, scr, gw2, ngw2, lane);
                            __syncthreads();
                        }
                    }
                } else {
                    const int nsc = G >= 2 ? G / 2 : G;
                    if (bid < nsc) gla_scan((bf16*)(ws + SC_GL_US), (const float*)(ws + SC_GL_EGL), outp + O_PGLA + (size_t)li * 2 * 4 * 32768, bid * 512 + tid, nsc * 512);
                    if (G < 2 || bid >= nsc) {
                        const float* wg = in[18] + (size_t)li * 16 * 512; const float* bgp = in[19] + li * 512; const float* gn = in[20] + li * 256; const float* sg = in[6];
                        const int ob = G >= 2 ? bid - nsc : 0, on = G >= 2 ? G - nsc : 1;
                        for (int u = ob; u < MSA; u += on) sample_odd(tid, u, li, lds, PROJ, sg, wg, bgp, gn, MIX, outp);
                    }
                }
            } else if (sp == 3) {
                if (even) { const float* dnn = in[14] + li * 128;
                    for (int u = bid; u < 1024; u += G) dn_stepC(tid, u, lds, PROJ, (const bf16*)(ws + SC_DN_QE), (const bf16*)(ws + SC_DN_AT), (const bf16*)(ws + SC_DN_O), (const bf16*)(ws + SC_DN_VN), dnn, MIX); }
                else { const float* gn = in[20] + li * 256;
                    for (int u = bid; u < 1024; u += G) gla_stepC(tid, u, lds, PROJ, (const bf16*)(ws + SC_GL_US), (const bf16*)(ws + SC_GL_QT), (const bf16*)(ws + SC_GL_OI), gn, MIX); }
            } else if (sp == 4 || sp == 7) {
                pg8::Gemm g{sp == 4 ? MIX : HID, sp == 4 ? (even ? WEO : WGO) + (size_t)li * DM * DM : WDN + (size_t)l * DM * FF, MPR, DM, sp == 4 ? DM : FF};
                pg8::StaticOrder S; S.init(g.M, g.N, G, bid);
#if PROBE_ID == 13 || PROBE_ID == 14
                const float sgn = (repcnt == 1) ? -1.f : 1.f;
#else
                const float sgn = 1.f;
#endif
                pg8::EpiRes E{X, DM, sgn, (l == 0 && sp == 4) ? in[0] : (const float*)X};
                pg8::gemm_phase<pg8::EpiRes, pg8::StaticOrder, true, true>((PG8_LAS unsigned char*)lds, g, S, E);
                for (int u = bid; u < 256; u += G) skinny_res(tid, u, lds, g.A, g.Bt, g.K, X);
            } else if (sp == 5) {
                norm_phase(X, in[8] + l * DM, HB, nullptr, gw, ngw, lane);
            } else if (sp == 6) {
                pg8::Gemm g{HB, WUP + (size_t)l * FF * DM, MPR, FF, DM};
                pg8::StaticOrder S; S.init(g.M, g.N, G, bid);
                pg8::EpiBf16<2> E{HID, FF};
                pg8::gemm_phase<pg8::EpiBf16<2>, pg8::StaticOrder, true, true>((PG8_LAS unsigned char*)lds, g, S, E);
                for (int u = bid; u < 256; u += G) skinny_unit<2>(tid, g.A, g.Bt, DM, DM, (size_t)MPR, u * 16, HID, FF);
            } else {
                if (l < 3) norm_phase(X, in[7] + (l + 1) * DM, HB, nullptr, gw, ngw, lane);
                else norm_phase(X, in[9], nullptr, outp + O_Y, gw, ngw, lane);
            }
        }
#if PROBE_ID
        if (coop) {
            const int l_ = (ph - 1) / 9, sp_ = (ph - 1) % 9, ev_ = !(l_ & 1);
            bool rp = false;
            if (PROBE_ID == 1) xcd_barrier(xbar);
            if (PROBE_ID == 2 && ph == 0) rp = true;
            if (ph > 0) {
                if (PROBE_ID == 3 && ev_ && sp_ == 1) rp = true;
                if ((PROBE_ID == 4 || PROBE_ID == 11 || PROBE_ID == 12) && ev_ && sp_ == 2) rp = true;
                if (PROBE_ID == 5 && !ev_ && sp_ == 1) rp = true;
                if (PROBE_ID == 6 && sp_ == 0) rp = true;
                if (PROBE_ID == 7 && sp_ == 6) rp = true;
                if (PROBE_ID == 8 && !ev_ && sp_ == 3) rp = true;
                if (PROBE_ID == 9 && (sp_ == 5 || sp_ == 8)) rp = true;
                if (PROBE_ID == 10 && ev_ && sp_ == 3) rp = true;
            }
            if ((PROBE_ID == 13 && ph > 0 && sp_ == 4) || (PROBE_ID == 14 && ph > 0 && sp_ == 7)) { if (repcnt < 2) { ++repcnt; --ph; xcd_barrier(xbar); continue; } repcnt = 0; }
            if (PROBE_ID == 15 && ph > 0 && !ev_ && sp_ == 2 && !((donemask >> l_) & 1u)) { donemask |= 1u << l_; ph -= 2; xcd_barrier(xbar); continue; }
            if (rp && !repeated) { repeated = true; --ph; xcd_barrier(xbar); continue; }
            repeated = false;
        }
#endif
        if (ph + 1 < a.ph_hi) { if (coop) xcd_barrier(xbar); }
    }
}

extern "C" void kernel_launch(void* const* d_in, const int* in_sizes, int n_in, void* d_out, int out_size, void* d_ws, size_t ws_size, hipStream_t stream) {
    static int grid = 0;
    if (grid == 0) {
        int dev = 0, cus = 0, per_cu = 0;
        hipGetDevice(&dev);
        hipDeviceGetAttribute(&cus, hipDeviceAttributeMultiprocessorCount, dev);
        hipFuncSetAttribute((const void*)mega_fwd, hipFuncAttributeMaxDynamicSharedMemorySize, LDS_BYTES);
        hipOccupancyMaxActiveBlocksPerMultiprocessor(&per_cu, (const void*)mega_fwd, 512, LDS_BYTES);
        if (per_cu < 1) { fprintf(stderr, "kernel_launch: occupancy query says %d blocks/CU\n", per_cu); per_cu = 1; }
        grid = cus * (per_cu > 1 ? 1 : per_cu);
        if (ws_size < WS_END) { fprintf(stderr, "kernel_launch: workspace too small: %zu < %zu\n", ws_size, (size_t)WS_END); grid = -1; }
        if (n_in != 24) { fprintf(stderr, "kernel_launch: expected 24 inputs, got %d\n", n_in); grid = -1; }
    }
    if (grid < 0) return;
    Args a{};
    for (int i = 0; i < 24; ++i) a.in[i] = (const float*)d_in[i];
    a.out = (float*)d_out; a.ws = (unsigned char*)d_ws;
#if MK_LAUNCH_PER_PHASE
    for (int ph = 0; ph < NPH; ++ph) { a.ph_lo = ph; a.ph_hi = ph + 1; hipLaunchKernelGGL(mega_fwd, dim3(grid), dim3(512), LDS_BYTES, stream, a); }
#else
    a.ph_lo = 0; a.ph_hi = NPH;
    if (hipMemsetAsync((char*)d_ws + WS_BAR, 0, 16384, stream) != hipSuccess) { fprintf(stderr, "kernel_launch: memset of barrier words failed\n"); return; }
    void* args[] = {&a};
    hipError_t e = hipLaunchCooperativeKernel((const void*)mega_fwd, dim3(grid), dim3(512), args, LDS_BYTES, stream);
    if (e != hipSuccess) fprintf(stderr, "cooperative launch failed: %s (grid %d)\n", hipGetErrorString(e), grid);
#endif
}
```

```cpp
#include <hip/hip_runtime.h>
#include <hip/hip_cooperative_groups.h>
#include <cstdio>
#include <cstdint>
namespace cg = cooperative_groups;
#ifndef MK_LAUNCH_PER_PHASE
#define MK_LAUNCH_PER_PHASE 0
#endif
namespace pg8 {
#define PG8_LAS __attribute__((address_space(3)))
typedef unsigned short bf16_t;
typedef short bf16x8 __attribute__((ext_vector_type(8)));
typedef float f32x4 __attribute__((ext_vector_type(4)));
typedef unsigned u32x4 __attribute__((ext_vector_type(4)));
constexpr int BM = 256, BK = 64, HALF = 128, HTB = HALF * BK * 2  , STAGE_BYTES = 8 * HTB, NXCD = 8, WGM = 8;

__host__ __device__ __forceinline__ int lds_byte(int r, int c) { const int st = (r >> 4) * 2 + (c >> 5), rr = r & 15, cc = c & 31, ob = rr * 64 + cc * 2; return st * 1024 + (ob ^ (((ob >> 9) & 1) << 5)); }
__host__ __device__ __forceinline__ void stage_rc(int b, int& R, int& C) { const int st = b / 1024, sb = b % 1024, swz = sb ^ (((sb >> 9) & 1) << 5); R = (st >> 1) * 16 + swz / 64; C = (st & 1) * 32 + (swz % 64) / 2; }
__host__ __device__ __forceinline__ int perm32(int rho) { const int n = rho >> 4, i = rho & 15; return 8 * (i >> 2) + 4 * n + (i & 3); }

struct Unit { int pm, pn; };
struct Gemm { const bf16_t* A; const bf16_t* Bt; int M, N, K; };

struct StaticOrder {
    int nM, nN, nwg, G, c;
    __host__ __device__ void init(int M, int N, int G_, int c_) { nM = M / BM; nN = N / BM; nwg = nM * nN; G = G_; c = c_; }
    __host__ __device__ bool next(int i, Unit& u) const {
        const long L = (long)i * G + c; if (L >= nwg) return false;
        int wgid = (int)L; { const int q = nwg / NXCD, r = nwg % NXCD, xcd = wgid % NXCD, off = wgid / NXCD; wgid = (xcd < r ? xcd * (q + 1) : r * (q + 1) + (xcd - r) * q) + off; }
        const int nig = WGM * nN, gid = wgid / nig, fm = gid * WGM, gsz = (nM - fm) < WGM ? (nM - fm) : WGM;
        u.pm = fm + ((wgid % nig) % gsz); u.pn = (wgid % nig) / gsz; return true;
    }
    __device__ __forceinline__ void a_ready(const Unit&) const {}
    __device__ __forceinline__ void done(const Unit&) const {}
};

__device__ __forceinline__ unsigned cvt_pk_bf16(float lo, float hi) { unsigned r; asm volatile("v_cvt_pk_bf16_f32 %0, %1, %2" : "=v"(r) : "v"(lo), "v"(hi)); return r; }
typedef float f32x2 __attribute__((ext_vector_type(2)));
template <int ACT> struct EpiBf16 {
    static constexpr bool PERM = true, AFTER_DRAIN = false;
    bf16_t* O; int ldc;
    __device__ __forceinline__ void operator()(const f32x4 (&acc)[2][2][4][2], const Unit& u, int wr, int wc, int fr, int fq) const {
        const int row0 = u.pm * BM + wr * 64 + fr; const int col0 = u.pn * BM + wc * 32 + 8 * fq;
#pragma unroll
        for (int ai = 0; ai < 2; ++ai)
#pragma unroll
            for (int m = 0; m < 4; ++m) { bf16_t* rowp = O + (size_t)(row0 + ai * HALF + m * 16) * ldc + col0;
#pragma unroll
                for (int bj = 0; bj < 2; ++bj) { f32x4 v0 = acc[ai][bj][m][0], v1 = acc[ai][bj][m][1];
                    if (ACT == 2) {
#pragma unroll
                        for (int j = 0; j < 4; ++j) { float a = v0[j] > 0.f ? v0[j] : 0.f; v0[j] = a * a; float b = v1[j] > 0.f ? v1[j] : 0.f; v1[j] = b * b; } }
                    u32x4 w; w.x = cvt_pk_bf16(v0[0], v0[1]); w.y = cvt_pk_bf16(v0[2], v0[3]); w.z = cvt_pk_bf16(v1[0], v1[1]); w.w = cvt_pk_bf16(v1[2], v1[3]);
                    *(u32x4*)(rowp + bj * HALF) = w; } }
    }
};
struct EpiRes {
    static constexpr bool PERM = false, AFTER_DRAIN = false;
    float* X; int ldc; float sgn; const float* R;
    __device__ __forceinline__ void operator()(const f32x4 (&acc)[2][2][4][2], const Unit& u, int wr, int wc, int fr, int fq) const {
        const int col0 = u.pn * BM + wc * 32 + 4 * fq;
#pragma unroll
        for (int ai = 0; ai < 2; ++ai) {
            float* base = X + (size_t)(u.pm * BM + ai * HALF + wr * 64 + fr) * ldc + col0; const float* rbase = R + (size_t)(u.pm * BM + ai * HALF + wr * 64 + fr) * ldc + col0;
            f32x4 r[4][2][2];
#pragma unroll
            for (int m = 0; m < 4; ++m)
#pragma unroll
                for (int bj = 0; bj < 2; ++bj)
#pragma unroll
                    for (int n = 0; n < 2; ++n) r[m][bj][n] = *(const f32x4*)(rbase + (size_t)(m * 16) * ldc + bj * HALF + n * 16);
            asm volatile("" ::: "memory");
#pragma unroll
            for (int m = 0; m < 4; ++m)
#pragma unroll
                for (int bj = 0; bj < 2; ++bj)
#pragma unroll
                    for (int n = 0; n < 2; ++n) *(f32x4*)(base + (size_t)(m * 16) * ldc + bj * HALF + n * 16) = r[m][bj][n] + acc[ai][bj][m][n] * sgn;
            asm volatile("" ::: "memory");
        }
    }
};
template <class Epi, class Sched, bool ALIGN_EPI = false, bool SP2 = false>
__device__ __forceinline__ void gemm_phase(PG8_LAS unsigned char* lds, const Gemm g, const Sched& S, const Epi& E) {
    int tid = threadIdx.x; asm volatile("" : "+v"(tid)); const int wid = __builtin_amdgcn_readfirstlane(tid >> 6), lane = tid & 63, wr = wid >> 2, wc = wid & 3, fr = lane & 15, fq = lane >> 4;
    const int K = g.K, nt = K / BK;
    unsigned voffA[2], voffB[2];
#pragma unroll
    for (int i = 0; i < 2; ++i) { int R, C; stage_rc(tid * 16 + i * 8192, R, C); const int Rb = Epi::PERM ? ((R & ~31) + perm32(R & 31)) : R;
        voffA[i] = (unsigned)(R * K + C) * 2u; voffB[i] = (unsigned)(Rb * K + C) * 2u; }
    const size_t kstep = (size_t)(BK * 2);
    const size_t hstep = (size_t)HALF * K * 2;
    const size_t tstep = 2 * hstep;
    const unsigned ldsw = (unsigned)wid * 1024u;
    const int aoff = lds_byte(wr * 64 + fr, fq * 8), boff = lds_byte(wc * 32 + fr, fq * 8);
#define PG8_SA(b, h) (((b) * 2 + (h)) * HTB)
#define PG8_SB(b, h) ((4 + (b) * 2 + (h)) * HTB)
#define PG8_STAGE(bufoff, gbase, voff) do { _Pragma("unroll") for (int _i = 0; _i < 2; ++_i) \
        __builtin_amdgcn_global_load_lds((const unsigned*)((const char*)(gbase) + (voff)[_i]), (PG8_LAS unsigned*)(lds + (bufoff) + ldsw + _i * 8192), 16, 0, 0); } while (0)
#define PG8_LDA(dst, b, h) do { _Pragma("unroll") for (int m = 0; m < 4; ++m) _Pragma("unroll") for (int k = 0; k < 2; ++k) dst[m][k] = *(const PG8_LAS bf16x8*)(lds + PG8_SA(b, h) + aoff + m * 2048 + k * 1024); } while (0)
#define PG8_LDB(dst, b, h) do { _Pragma("unroll") for (int n = 0; n < 2; ++n) _Pragma("unroll") for (int k = 0; k < 2; ++k) dst[n][k] = *(const PG8_LAS bf16x8*)(lds + PG8_SB(b, h) + boff + n * 2048 + k * 1024); } while (0)
#define PG8_MMA(ai, bj, At, Bt) do { __builtin_amdgcn_s_setprio(1); _Pragma("unroll") for (int m = 0; m < 4; ++m) _Pragma("unroll") for (int n = 0; n < 2; ++n) _Pragma("unroll") for (int k = 0; k < 2; ++k) \
        acc[ai][bj][m][n] = __builtin_amdgcn_mfma_f32_16x16x32_bf16(Bt[n][k], At[m][k], acc[ai][bj][m][n], 0, 0, 0); __builtin_amdgcn_s_setprio(0); } while (0)
#define PG8_WAIT_V(n) asm volatile("s_waitcnt vmcnt(" #n ")" ::: "memory")
#define PG8_WAIT_L(n) asm volatile("s_waitcnt lgkmcnt(" #n ")" ::: "memory")
#define PG8_BAR __builtin_amdgcn_s_barrier()
#define PG8_SCHED __builtin_amdgcn_sched_barrier(0)
    Unit cur, nxt; int ui = 0;
    if (!S.next(0, cur)) return;
    f32x4 acc[2][2][4][2];
#pragma unroll
    for (int a = 0; a < 2; ++a)
#pragma unroll
        for (int b = 0; b < 2; ++b)
#pragma unroll
            for (int m = 0; m < 4; ++m)
#pragma unroll
                for (int n = 0; n < 2; ++n) acc[a][b][m][n] = (f32x4){0.f, 0.f, 0.f, 0.f};
    bf16x8 At[4][2], B0[2][2], B1[2][2];
    const char* cA = (const char*)g.A + (size_t)cur.pm * tstep; const char* cB = (const char*)g.Bt + (size_t)cur.pn * tstep;
    S.a_ready(cur);
    if constexpr (SP2) {
        PG8_STAGE(PG8_SB(0, 0), cB, voffB); PG8_STAGE(PG8_SB(0, 1), cB + hstep, voffB); PG8_STAGE(PG8_SA(0, 0), cA, voffA); PG8_STAGE(PG8_SA(0, 1), cA + hstep, voffA);
        if (wr == 1) PG8_BAR;
        PG8_WAIT_V(2); PG8_BAR;
        PG8_STAGE(PG8_SB(1, 0), cB + kstep, voffB); PG8_STAGE(PG8_SA(1, 0), cA + kstep, voffA); PG8_STAGE(PG8_SB(1, 1), cB + hstep + kstep, voffB);
        PG8_WAIT_V(6); PG8_BAR;
    } else {
        PG8_STAGE(PG8_SB(0, 0), cB, voffB); PG8_STAGE(PG8_SA(0, 0), cA, voffA); PG8_STAGE(PG8_SB(0, 1), cB + hstep, voffB); PG8_STAGE(PG8_SA(0, 1), cA + hstep, voffA);
        if (wr == 1) PG8_BAR;
        PG8_WAIT_V(4); PG8_BAR;
        PG8_STAGE(PG8_SB(1, 0), cB + kstep, voffB); PG8_STAGE(PG8_SA(1, 0), cA + kstep, voffA); PG8_STAGE(PG8_SB(1, 1), cB + hstep + kstep, voffB);
        PG8_WAIT_V(6); PG8_BAR;
    }
    for (;;) {
        const bool has_next = S.next(ui + 1, nxt);
        const char* nA = has_next ? (const char*)g.A + (size_t)nxt.pm * tstep : cA; const char* nB = has_next ? (const char*)g.Bt + (size_t)nxt.pn * tstep : cB;
        for (int t = 0; t < nt; t += 2) {
            const bool last = (t == nt - 2);
            const char* a1 = cA + (size_t)(t + 1) * kstep;
            const char* a2 = last ? nA : cA + (size_t)(t + 2) * kstep; const char* b2 = last ? nB : cB + (size_t)(t + 2) * kstep;
            const char* a3 = a2 + kstep; const char* b3 = b2 + kstep;
            if (last && has_next) S.a_ready(nxt);
            if constexpr (SP2) {
            PG8_LDB(B0, 0, 0); PG8_LDB(B1, 0, 1); PG8_SCHED; PG8_LDA(At, 0, 0); PG8_STAGE(PG8_SA(1, 1), a1 + hstep, voffA);
            PG8_WAIT_V(8); PG8_WAIT_L(0); PG8_BAR; PG8_MMA(0, 0, At, B0); PG8_MMA(0, 1, At, B1); PG8_BAR; PG8_SCHED;
            PG8_LDA(At, 0, 1); PG8_STAGE(PG8_SB(0, 0), b2, voffB); PG8_STAGE(PG8_SB(0, 1), b2 + hstep, voffB); PG8_STAGE(PG8_SA(0, 0), a2, voffA);
            PG8_WAIT_V(8); PG8_WAIT_L(0); PG8_BAR; PG8_MMA(1, 0, At, B0); PG8_MMA(1, 1, At, B1); PG8_BAR; PG8_SCHED;
            PG8_LDB(B0, 1, 0); PG8_LDB(B1, 1, 1); PG8_SCHED; PG8_LDA(At, 1, 0); PG8_STAGE(PG8_SA(0, 1), a2 + hstep, voffA);
            PG8_WAIT_V(8); PG8_WAIT_L(0); PG8_BAR; PG8_MMA(0, 0, At, B0); PG8_MMA(0, 1, At, B1); PG8_BAR; PG8_SCHED;
            PG8_LDA(At, 1, 1); PG8_STAGE(PG8_SB(1, 0), b3, voffB); PG8_STAGE(PG8_SB(1, 1), b3 + hstep, voffB); PG8_STAGE(PG8_SA(1, 0), a3, voffA);
            PG8_WAIT_V(8); PG8_WAIT_L(0); PG8_BAR; PG8_MMA(1, 0, At, B0); PG8_MMA(1, 1, At, B1); PG8_BAR; PG8_SCHED;
            } else {
            PG8_LDB(B0, 0, 0); PG8_SCHED; PG8_LDA(At, 0, 0); PG8_STAGE(PG8_SA(1, 1), a1 + hstep, voffA);
            PG8_WAIT_L(8); PG8_BAR; PG8_WAIT_L(0); PG8_MMA(0, 0, At, B0); PG8_BAR; PG8_SCHED;
            PG8_LDB(B1, 0, 1); PG8_STAGE(PG8_SB(0, 0), b2, voffB);
            PG8_BAR; PG8_WAIT_L(0); PG8_MMA(0, 1, At, B1); PG8_BAR;
            PG8_LDA(At, 0, 1); PG8_STAGE(PG8_SA(0, 0), a2, voffA);
            PG8_BAR; PG8_WAIT_L(0); PG8_MMA(1, 0, At, B0); PG8_BAR; PG8_SCHED;
            PG8_STAGE(PG8_SB(0, 1), b2 + hstep, voffB);
            PG8_WAIT_V(6); PG8_BAR; PG8_MMA(1, 1, At, B1); PG8_BAR;
            PG8_LDB(B0, 1, 0); PG8_SCHED; PG8_LDA(At, 1, 0); PG8_STAGE(PG8_SA(0, 1), a2 + hstep, voffA);
            PG8_WAIT_L(8); PG8_BAR; PG8_WAIT_L(0); PG8_MMA(0, 0, At, B0); PG8_BAR; PG8_SCHED;
            PG8_LDB(B1, 1, 1); PG8_STAGE(PG8_SB(1, 0), b3, voffB);
            PG8_BAR; PG8_WAIT_L(0); PG8_MMA(0, 1, At, B1); PG8_BAR;
            PG8_LDA(At, 1, 1); PG8_STAGE(PG8_SA(1, 0), a3, voffA);
            PG8_BAR; PG8_WAIT_L(0); PG8_MMA(1, 0, At, B0); PG8_BAR; PG8_SCHED;
            PG8_STAGE(PG8_SB(1, 1), b3 + hstep, voffB);
            PG8_WAIT_V(6); PG8_BAR; PG8_MMA(1, 1, At, B1); PG8_BAR;
            }
        }
        if constexpr (ALIGN_EPI) { if (wr == 0) PG8_BAR; }
        if constexpr (!Epi::AFTER_DRAIN) { E(acc, cur, wr, wc, fr, fq); S.done(cur); }
        if (!has_next) break;
#pragma unroll
        for (int a = 0; a < 2; ++a)
#pragma unroll
            for (int b = 0; b < 2; ++b)
#pragma unroll
                for (int m = 0; m < 4; ++m)
#pragma unroll
                    for (int n = 0; n < 2; ++n) acc[a][b][m][n] = (f32x4){0.f, 0.f, 0.f, 0.f};
        cur = nxt; cA = nA; cB = nB; ++ui;
        if constexpr (ALIGN_EPI) { if (wr == 1) PG8_BAR; }
    }
    PG8_WAIT_V(0);
    if constexpr (!ALIGN_EPI) { if (wr == 0) PG8_BAR; }
    PG8_BAR;
    if constexpr (Epi::AFTER_DRAIN) { E.fused(acc, cur, wr, wc, fr, fq, lds, wid, lane); S.done(cur); }
#undef PG8_SA
#undef PG8_SB
#undef PG8_STAGE
#undef PG8_LDA
#undef PG8_LDB
#undef PG8_MMA
#undef PG8_WAIT_V
#undef PG8_WAIT_L
#undef PG8_BAR
#undef PG8_SCHED
}
}
typedef unsigned short bf16;
typedef short bf16x8 __attribute__((ext_vector_type(8)));
typedef float f32x4 __attribute__((ext_vector_type(4)));
typedef float f32x2v __attribute__((ext_vector_type(2)));
typedef unsigned u32x4 __attribute__((ext_vector_type(4)));
typedef unsigned u32x2 __attribute__((ext_vector_type(2)));

constexpr int DM = 1024, SEQ = 8192, MPR = 16384, MSA = 128, MREAL = 16512, MPAD = 16640, FF = 4096;
constexpr int NPE = 3072, NPO = 3328, NE_IN = 2824, NO_IN = 3088;
constexpr float EPS = 1e-6f;
constexpr size_t MiB = 1u << 20;
constexpr size_t WS_WEI = 1 * MiB;
constexpr size_t WS_WEO = WS_WEI + 12 * MiB;
constexpr size_t WS_WGI = WS_WEO + 4 * MiB;
constexpr size_t WS_WGO = WS_WGI + 13 * MiB;
constexpr size_t WS_WUP = WS_WGO + 4 * MiB;
constexpr size_t WS_WDN = WS_WUP + 32 * MiB;
constexpr size_t WS_X   = WS_WDN + 32 * MiB;
constexpr size_t WS_HB  = WS_X + 65 * MiB;
constexpr size_t WS_MIX = WS_HB + 33 * MiB;
constexpr size_t WS_BIG = WS_MIX + 33 * MiB;
constexpr size_t WS_SCR = WS_BIG + 106 * MiB;
constexpr size_t SC_DN_W = WS_SCR, SC_DN_QE = SC_DN_W + 16 * MiB, SC_DN_KT = SC_DN_QE + 16 * MiB, SC_DN_AT = SC_DN_KT + 16 * MiB,
                 SC_DN_U = SC_DN_AT + 8 * MiB, SC_DN_EGL = SC_DN_U + 16 * MiB, SC_DN_O = SC_DN_EGL + 1 * MiB;
constexpr size_t SC_GL_US = WS_SCR, SC_GL_QT = SC_GL_US + 64 * MiB, SC_GL_OI = SC_GL_QT + 16 * MiB, SC_GL_EGL = SC_GL_OI + 32 * MiB;
constexpr size_t SC_DN_VN = SC_DN_O + 32 * MiB;
constexpr size_t WS_END = WS_SCR + 122 * MiB;
constexpr size_t O_Y = 0, O_PDN = 16908288, O_PCONV = 17170432, O_PK = 17188864, O_PV = 17254400, O_PGLA = 17319936,
                 O_SDN = 17844224, O_SCONV = 34621440, O_SK = 35801088, O_SV = 39995392, O_SGLA = 44189696;
constexpr int LDS_BYTES = 147456;
constexpr int NPH = 37;

struct Args { const float* in[24]; float* out; unsigned char* ws; int ph_lo, ph_hi; };

typedef __bf16 bf16x2_t __attribute__((ext_vector_type(2)));
__device__ __forceinline__ unsigned pk2(float lo, float hi) { bf16x2_t v; v.x = (__bf16)lo; v.y = (__bf16)hi; return __builtin_bit_cast(unsigned, v); }
__device__ __forceinline__ unsigned f2bf(float f) { return pk2(f, 0.f) & 0xffffu; }
__device__ __forceinline__ float bf2f(unsigned h) { return __uint_as_float(h << 16); }

__device__ __forceinline__ float bflo(unsigned u) { return __uint_as_float(u << 16); }
__device__ __forceinline__ float bfhi(unsigned u) { return __uint_as_float(u & 0xffff0000u); }
__device__ __forceinline__ f32x4 mfma16(bf16x8 a, bf16x8 b, f32x4 c) { return __builtin_amdgcn_mfma_f32_16x16x32_bf16(a, b, c, 0, 0, 0); }
__device__ __forceinline__ float opq(float x) { asm volatile("" : "+v"(x)); return x; }
__device__ __forceinline__ float siluf(float x) { return x * __builtin_amdgcn_rcpf(1.f + __expf(-x)); }
#define DPPF(v, ctrl) __int_as_float(__builtin_amdgcn_update_dpp(0, __float_as_int(v), ctrl, 0xf, 0xf, false))
__device__ __forceinline__ float sum16(float v) { v += DPPF(v, 0xB1); v += DPPF(v, 0x4E); v += DPPF(v, 0x141); v += DPPF(v, 0x140); return v; }
__device__ __forceinline__ float max16(float v) { v = fmaxf(v, DPPF(v, 0xB1)); v = fmaxf(v, DPPF(v, 0x4E)); v = fmaxf(v, DPPF(v, 0x141)); v = fmaxf(v, DPPF(v, 0x140)); return v; }
__device__ __forceinline__ float wave_sum(float v) { v = sum16(v); v += __shfl_xor(v, 16); v += __shfl_xor(v, 32); return v; }
__device__ __forceinline__ float wave_max(float v) { v = max16(v); v = fmaxf(v, __shfl_xor(v, 16)); v = fmaxf(v, __shfl_xor(v, 32)); return v; }
#define LDSWAIT() asm volatile("s_waitcnt lgkmcnt(0)" ::: "memory")
#define BAR_LDS() do { asm volatile("s_waitcnt lgkmcnt(0)" ::: "memory"); __builtin_amdgcn_s_barrier(); asm volatile("" ::: "memory"); } while (0)
__device__ __forceinline__ void unpack8(u32x4 w, float (&f)[8]) { f[0] = bflo(w.x); f[1] = bfhi(w.x); f[2] = bflo(w.y); f[3] = bfhi(w.y); f[4] = bflo(w.z); f[5] = bfhi(w.z); f[6] = bflo(w.w); f[7] = bfhi(w.w); }
__device__ __forceinline__ u32x4 pack8(const float (&f)[8]) { u32x4 w; w.x = pk2(f[0], f[1]); w.y = pk2(f[2], f[3]); w.z = pk2(f[4], f[5]); w.w = pk2(f[6], f[7]); return w; }

__device__ __forceinline__ void transpose_w(const float* __restrict__ W, int K, int N, int Npad, bf16* __restrict__ WT, float* scr, int gw, int ngw, int lane) {
    const int nblk = Npad / 64, nitems = (K / 64) * nblk;
    for (int it = gw; it < nitems; it += ngw) {
        const int kb = it / nblk, nb = it % nblk, k0 = 64 * kb, n0 = 64 * nb;
        const int n = n0 + lane;
        float v[64];
#pragma unroll
        for (int kk = 0; kk < 64; ++kk) v[kk] = (n < N) ? W[(size_t)(k0 + kk) * N + n] : 0.f;
#pragma unroll
        for (int kk = 0; kk < 64; ++kk) scr[kk * 65 + lane] = v[kk];
        LDSWAIT();
        const int c = lane & 7;
#pragma unroll
        for (int j = 0; j < 8; ++j) { const int nl = (lane >> 3) + 8 * j; const float* s = scr + (8 * c) * 65 + nl;
            u32x4 o; o.x = pk2(s[0 * 65], s[1 * 65]); o.y = pk2(s[2 * 65], s[3 * 65]); o.z = pk2(s[4 * 65], s[5 * 65]); o.w = pk2(s[6 * 65], s[7 * 65]);
            *(u32x4*)(WT + (size_t)(n0 + nl) * K + k0 + 8 * c) = o; }
        LDSWAIT();
    }
}
__device__ __forceinline__ void norm_row(const f32x4 (&v)[4], const float* g, bf16* hrow, float* yrow, int lane) {
    float s = 0.f;
#pragma unroll
    for (int j = 0; j < 4; ++j) s += (v[j].x * v[j].x + v[j].y * v[j].y) + (v[j].z * v[j].z + v[j].w * v[j].w);
    const float rstd = rsqrtf(wave_sum(s) * (1.f / DM) + EPS);
#pragma unroll
    for (int j = 0; j < 4; ++j) { const f32x4 gg = *(const f32x4*)(g + 4 * lane + 256 * j); const f32x4 o = v[j] * rstd * gg;
        if (hrow) { u32x2 w; w.x = pk2(o.x, o.y); w.y = pk2(o.z, o.w); *(u32x2*)(hrow + 4 * lane + 256 * j) = w; }
        else *(f32x4*)(yrow + 4 * lane + 256 * j) = o; }
}
__device__ __forceinline__ void norm_phase(const float* __restrict__ X, const float* g, bf16* __restrict__ HB, float* __restrict__ Y, int gw, int ngw, int lane) {
    for (int m0 = gw; m0 < MREAL; m0 += 4 * ngw) {
        f32x4 v[4][4];
#pragma unroll
        for (int r = 0; r < 4; ++r) { const int m = m0 + r * ngw; const int mm = m < MREAL ? m : m0;
#pragma unroll
            for (int j = 0; j < 4; ++j) v[r][j] = *(const f32x4*)(X + (size_t)mm * DM + 4 * lane + 256 * j); }
#pragma unroll
        for (int r = 0; r < 4; ++r) { const int m = m0 + r * ngw;
            if (m < MREAL) norm_row(v[r], g, HB ? HB + (size_t)m * DM : nullptr, Y ? Y + (size_t)m * DM : nullptr, lane); }
    }
}

__device__ __forceinline__ void dn_stepA(int tid, int unit, unsigned char* lds, const bf16* PROJ, const float* conv_w, const float* a_log, const float* dt_bias,
                                         bf16* W_, bf16* QE_, bf16* KT_, bf16* AT_, bf16* U_, float* EGL_) {
    asm volatile("" : "+v"(tid));
    const int lane = tid & 63, wave = tid >> 6, m16 = lane & 15, q4 = lane >> 4;
    const int h = unit & 3, c = (unit >> 2) & 127, b = unit >> 9;
    const int t0 = c * 64; const size_t rowb = (size_t)b * SEQ;
    const size_t ch = (size_t)unit;
    bf16* qs = (bf16*)(lds); bf16* ks = (bf16*)(lds + 17408); bf16* kbs = (bf16*)(lds + 34816);
    bf16* vbT = (bf16*)(lds + 52224); bf16* kbgT = (bf16*)(lds + 70656);
    float* Ms = (float*)(lds + 89088); bf16* Tb = (bf16*)(lds + 105728);
    float* Gs = (float*)(lds + 114944); float* Bs = Gs + 64;
    if (wave == 0) {
        const bf16* pr = PROJ + (rowb + t0 + lane) * NPE;
        const float a = bf2f(pr[2048 + h]), bb = bf2f(pr[2052 + h]);
        const float x = a + dt_bias[h];
        const float sp = x > 20.f ? x : __logf(1.f + __expf(x));
        const float g = -__expf(a_log[h]) * sp;
        float G = g;
#pragma unroll
        for (int o = 1; o < 64; o <<= 1) { const float v = __shfl_up(G, o); if (lane >= o) G += v; }
        Gs[lane] = G; Bs[lane] = __builtin_amdgcn_rcpf(1.f + __expf(-bb));
    }
    __syncthreads();
#pragma unroll 1
    for (int bt = 0; bt < 2; ++bt) {
        u32x4 raw[3][4];
#pragma unroll
        for (int ii = 0; ii < 3; ++ii) {
            const int item = (bt * 3 + ii) * 512 + tid, part = item >> 10, t = (item >> 4) & 63, cg = item & 15;
            const int chn = part * 512 + h * 128 + cg * 8;
#pragma unroll
            for (int tap = 0; tap < 4; ++tap) { const int tt = t0 + t - 3 + tap;
                raw[ii][tap] = tt >= 0 ? *(const u32x4*)(PROJ + (rowb + tt) * NPE + chn) : (u32x4){0u, 0u, 0u, 0u}; }
        }
#pragma unroll
        for (int ii = 0; ii < 3; ++ii) {
            const int item = (bt * 3 + ii) * 512 + tid, part = item >> 10, t = (item >> 4) & 63, cg = item & 15;
            const int chn = part * 512 + h * 128 + cg * 8;
            float acc[8];
#pragma unroll
            for (int j = 0; j < 8; ++j) acc[j] = 0.f;
#pragma unroll
            for (int tap = 0; tap < 4; ++tap) {
                float f[8]; unpack8(raw[ii][tap], f);
                const f32x4 c0 = *(const f32x4*)(conv_w + tap * 1536 + chn), c1 = *(const f32x4*)(conv_w + tap * 1536 + chn + 4);
                acc[0] += f[0] * c0.x; acc[1] += f[1] * c0.y; acc[2] += f[2] * c0.z; acc[3] += f[3] * c0.w;
                acc[4] += f[4] * c1.x; acc[5] += f[5] * c1.y; acc[6] += f[6] * c1.z; acc[7] += f[7] * c1.w;
            }
            float ss = 0.f;
#pragma unroll
            for (int j = 0; j < 8; ++j) { acc[j] = siluf(acc[j]); ss += acc[j] * acc[j]; }
            ss = sum16(ss);
            const float rstd = rsqrtf(ss + EPS);
            const float Gt = Gs[t], bt_ = Bs[t];
            if (part == 0) {
                float o[8], oe[8]; const float sc = rstd * 0.08838834764831845f, eg = __expf(Gt);
#pragma unroll
                for (int j = 0; j < 8; ++j) { o[j] = acc[j] * sc; oe[j] = o[j] * eg; }
                *(u32x4*)(qs + t * 136 + cg * 8) = pack8(o);
                *(u32x4*)(QE_ + ch * 8192 + t * 128 + cg * 8) = pack8(oe);
            } else if (part == 1) {
                float o[8], ob[8]; const float eg = __expf(Gt) * bt_;
#pragma unroll
                for (int j = 0; j < 8; ++j) { o[j] = acc[j] * rstd; ob[j] = o[j] * bt_; }
                *(u32x4*)(ks + t * 136 + cg * 8) = pack8(o);
                *(u32x4*)(kbs + t * 136 + cg * 8) = pack8(ob);
#pragma unroll
                for (int j = 0; j < 8; ++j) kbgT[(cg * 8 + j) * 72 + (((t >> 3) ^ (cg & 7)) << 3) + (t & 7)] = (bf16)f2bf(o[j] * eg);
            } else {
#pragma unroll
                for (int j = 0; j < 8; ++j) vbT[(cg * 8 + j) * 72 + (((t >> 3) ^ (cg & 7)) << 3) + (t & 7)] = (bf16)f2bf(acc[j] * bt_);
            }
        }
    }
    __syncthreads();
    {
        const int d = tid >> 2, tg = tid & 3; const float gl = Gs[63];
#pragma unroll
        for (int half = 0; half < 2; ++half) {
            float o[8];
#pragma unroll
            for (int j = 0; j < 8; ++j) { const int t = tg * 16 + half * 8 + j; o[j] = bf2f(ks[t * 136 + d]) * __expf(gl - Gs[t]); }
            *(u32x4*)(KT_ + ch * 8192 + d * 64 + tg * 16 + half * 8) = pack8(o);
        }
        if (tid == 0) EGL_[ch] = __expf(gl);
    }
    {
        const int which = wave >> 2, mt = wave & 3;
        const bf16* As = which ? kbs : qs;
        bf16x8 aF[4];
#pragma unroll
        for (int k4 = 0; k4 < 4; ++k4) aF[k4] = *(const bf16x8*)(As + (mt * 16 + m16) * 136 + k4 * 32 + q4 * 8);
#pragma unroll
        for (int nt = 0; nt < 4; ++nt) {
            f32x4 acc = {0.f, 0.f, 0.f, 0.f};
            if (nt <= mt) {
#pragma unroll
                for (int k4 = 0; k4 < 4; ++k4) { const bf16x8 bF = *(const bf16x8*)(ks + (nt * 16 + m16) * 136 + k4 * 32 + q4 * 8); acc = mfma16(aF[k4], bF, acc); }
            }
            const int s = nt * 16 + m16; const float Gsv = Gs[s];
#pragma unroll
            for (int i = 0; i < 4; ++i) {
                const int t = mt * 16 + q4 * 4 + i;
                const bool on = which ? (t > s) : (t >= s);
                const float v = on ? acc[i] * __expf(Gs[t] - Gsv) : 0.f;
                if (which) Ms[t * 65 + s] = v; else AT_[ch * 4096 + t * 64 + s] = (bf16)f2bf(v);
            }
        }
    }
    __syncthreads();
    {
        float* Ts = (float*)(lds + 115456);
        if (wave == 0) {
            const int blk = lane >> 4, cc = lane & 15; const float* Mb = Ms + (blk * 16) * 65 + blk * 16;
            float tc[16];
#pragma unroll
            for (int r = 0; r < 16; ++r) {
                float acc = (r == cc) ? 1.f : 0.f;
#pragma unroll
                for (int j = 0; j < r; ++j) acc -= Mb[r * 65 + j] * tc[j];
                tc[r] = acc;
            }
#pragma unroll
            for (int r = 0; r < 16; ++r) Ts[(blk * 16 + r) * 65 + blk * 16 + cc] = tc[r];
        }
        __syncthreads();
#pragma unroll 1
        for (int dd = 1; dd < 4; ++dd) {
            if (wave < 4 - dd) {
                const int j = wave, i = wave + dd;
                f32x4 acc = {0.f, 0.f, 0.f, 0.f};
                for (int k = j; k < i; ++k) {
                    const float* A = Ms + (i * 16) * 65 + k * 16; const float* B = Ts + (k * 16) * 65 + j * 16;
#pragma unroll
                    for (int kk = 0; kk < 4; ++kk) acc = __builtin_amdgcn_mfma_f32_16x16x4f32(A[m16 * 65 + kk * 4 + q4], B[(kk * 4 + q4) * 65 + m16], acc, 0, 0, 0);
                }
                float* Tmp = Ts + (j * 16) * 65 + i * 16;
#pragma unroll
                for (int r = 0; r < 4; ++r) Tmp[(q4 * 4 + r) * 65 + m16] = acc[r];
                LDSWAIT();
                f32x4 acc2 = {0.f, 0.f, 0.f, 0.f};
                { const float* A = Ts + (i * 16) * 65 + i * 16;
#pragma unroll
                  for (int kk = 0; kk < 4; ++kk) acc2 = __builtin_amdgcn_mfma_f32_16x16x4f32(A[m16 * 65 + kk * 4 + q4], Tmp[(kk * 4 + q4) * 65 + m16], acc2, 0, 0, 0); }
                float* Out = Ts + (i * 16) * 65 + j * 16;
#pragma unroll
                for (int r = 0; r < 4; ++r) Out[(q4 * 4 + r) * 65 + m16] = -acc2[r];
            }
            __syncthreads();
        }
        const int t = tid >> 3, s8 = (tid & 7) * 8; float o[8];
#pragma unroll
        for (int j = 0; j < 8; ++j) o[j] = (s8 + j <= t) ? Ts[t * 65 + s8 + j] : 0.f;
        *(u32x4*)(Tb + t * 72 + s8) = pack8(o);
    }
    __syncthreads();
    {
        const bf16* BT = wave < 4 ? vbT : kbgT; bf16* OUT = wave < 4 ? U_ : W_;
        bf16x8 bF[2][2];
#pragma unroll
        for (int n2 = 0; n2 < 2; ++n2)
#pragma unroll
            for (int k2 = 0; k2 < 2; ++k2) { const int rr = ((wave & 3) * 2 + n2) * 16 + m16; bF[n2][k2] = *(const bf16x8*)(BT + rr * 72 + (((k2 * 4 + q4) ^ ((rr >> 3) & 7)) << 3)); }
#pragma unroll
        for (int mt = 0; mt < 4; ++mt) {
            bf16x8 aF[2];
#pragma unroll
            for (int k2 = 0; k2 < 2; ++k2) aF[k2] = *(const bf16x8*)(Tb + (mt * 16 + m16) * 72 + k2 * 32 + q4 * 8);
#pragma unroll
            for (int n2 = 0; n2 < 2; ++n2) {
                f32x4 acc = {0.f, 0.f, 0.f, 0.f};
                u32x2 w;
                if (wave < 4) {
                    acc = mfma16(aF[0], bF[n2][0], acc); acc = mfma16(aF[1], bF[n2][1], acc);
                    w.x = pk2(acc[0], acc[1]); w.y = pk2(acc[2], acc[3]);
                    *(u32x2*)(OUT + ch * 8192 + (((wave & 3) * 2 + n2) * 16 + m16) * 64 + mt * 16 + q4 * 4) = w;
                } else {
                    acc = mfma16(bF[n2][0], aF[0], acc); acc = mfma16(bF[n2][1], aF[1], acc);
                    w.x = pk2(acc[0], acc[1]); w.y = pk2(acc[2], acc[3]);
                    *(u32x2*)(OUT + ch * 8192 + (mt * 16 + m16) * 128 + ((wave & 3) * 2 + n2) * 16 + q4 * 4) = w;
                }
            }
        }
    }
    __syncthreads();
}

__device__ __forceinline__ void dn_stepB(int tid, int item, unsigned char* lds, const bf16* W_, const bf16* KT_, const bf16* U_, const float* EGL_,
                                         bf16* SC_, bf16* VN_, float* state_out) {
    asm volatile("" : "+v"(tid));
    const int lane = tid & 63, wave = tid >> 6, m16 = lane & 15, q4 = lane >> 4;
    const int bh = item & 7, sl = item >> 3, b = bh >> 2, h = bh & 3, e0 = sl * 16;
    bf16* Sb = (bf16*)lds;
    bf16* Vn = (bf16*)(lds + 16 * 136 * 2);
    for (int i = tid; i < 16 * 136 / 2; i += 512) ((unsigned*)Sb)[i] = 0u;
    f32x4 accS = {0.f, 0.f, 0.f, 0.f};
    __syncthreads();
    const bool lo = wave < 4;
    int vz = 0; asm volatile("" : "+v"(vz));
    const bf16* xbase = W_ + ((wave & 3) * 16 + m16) * 128 + q4 * 8;
    const bf16* ubase = U_ + (e0 + m16) * 64 + (wave & 3) * 16 + q4 * 4;
    const bf16* kbase = KT_ + (wave * 16 + m16) * 64 + q4 * 8;
    bf16* scbase = SC_ + (e0 + m16) * 128 + wave * 16 + q4 * 4;
    bf16* vnbase = VN_ + (e0 + m16) * 64 + (wave & 3) * 16 + q4 * 4;
#define DNB_LOAD(cc, xA_, kA_, uC_, egl_) do { const int c_ = (cc) < 128 ? (cc) : 127; const size_t ch_ = (size_t)b * 512 + c_ * 4 + h; \
        if (lo) { _Pragma("unroll") for (int k4 = 0; k4 < 4; ++k4) xA_[k4] = *(const bf16x8*)(xbase + ch_ * 8192 + k4 * 32); uC_ = *(const u32x2*)(ubase + ch_ * 8192); } \
        kA_[0] = *(const bf16x8*)(kbase + ch_ * 8192); kA_[1] = *(const bf16x8*)(kbase + ch_ * 8192 + 32); \
        egl_ = EGL_[ch_ + vz]; } while (0)
#define DNB_STEP(cc, xA_, kA_, uC_, egl_) do { const size_t chs_ = (size_t)b * 512 + (cc) * 4 + h; \
        { u32x2 w; w.x = pk2(accS[0], accS[1]); w.y = pk2(accS[2], accS[3]); *(u32x2*)(scbase + chs_ * 16384) = w; }     \
        if (lo) { f32x4 accX = {0.f, 0.f, 0.f, 0.f}; \
            _Pragma("unroll") for (int k4 = 0; k4 < 4; ++k4) { const bf16x8 sB = *(const bf16x8*)(Sb + m16 * 136 + k4 * 32 + q4 * 8); accX = mfma16(xA_[k4], sB, accX); } \
            u32x2 w; w.x = pk2(bflo(uC_.x) - accX[0], bfhi(uC_.x) - accX[1]); w.y = pk2(bflo(uC_.y) - accX[2], bfhi(uC_.y) - accX[3]); \
            *(u32x2*)(Vn + m16 * 72 + wave * 16 + q4 * 4) = w; *(u32x2*)(vnbase + chs_ * 8192) = w; } \
        BAR_LDS(); \
        const bf16x8 vB0 = *(const bf16x8*)(Vn + m16 * 72 + q4 * 8), vB1 = *(const bf16x8*)(Vn + m16 * 72 + 32 + q4 * 8); \
        accS = accS * egl_; \
        accS = mfma16(kA_[0], vB0, accS); accS = mfma16(kA_[1], vB1, accS); \
        { u32x2 w; w.x = pk2(accS[0], accS[1]); w.y = pk2(accS[2], accS[3]); *(u32x2*)(Sb + m16 * 136 + wave * 16 + q4 * 4) = w; } \
        BAR_LDS(); } while (0)
    bf16x8 xA[4], kA[2]; u32x2 uA; float eglA;
    bf16x8 xB[4], kB[2]; u32x2 uB; float eglB;
    bf16x8 xC[4], kC[2]; u32x2 uC; float eglC;
    bf16x8 xD[4], kD[2]; u32x2 uD; float eglD;
    uA = uB = uC = uD = (u32x2){0u, 0u};
#pragma unroll
    for (int k4 = 0; k4 < 4; ++k4) xA[k4] = xB[k4] = xC[k4] = xD[k4] = (bf16x8){0, 0, 0, 0, 0, 0, 0, 0};
    DNB_LOAD(0, xA, kA, uA, eglA); DNB_LOAD(1, xB, kB, uB, eglB); DNB_LOAD(2, xC, kC, uC, eglC);
#pragma unroll 1
    for (int c = 0; c < 128; c += 4) {
        DNB_LOAD(c + 3, xD, kD, uD, eglD);
        DNB_STEP(c, xA, kA, uA, eglA);
        DNB_LOAD(c + 4, xA, kA, uA, eglA);
        DNB_STEP(c + 1, xB, kB, uB, eglB);
        DNB_LOAD(c + 5, xB, kB, uB, eglB);
        DNB_STEP(c + 2, xC, kC, uC, eglC);
        DNB_LOAD(c + 6, xC, kC, uC, eglC);
        DNB_STEP(c + 3, xD, kD, uD, eglD);
    }
#undef DNB_LOAD
#undef DNB_STEP
    {
        float* sp = state_out + ((size_t)(b * 4 + h) * 128 + wave * 16 + q4 * 4) * 128 + e0 + m16;
#pragma unroll
        for (int i = 0; i < 4; ++i) sp[i * 128] = accS[i];
    }
    __syncthreads();
}

__device__ __forceinline__ void dn_stepC(int tid, int unit, unsigned char* lds, const bf16* __restrict__ PROJ, const bf16* __restrict__ QE_, const bf16* __restrict__ AT_, const bf16* __restrict__ SC_, const bf16* __restrict__ VN_,
                                         const float* dn_norm, bf16* __restrict__ MIX) {
    asm volatile("" : "+v"(tid));
    const int lane = tid & 63, wave = tid >> 6, m16 = lane & 15, q4 = lane >> 4;
    const int h = unit & 3, c = (unit >> 2) & 127, b = unit >> 9;
    const size_t row0 = (size_t)b * SEQ + c * 64; const size_t ch = (size_t)unit;
    float* red = (float*)lds;
    bf16x8 scF[4], vnF[2], qeF[4][4], atF[4][2]; u32x2 zg[4];
#pragma unroll
    for (int k4 = 0; k4 < 4; ++k4) scF[k4] = *(const bf16x8*)(SC_ + ch * 16384 + (wave * 16 + m16) * 128 + k4 * 32 + q4 * 8);
#pragma unroll
    for (int k2 = 0; k2 < 2; ++k2) vnF[k2] = *(const bf16x8*)(VN_ + ch * 8192 + (wave * 16 + m16) * 64 + k2 * 32 + q4 * 8);
#pragma unroll
    for (int mt = 0; mt < 4; ++mt) {
#pragma unroll
        for (int k4 = 0; k4 < 4; ++k4) qeF[mt][k4] = *(const bf16x8*)(QE_ + ch * 8192 + (mt * 16 + m16) * 128 + k4 * 32 + q4 * 8);
#pragma unroll
        for (int k2 = 0; k2 < 2; ++k2) atF[mt][k2] = *(const bf16x8*)(AT_ + ch * 4096 + (mt * 16 + m16) * 64 + k2 * 32 + q4 * 8);
        zg[mt] = *(const u32x2*)(PROJ + (row0 + mt * 16 + m16) * NPE + 1536 + h * 128 + wave * 16 + q4 * 4);
    }
    f32x4 acc[4];
#pragma unroll
    for (int mt = 0; mt < 4; ++mt) {
        f32x4 a = {0.f, 0.f, 0.f, 0.f};
#pragma unroll
        for (int k4 = 0; k4 < 4; ++k4) a = mfma16(scF[k4], qeF[mt][k4], a);
#pragma unroll
        for (int k2 = 0; k2 < 2; ++k2) a = mfma16(vnF[k2], atF[mt][k2], a);
        acc[mt] = a;
        float ss = (a[0] * a[0] + a[1] * a[1]) + (a[2] * a[2] + a[3] * a[3]);
        ss += __shfl_xor(ss, 16); ss += __shfl_xor(ss, 32);
        if (q4 == 0) red[wave * 64 + mt * 16 + m16] = ss;
    }
    __syncthreads();
    const f32x4 gn = *(const f32x4*)(dn_norm + wave * 16 + q4 * 4);
#pragma unroll
    for (int mt = 0; mt < 4; ++mt) {
        const int t = mt * 16 + m16; float tot = 0.f;
#pragma unroll
        for (int w = 0; w < 8; ++w) tot += red[w * 64 + t];
        const float rstd = rsqrtf(tot * (1.f / 128.f) + EPS);
        const f32x4 a = acc[mt]; const u32x2 z = zg[mt];
        u32x2 w; w.x = pk2(a[0] * rstd * gn[0] * siluf(bflo(z.x)), a[1] * rstd * gn[1] * siluf(bfhi(z.x)));
        w.y = pk2(a[2] * rstd * gn[2] * siluf(bflo(z.y)), a[3] * rstd * gn[3] * siluf(bfhi(z.y)));
        *(u32x2*)(MIX + (row0 + t) * DM + h * 128 + wave * 16 + q4 * 4) = w;
    }
    __syncthreads();
}

__device__ __forceinline__ void swa_prompt(int tid, int unit, unsigned char* lds, const bf16* PROJ, const float* sinks, bf16* MIX) {
    asm volatile("" : "+v"(tid));
    const int lane = tid & 63, wave = tid >> 6, m16 = lane & 15, q4 = lane >> 4;
    const int qb = unit & 63, kvh = (unit >> 6) & 1, b = unit >> 7;
    const int p0 = qb * 128; const size_t rowb = (size_t)b * SEQ;
    bf16* Ks = (bf16*)lds;
    bf16* VsT = (bf16*)(lds + 39168);
    bf16* Pw = (bf16*)(lds + 75008 + wave * 5376);
    for (int i = 0; i < 4; ++i) {
        const int item = i * 512 + tid, key = item >> 3, dg = item & 7; const int pos = p0 - 128 + key;
        u32x4 kw = {0u, 0u, 0u, 0u}, vw = {0u, 0u, 0u, 0u};
        if (pos >= 0) { const bf16* pr = PROJ + (rowb + pos) * NPE + kvh * 64 + dg * 8; kw = *(const u32x4*)(pr + 2568); vw = *(const u32x4*)(pr + 2696); }
        *(u32x4*)(Ks + key * 72 + dg * 8) = kw;
        VsT[(dg * 8 + 0) * 280 + key] = (bf16)(vw.x & 0xffff); VsT[(dg * 8 + 1) * 280 + key] = (bf16)(vw.x >> 16);
        VsT[(dg * 8 + 2) * 280 + key] = (bf16)(vw.y & 0xffff); VsT[(dg * 8 + 3) * 280 + key] = (bf16)(vw.y >> 16);
        VsT[(dg * 8 + 4) * 280 + key] = (bf16)(vw.z & 0xffff); VsT[(dg * 8 + 5) * 280 + key] = (bf16)(vw.z >> 16);
        VsT[(dg * 8 + 6) * 280 + key] = (bf16)(vw.w & 0xffff); VsT[(dg * 8 + 7) * 280 + key] = (bf16)(vw.w >> 16);
    }
    { unsigned zz = 0u; asm volatile("" : "+v"(zz));
      if (tid < 128) { const int key = 256 + (tid >> 3), dg = tid & 7; *(u32x4*)(Ks + key * 72 + dg * 8) = (u32x4){zz, zz, zz, zz}; } }
    for (int i = tid; i < 64 * 24; i += 512) { const int d = i / 24, kk = 256 + i % 24; VsT[d * 280 + kk] = 0; }
    __syncthreads();
    const int g = wave >> 1, half = wave & 1, head = kvh * 4 + g;
    const float slope = exp2f(-(float)(head + 1)), sink = sinks[head];
#pragma unroll 1
    for (int mt4 = 0; mt4 < 4; ++mt4) {
        const int q0 = half * 64 + mt4 * 16;
        const bf16* qp = PROJ + (rowb + p0 + q0 + m16) * NPE + 2056 + head * 64 + q4 * 8;
        const bf16x8 qA0 = *(const bf16x8*)(qp), qA1 = *(const bf16x8*)(qp + 32);
        float sc[10][4];
#pragma unroll
        for (int kt = 0; kt < 10; ++kt) {
            const int j0 = q0 + kt * 16;
            const bf16x8 kB0 = *(const bf16x8*)(Ks + (j0 + m16) * 72 + q4 * 8), kB1 = *(const bf16x8*)(Ks + (j0 + m16) * 72 + 32 + q4 * 8);
            f32x4 acc = {0.f, 0.f, 0.f, 0.f};
            acc = mfma16(qA0, kB0, acc); acc = mfma16(qA1, kB1, acc);
            const int j = j0 + m16; const int pos = p0 - 128 + j;
#pragma unroll
            for (int i = 0; i < 4; ++i) { const int rel = q0 + q4 * 4 + i + 128 - j; const bool valid = rel >= 0 && rel < 128 && pos >= 0;
                sc[kt][i] = valid ? acc[i] * 0.125f - slope * (float)rel : -1e30f; }
        }
        float inv[4], mx[4];
#pragma unroll
        for (int i = 0; i < 4; ++i) {
            float m = sc[0][i];
#pragma unroll
            for (int kt = 1; kt < 10; ++kt) m = fmaxf(m, sc[kt][i]);
            m = fmaxf(max16(m), sink); mx[i] = m;
            float s = 0.f;
#pragma unroll
            for (int kt = 0; kt < 10; ++kt) { sc[kt][i] = __expf(sc[kt][i] - m); s += sc[kt][i]; }
            s = sum16(s) + __expf(sink - m);
            inv[i] = __builtin_amdgcn_rcpf(s);
        }
#pragma unroll
        for (int kt = 0; kt < 10; ++kt)
#pragma unroll
            for (int i = 0; i < 4; ++i) Pw[(q4 * 4 + i) * 168 + kt * 16 + m16] = (bf16)f2bf(sc[kt][i] * inv[i]);
        LDSWAIT();
        bf16x8 pA[5];
#pragma unroll
        for (int k5 = 0; k5 < 5; ++k5) pA[k5] = *(const bf16x8*)(Pw + m16 * 168 + k5 * 32 + q4 * 8);
#pragma unroll
        for (int nt = 0; nt < 4; ++nt) {
            f32x4 acc = {0.f, 0.f, 0.f, 0.f};
#pragma unroll
            for (int k5 = 0; k5 < 5; ++k5) { const bf16x8 vB = *(const bf16x8*)(VsT + (nt * 16 + m16) * 280 + q0 + k5 * 32 + q4 * 8); acc = mfma16(vB, pA[k5], acc); }
            u32x2 w; w.x = pk2(acc[0], acc[1]); w.y = pk2(acc[2], acc[3]);
            *(u32x2*)(MIX + (rowb + p0 + q0 + m16) * DM + 512 + head * 64 + nt * 16 + q4 * 4) = w;
        }
        LDSWAIT();
    }
    __syncthreads();
}

__device__ __forceinline__ void sample_even(int tid, int s, int el, unsigned char* lds, const bf16* PROJ, const float* state_dn, const float* state_conv, const float* cache_k, const float* cache_v,
                                            const float* conv_w, const float* a_log, const float* dt_bias, const float* dn_norm, const float* sinks, bf16* MIX, float* out) {
    asm volatile("" : "+v"(tid));
    const int lane = tid & 63, wave = tid >> 6;
    const size_t row = (size_t)MPR + s; const bf16* pr = PROJ + row * NPE;
    float* cv = (float*)lds;
    float* gsm = cv + 1536;
    float* red = gsm + 16;
    float* qsw = red + 16;
    float* knew = qsw + 512;
    float* vnew = knew + 128;
    float* scs = vnew + 128;
    {
        const float* cb = state_conv + ((size_t)el * MSA + s) * 3 * 1536;
        float* ob = out + O_SCONV + ((size_t)el * MSA + s) * 3 * 1536;
#pragma unroll
        for (int r = 0; r < 3; ++r) {
            const int chn = tid + r * 512;
            const float x3 = bf2f(pr[chn]), b0 = cb[chn], b1 = cb[1536 + chn], b2 = cb[3072 + chn];
            const float v = b0 * conv_w[chn] + b1 * conv_w[1536 + chn] + b2 * conv_w[3072 + chn] + x3 * conv_w[4608 + chn];
            cv[chn] = siluf(v);
            ob[chn] = b1; ob[1536 + chn] = b2; ob[3072 + chn] = x3;
        }
        qsw[tid] = bf2f(pr[2056 + tid]);
        if (tid < 128) { knew[tid] = bf2f(pr[2568 + tid]); vnew[tid] = bf2f(pr[2696 + tid]); }
        if (tid < 4) {
            const float a = bf2f(pr[2048 + tid]), bb = bf2f(pr[2052 + tid]);
            const float x = a + dt_bias[tid]; const float sp = x > 20.f ? x : __logf(1.f + __expf(x));
            gsm[tid] = __expf(-__expf(a_log[tid]) * sp); gsm[4 + tid] = __builtin_amdgcn_rcpf(1.f + __expf(-bb));
        }
    }
    __syncthreads();
    {
        const float a = cv[wave * 128 + lane], bq = cv[wave * 128 + 64 + lane];
        const float ss = wave_sum(a * a + bq * bq);
        const float sc = rsqrtf(ss + EPS) * (wave < 4 ? 0.08838834764831845f : 1.f);
        cv[wave * 128 + lane] = a * sc; cv[wave * 128 + 64 + lane] = bq * sc;
    }
    __syncthreads();
    if (wave < 4) { const float v = cv[wave * 128 + lane] * cv[512 + wave * 128 + lane] + cv[wave * 128 + 64 + lane] * cv[512 + wave * 128 + 64 + lane]; const float t_ = wave_sum(v); if (lane == 0) gsm[8 + wave] = t_; }
    __syncthreads();
#pragma unroll 1
    for (int p = 0; p < 2; ++p) {
        const int hl = tid >> 8, h = p * 2 + hl, dg = (tid >> 5) & 7, e4 = (tid & 31) * 4;
        const float* __restrict__ S = state_dn + (((size_t)el * MSA + s) * 4 + h) * 16384 + (size_t)(dg * 16) * 128 + e4;
        float* __restrict__ So = out + O_SDN + (((size_t)el * MSA + s) * 4 + h) * 16384 + (size_t)(dg * 16) * 128 + e4;
        const float* qh = cv + h * 128 + dg * 16; const float* kh = cv + 512 + h * 128 + dg * 16;
        float* part = vnew + 128 + 1024;
        f32x4 sv[16];
#pragma unroll
        for (int d = 0; d < 16; ++d) sv[d] = *(const f32x4*)(S + d * 128);
        f32x4 r = {0.f, 0.f, 0.f, 0.f}, qS = {0.f, 0.f, 0.f, 0.f};
#pragma unroll
        for (int d = 0; d < 16; ++d) { r += sv[d] * kh[d]; qS += sv[d] * qh[d]; }
        *(f32x4*)(part + ((hl * 8 + dg) * 128 + e4) * 2) = r; *(f32x4*)(part + ((hl * 8 + dg) * 128 + e4) * 2 + 4) = qS;
        __syncthreads();
        f32x4 rt = {0.f, 0.f, 0.f, 0.f}, qt = {0.f, 0.f, 0.f, 0.f};
#pragma unroll
        for (int g2 = 0; g2 < 8; ++g2) { rt += *(const f32x4*)(part + ((hl * 8 + g2) * 128 + e4) * 2); qt += *(const f32x4*)(part + ((hl * 8 + g2) * 128 + e4) * 2 + 4); }
        const float eg = gsm[h], beta = gsm[4 + h], qk = gsm[8 + h];
        const f32x4 vv4 = *(const f32x4*)(cv + 1024 + h * 128 + e4);
        const f32x4 vn = (vv4 - rt * eg) * beta;
        const f32x4 o = qt * eg + vn * qk;
#pragma unroll
        for (int d = 0; d < 16; ++d) *(f32x4*)(So + d * 128) = sv[d] * eg + vn * kh[d];
        float ss = (o.x * o.x + o.y * o.y) + (o.z * o.z + o.w * o.w);
        ss += __shfl_xor(ss, 1); ss += __shfl_xor(ss, 2); ss += __shfl_xor(ss, 4); ss += __shfl_xor(ss, 8); ss += __shfl_xor(ss, 16);
        const float rstd = rsqrtf(ss * (1.f / 128.f) + EPS);
        if (dg == 0) {
            const u32x2 zw = *(const u32x2*)(pr + 1536 + h * 128 + e4);
            const f32x4 nn = *(const f32x4*)(dn_norm + e4);
            u32x2 w; w.x = pk2(o.x * rstd * nn.x * siluf(bflo(zw.x)), o.y * rstd * nn.y * siluf(bfhi(zw.x)));
            w.y = pk2(o.z * rstd * nn.z * siluf(bflo(zw.y)), o.w * rstd * nn.w * siluf(bfhi(zw.y)));
            *(u32x2*)(MIX + row * DM + h * 128 + e4) = w;
        }
        __syncthreads();
    }
    {
        const float* ck = cache_k + ((size_t)el * MSA + s) * 16384; const float* cvv = cache_v + ((size_t)el * MSA + s) * 16384;
        const int head = tid >> 6, jj = tid & 63, kvh = head >> 2;
        const float slope = exp2f(-(float)(head + 1)); const float c125 = opq(0.125f);
#pragma unroll
        for (int r = 0; r < 2; ++r) {
            const int ci = jj + r * 64;
            float dot = 0.f;
            if (ci < 127) { const float* kp = ck + (ci + 1) * 128 + kvh * 64;
#pragma unroll
                for (int d4 = 0; d4 < 16; ++d4) { const f32x4 kv = *(const f32x4*)(kp + d4 * 4); const float* q = qsw + head * 64 + d4 * 4; dot += kv.x * q[0] + kv.y * q[1] + kv.z * q[2] + kv.w * q[3]; }
            } else {
#pragma unroll
                for (int d = 0; d < 64; ++d) dot += knew[kvh * 64 + d] * qsw[head * 64 + d];
            }
            scs[head * 128 + ci] = dot * c125 - slope * (float)(127 - ci);
        }
        __syncthreads();
        {
            const float sink = sinks[wave];
            const float v0 = scs[wave * 128 + lane], v1 = scs[wave * 128 + 64 + lane];
            const float m = fmaxf(wave_max(fmaxf(v0, v1)), sink);
            const float p0 = __expf(v0 - m), p1 = __expf(v1 - m);
            const float den = wave_sum(p0 + p1) + __expf(sink - m);
            scs[wave * 128 + lane] = p0 / den; scs[wave * 128 + 64 + lane] = p1 / den;
        }
        __syncthreads();
        {
            const int d = tid & 63; float o = 0.f;
#pragma unroll 8
            for (int ci = 0; ci < 127; ++ci) o += scs[head * 128 + ci] * cvv[(ci + 1) * 128 + kvh * 64 + d];
            o += scs[head * 128 + 127] * vnew[kvh * 64 + d];
            MIX[row * DM + 512 + head * 64 + d] = (bf16)f2bf(o);
        }
        float* __restrict__ ok = out + O_SK + ((size_t)el * MSA + s) * 16384; float* __restrict__ ov = out + O_SV + ((size_t)el * MSA + s) * 16384;
        f32x4 ck4[8], cv4[8];
#pragma unroll
        for (int i = 0; i < 8; ++i) { const int i4 = (i * 512 + tid) * 4; const bool past = i4 < 127 * 128;
            ck4[i] = past ? *(const f32x4*)(ck + i4 + 128) : *(const f32x4*)(knew + (i4 & 127));
            cv4[i] = past ? *(const f32x4*)(cvv + i4 + 128) : *(const f32x4*)(vnew + (i4 & 127)); }
#pragma unroll
        for (int i = 0; i < 8; ++i) { const int i4 = (i * 512 + tid) * 4; *(f32x4*)(ok + i4) = ck4[i]; *(f32x4*)(ov + i4) = cv4[i]; }
    }
    __syncthreads();
}
__device__ __forceinline__ void prompt_misc(int tid, int u, int el, const bf16* PROJ, float* out) {
    asm volatile("" : "+v"(tid));
    const int b = u & 1, which = u >> 1;
    float* o = out + (which ? O_PV : O_PK) + ((size_t)el * 2 + b) * 16384;
    for (int i = tid; i < 16384; i += 512) { const int j = i >> 7, rem = i & 127; o[i] = bf2f(PROJ[((size_t)b * SEQ + 8064 + j) * NPE + (which ? 2696 : 2568) + rem]); }
    if (which == 0) { float* oc = out + O_PCONV + ((size_t)el * 2 + b) * 4608;
        for (int i = tid; i < 4608; i += 512) { const int r = i / 1536, chn = i % 1536; oc[i] = bf2f(PROJ[((size_t)b * SEQ + 8189 + r) * NPE + chn]); } }
}

__device__ __forceinline__ void sample_odd(int tid, int s, int ol, unsigned char* lds, const bf16* PROJ, const float* state_gla, const float* Wg, const float* bg, const float* gla_norm, bf16* MIX, float* out) {
    asm volatile("" : "+v"(tid));
    const int lane = tid & 63, wave = tid >> 6;
    const size_t row = (size_t)MPR + s; const bf16* pr = PROJ + row * NPO;
    float* qv = (float*)lds; float* kv = qv + 512; float* egs = kv + 512; float* vv = egs + 512; float* red = vv + 1024;
    {
        float x = bg[tid];
#pragma unroll
        for (int j = 0; j < 16; ++j) x += bf2f(pr[3072 + j]) * Wg[j * 512 + tid];
        const float ls = fminf(x, 0.f) - __logf(1.f + __expf(-fabsf(x)));
        egs[tid] = __expf(ls * (1.f / 16.f));
        qv[tid] = bf2f(pr[tid]) * 0.08838834764831845f; kv[tid] = bf2f(pr[512 + tid]);
        vv[tid] = bf2f(pr[1024 + tid]); vv[tid + 512] = bf2f(pr[1536 + tid]);
    }
    __syncthreads();
    {
        const int h = tid >> 7, dg = (tid >> 6) & 1, e4 = (tid & 63) * 4;
        const float* __restrict__ S = state_gla + (((size_t)ol * MSA + s) * 4 + h) * 32768 + (size_t)(dg * 64) * 256 + e4;
        float* __restrict__ So = out + O_SGLA + (((size_t)ol * MSA + s) * 4 + h) * 32768 + (size_t)(dg * 64) * 256 + e4;
        const f32x4 v4 = *(const f32x4*)(vv + h * 256 + e4);
        const float* kd = kv + h * 128 + dg * 64; const float* ed = egs + h * 128 + dg * 64; const float* qd = qv + h * 128 + dg * 64;
        float* part = red + 16;
        f32x4 o = {0.f, 0.f, 0.f, 0.f};
#pragma unroll 1
        for (int d0 = 0; d0 < 64; d0 += 16) {
            f32x4 sv[16];
#pragma unroll
            for (int d = 0; d < 16; ++d) sv[d] = *(const f32x4*)(S + (d0 + d) * 256);
#pragma unroll
            for (int d = 0; d < 16; ++d) { const f32x4 n = sv[d] * ed[d0 + d] + v4 * kd[d0 + d]; *(f32x4*)(So + (d0 + d) * 256) = n; o += n * qd[d0 + d]; }
        }
        *(f32x4*)(part + (h * 2 + dg) * 256 + e4) = o;
        __syncthreads();
        const f32x4 ot = *(const f32x4*)(part + (h * 2) * 256 + e4) + *(const f32x4*)(part + (h * 2 + 1) * 256 + e4);
        const float ss = wave_sum((ot.x * ot.x + ot.y * ot.y) + (ot.z * ot.z + ot.w * ot.w));
        const float rstd = rsqrtf(ss * (1.f / 256.f) + EPS);
        if (dg == 0) {
            const u32x2 rw = *(const u32x2*)(pr + 2048 + h * 256 + e4);
            const f32x4 nn = *(const f32x4*)(gla_norm + e4);
            u32x2 w; w.x = pk2(ot.x * rstd * nn.x * siluf(bflo(rw.x)), ot.y * rstd * nn.y * siluf(bfhi(rw.x)));
            w.y = pk2(ot.z * rstd * nn.z * siluf(bflo(rw.y)), ot.w * rstd * nn.w * siluf(bfhi(rw.y)));
            *(u32x2*)(MIX + row * DM + h * 256 + e4) = w;
        }
    }
    __syncthreads();
}

__device__ __forceinline__ void gla_stepA(int tid, int unit, unsigned char* lds, const bf16* PROJ, const float* Wg, const float* bg, bf16* US_, bf16* QT_, bf16* OI, float* EGL_) {
    asm volatile("" : "+v"(tid));
    const int lane = tid & 63, wave = tid >> 6, m16 = lane & 15, q4 = lane >> 4;
    const int h = unit & 3, c = (unit >> 2) & 127, b = unit >> 9;
    const size_t row0 = (size_t)b * SEQ + c * 64; const size_t ch = (size_t)unit;
    float* Gs = (float*)lds;
    bf16* qs = (bf16*)(lds + 32768); bf16* ks = (bf16*)(lds + 50176);
    bf16* kT = (bf16*)(lds + 67584);
    bf16* vT = (bf16*)(lds + 86016);
    bf16* as = (bf16*)(lds + 122880);
    float* qt = (float*)(lds + 132096);
    float* gdl = (float*)(lds + 134144);
    u32x4 rq[4], rv[4];
    float wg[16];
    const unsigned short gd0 = PROJ[(row0 + (tid >> 4)) * NPO + 3072 + (tid & 15)], gd1 = PROJ[(row0 + 32 + (tid >> 4)) * NPO + 3072 + (tid & 15)];
#pragma unroll
    for (int j = 0; j < 16; ++j) wg[j] = Wg[j * 512 + h * 128 + (tid & 127)];
#pragma unroll
    for (int i = 0; i < 4; ++i) {
        const int item = i * 512 + tid, part = item >> 10, t = (item >> 4) & 63, cg = item & 15;
        rq[i] = *(const u32x4*)(PROJ + (row0 + t) * NPO + part * 512 + h * 128 + cg * 8);
        const int t2 = item >> 5, eg8 = item & 31;
        rv[i] = *(const u32x4*)(PROJ + (row0 + t2) * NPO + 1024 + h * 256 + eg8 * 8);
    }
    gdl[tid] = bf2f(gd0); gdl[tid + 512] = bf2f(gd1);
    __syncthreads();
    {
        const int d = tid & 127, tq = tid >> 7, col = h * 128 + d;
        const float bgc = bg[col]; float run = 0.f;
        float cum[16];
#pragma unroll
        for (int tt = 0; tt < 16; ++tt) {
            const int t = tq * 16 + tt; float x = bgc;
            const f32x4 gq0 = *(const f32x4*)(gdl + t * 16), gq1 = *(const f32x4*)(gdl + t * 16 + 4), gq2 = *(const f32x4*)(gdl + t * 16 + 8), gq3 = *(const f32x4*)(gdl + t * 16 + 12);
            x += gq0.x * wg[0] + gq0.y * wg[1] + gq0.z * wg[2] + gq0.w * wg[3];
            x += gq1.x * wg[4] + gq1.y * wg[5] + gq1.z * wg[6] + gq1.w * wg[7];
            x += gq2.x * wg[8] + gq2.y * wg[9] + gq2.z * wg[10] + gq2.w * wg[11];
            x += gq3.x * wg[12] + gq3.y * wg[13] + gq3.z * wg[14] + gq3.w * wg[15];
            const float ls = fminf(x, 0.f) - __logf(1.f + __expf(-fabsf(x)));
            run += ls * (1.f / 16.f);
            cum[tt] = run;
        }
        qt[tq * 128 + d] = run;
        __syncthreads();
        float off = 0.f;
#pragma unroll
        for (int q = 0; q < 3; ++q) off += (q < tq) ? qt[q * 128 + d] : 0.f;
#pragma unroll
        for (int tt = 0; tt < 16; ++tt) Gs[(tq * 16 + tt) * 128 + d] = cum[tt] + off;
    }
    __syncthreads();
    {
#pragma unroll
        for (int i = 0; i < 4; ++i) {
            const int item = i * 512 + tid, part = item >> 10, t = (item >> 4) & 63, cg = item & 15;
            float f[8]; unpack8(rq[i], f);
            float o[8];
            const f32x4 g0 = *(const f32x4*)(Gs + t * 128 + cg * 8), g1 = *(const f32x4*)(Gs + t * 128 + cg * 8 + 4), l0 = *(const f32x4*)(Gs + 63 * 128 + cg * 8), l1 = *(const f32x4*)(Gs + 63 * 128 + cg * 8 + 4);
            const float dls[8] = {g0.x - l0.x, g0.y - l0.y, g0.z - l0.z, g0.w - l0.w, g1.x - l1.x, g1.y - l1.y, g1.z - l1.z, g1.w - l1.w};
#pragma unroll
            for (int j = 0; j < 8; ++j) { const float dl = dls[j]; o[j] = part == 0 ? f[j] * 0.08838834764831845f * __expf(dl) : f[j] * __expf(-dl); }
            const u32x4 w = pack8(o);
            if (part == 0) { *(u32x4*)(qs + t * 136 + cg * 8) = w; *(u32x4*)(QT_ + ch * 8192 + t * 128 + cg * 8) = w; }
            else { *(u32x4*)(ks + t * 136 + cg * 8) = w;
#pragma unroll
                for (int j = 0; j < 8; ++j) kT[(cg * 8 + j) * 72 + (((t >> 3) ^ (cg & 7)) << 3) + (t & 7)] = (bf16)f2bf(o[j]); }
        }
#pragma unroll
        for (int i = 0; i < 4; ++i) {
            const int item = i * 512 + tid, t = item >> 5, eg8 = item & 31;
            const u32x4 w = rv[i];
            bf16* vp = vT + (eg8 * 8) * 72 + (((t >> 3) ^ (eg8 & 7)) << 3) + (t & 7);
            vp[0] = (bf16)(w.x & 0xffff); vp[72] = (bf16)(w.x >> 16); vp[144] = (bf16)(w.y & 0xffff); vp[216] = (bf16)(w.y >> 16);
            vp[288] = (bf16)(w.z & 0xffff); vp[360] = (bf16)(w.z >> 16); vp[432] = (bf16)(w.w & 0xffff); vp[504] = (bf16)(w.w >> 16);
        }
    }
    if (tid < 128) EGL_[ch * 128 + tid] = __expf(Gs[63 * 128 + tid]);
    __syncthreads();
    {
        const int mt = wave >> 1;
        bf16x8 aF[4];
#pragma unroll
        for (int k4 = 0; k4 < 4; ++k4) aF[k4] = *(const bf16x8*)(qs + (mt * 16 + m16) * 136 + k4 * 32 + q4 * 8);
#pragma unroll
        for (int n2 = 0; n2 < 2; ++n2) {
            const int nt = (wave & 1) * 2 + n2;
            f32x4 acc = {0.f, 0.f, 0.f, 0.f};
            if (nt <= mt) {
#pragma unroll
                for (int k4 = 0; k4 < 4; ++k4) { const bf16x8 bF = *(const bf16x8*)(ks + (nt * 16 + m16) * 136 + k4 * 32 + q4 * 8); acc = mfma16(aF[k4], bF, acc); }
            }
            const int s = nt * 16 + m16;
#pragma unroll
            for (int i = 0; i < 4; ++i) { const int t = mt * 16 + q4 * 4 + i; as[t * 72 + s] = (bf16)f2bf(t >= s ? acc[i] : 0.f); }
        }
    }
    {
        bf16x8 aF[2];
#pragma unroll
        for (int k2 = 0; k2 < 2; ++k2) { const int rr = wave * 16 + m16; aF[k2] = *(const bf16x8*)(kT + rr * 72 + (((k2 * 4 + q4) ^ ((rr >> 3) & 7)) << 3)); }
#pragma unroll 4
        for (int nt = 0; nt < 16; ++nt) {
            f32x4 acc = {0.f, 0.f, 0.f, 0.f};
#pragma unroll
            for (int k2 = 0; k2 < 2; ++k2) { const int rr = nt * 16 + m16; const bf16x8 bF = *(const bf16x8*)(vT + rr * 72 + (((k2 * 4 + q4) ^ ((rr >> 3) & 7)) << 3)); acc = mfma16(aF[k2], bF, acc); }
            u32x2 w; w.x = pk2(acc[0], acc[1]); w.y = pk2(acc[2], acc[3]);
            *(u32x2*)(US_ + ch * 32768 + (nt * 16 + m16) * 128 + wave * 16 + q4 * 4) = w;
        }
    }
    __syncthreads();
    {
        bf16x8 bF[2][2];
#pragma unroll
        for (int n2 = 0; n2 < 2; ++n2)
#pragma unroll
            for (int k2 = 0; k2 < 2; ++k2) { const int rr = (wave * 2 + n2) * 16 + m16; bF[n2][k2] = *(const bf16x8*)(vT + rr * 72 + (((k2 * 4 + q4) ^ ((rr >> 3) & 7)) << 3)); }
#pragma unroll
        for (int mt = 0; mt < 4; ++mt) {
            bf16x8 aF[2];
#pragma unroll
            for (int k2 = 0; k2 < 2; ++k2) aF[k2] = *(const bf16x8*)(as + (mt * 16 + m16) * 72 + k2 * 32 + q4 * 8);
#pragma unroll
            for (int n2 = 0; n2 < 2; ++n2) {
                f32x4 acc = {0.f, 0.f, 0.f, 0.f};
                acc = mfma16(bF[n2][0], aF[0], acc); acc = mfma16(bF[n2][1], aF[1], acc);
                u32x2 w; w.x = pk2(acc[0], acc[1]); w.y = pk2(acc[2], acc[3]);
                ((u32x2*)OI)[(((ch * 8 + wave) * 4 + mt) * 2 + n2) * 64 + lane] = w;
            }
        }
    }
    __syncthreads();
}

__device__ __forceinline__ void gla_scan(bf16* US_, const float* __restrict__ EGL_, float* __restrict__ state_out, int gtid, int ngt) {
    for (int idx = gtid; idx < 131072; idx += ngt) {
        const int dp = idx & 63, e = (idx >> 6) & 255, bh = idx >> 14, b = bh >> 2, h = bh & 3;
        float s0 = 0.f, s1 = 0.f;
        unsigned* p = (unsigned*)(US_ + ((size_t)b * 512 + h) * 32768 + e * 128 + dp * 2);
        const float* eg = EGL_ + ((size_t)b * 512 + h) * 128 + dp * 2;
        constexpr size_t PS = (size_t)4 * 32768 / 2, GS = (size_t)4 * 128;
        unsigned ua[8], ub[8]; f32x2v ga[8], gb[8];
#define GSC_LOAD(c0, u_, g_) do { _Pragma("unroll") for (int k = 0; k < 8; ++k) { const int cc = (c0) + k < 128 ? (c0) + k : 127; u_[k] = p[cc * PS]; g_[k] = *(const f32x2v*)(eg + cc * GS); } } while (0)
#define GSC_PROC(c0, u_, g_) do { _Pragma("unroll") for (int k = 0; k < 8; ++k) { s0 *= g_[k].x; s1 *= g_[k].y; p[((c0) + k) * PS] = pk2(s0, s1); s0 += bflo(u_[k]); s1 += bfhi(u_[k]); } } while (0)
        GSC_LOAD(0, ua, ga);
#pragma unroll 1
        for (int c0 = 0; c0 < 128; c0 += 16) {
            GSC_LOAD(c0 + 8, ub, gb);
            GSC_PROC(c0, ua, ga);
            GSC_LOAD(c0 + 16, ua, ga);
            GSC_PROC(c0 + 8, ub, gb);
        }
#undef GSC_LOAD
#undef GSC_PROC
        float* so = state_out + ((size_t)(b * 4 + h) * 128 + dp * 2) * 256 + e;
        so[0] = s0; so[256] = s1;
    }
}

__device__ __forceinline__ void gla_stepC(int tid, int unit, unsigned char* lds, const bf16* __restrict__ PROJ, const bf16* __restrict__ US_, const bf16* __restrict__ QT_, const bf16* __restrict__ OI, const float* gla_norm, bf16* __restrict__ MIX) {
    asm volatile("" : "+v"(tid));
    const int lane = tid & 63, wave = tid >> 6, m16 = lane & 15, q4 = lane >> 4;
    const int h = unit & 3, c = (unit >> 2) & 127, b = unit >> 9;
    const size_t row0 = (size_t)b * SEQ + c * 64; const size_t ch = (size_t)unit;
    float* red = (float*)lds;
    bf16x8 sB[2][4], aF[4][4]; u32x2 oi[4][2], rg[4][2];
#pragma unroll
    for (int n2 = 0; n2 < 2; ++n2)
#pragma unroll
        for (int k4 = 0; k4 < 4; ++k4) sB[n2][k4] = *(const bf16x8*)(US_ + ch * 32768 + ((wave * 2 + n2) * 16 + m16) * 128 + k4 * 32 + q4 * 8);
#pragma unroll
    for (int mt = 0; mt < 4; ++mt) {
#pragma unroll
        for (int k4 = 0; k4 < 4; ++k4) aF[mt][k4] = *(const bf16x8*)(QT_ + ch * 8192 + (mt * 16 + m16) * 128 + k4 * 32 + q4 * 8);
#pragma unroll
        for (int n2 = 0; n2 < 2; ++n2) { oi[mt][n2] = ((const u32x2*)OI)[(((ch * 8 + wave) * 4 + mt) * 2 + n2) * 64 + lane];
            rg[mt][n2] = *(const u32x2*)(PROJ + (row0 + mt * 16 + m16) * NPO + 2048 + h * 256 + (wave * 2 + n2) * 16 + q4 * 4); }
    }
    f32x4 acc[4][2];
#pragma unroll
    for (int mt = 0; mt < 4; ++mt) {
        float ss = 0.f;
#pragma unroll
        for (int n2 = 0; n2 < 2; ++n2) {
            f32x4 a = {bflo(oi[mt][n2].x), bfhi(oi[mt][n2].x), bflo(oi[mt][n2].y), bfhi(oi[mt][n2].y)};
#pragma unroll
            for (int k4 = 0; k4 < 4; ++k4) a = mfma16(sB[n2][k4], aF[mt][k4], a);
            acc[mt][n2] = a;
            ss += (a[0] * a[0] + a[1] * a[1]) + (a[2] * a[2] + a[3] * a[3]);
        }
        ss += __shfl_xor(ss, 16); ss += __shfl_xor(ss, 32);
        if (q4 == 0) red[wave * 64 + mt * 16 + m16] = ss;
    }
    __syncthreads();
    f32x4 gn[2];
#pragma unroll
    for (int n2 = 0; n2 < 2; ++n2) gn[n2] = *(const f32x4*)(gla_norm + (wave * 2 + n2) * 16 + q4 * 4);
#pragma unroll
    for (int mt = 0; mt < 4; ++mt) {
        const int t = mt * 16 + m16; float tot = 0.f;
#pragma unroll
        for (int w = 0; w < 8; ++w) tot += red[w * 64 + t];
        const float rstd = rsqrtf(tot * (1.f / 256.f) + EPS);
#pragma unroll
        for (int n2 = 0; n2 < 2; ++n2) {
            const f32x4 a = acc[mt][n2]; const u32x2 r = rg[mt][n2];
            u32x2 w; w.x = pk2(a[0] * rstd * gn[n2][0] * siluf(bflo(r.x)), a[1] * rstd * gn[n2][1] * siluf(bfhi(r.x)));
            w.y = pk2(a[2] * rstd * gn[n2][2] * siluf(bflo(r.y)), a[3] * rstd * gn[n2][3] * siluf(bfhi(r.y)));
            *(u32x2*)(MIX + (row0 + t) * DM + h * 256 + (wave * 2 + n2) * 16 + q4 * 4) = w;
        }
    }
    __syncthreads();
}

template <int MODE>
__device__ __forceinline__ void skinny_unit(int tid, const bf16* A, const bf16* Bt, int K, int ld, size_t row0, int col0, void* C, int ldc, float sgn = 1.f) {
    asm volatile("" : "+v"(tid));
    const int lane = tid & 63, wave = tid >> 6, m16 = lane & 15, q4 = lane >> 4;
    const bf16* ap = A + (row0 + wave * 16 + m16) * ld + q4 * 8;
    const bf16* bp = Bt + (size_t)(col0 + m16) * ld + q4 * 8;
    f32x4 acc0 = {0.f, 0.f, 0.f, 0.f}, acc1 = {0.f, 0.f, 0.f, 0.f};
#pragma unroll 1
    for (int k = 0; k < K; k += 256) {
        bf16x8 av[8], bv[8];
#pragma unroll
        for (int j = 0; j < 8; ++j) { av[j] = *(const bf16x8*)(ap + k + j * 32); bv[j] = *(const bf16x8*)(bp + k + j * 32); }
#pragma unroll
        for (int j = 0; j < 8; j += 2) { acc0 = mfma16(av[j], bv[j], acc0); acc1 = mfma16(av[j + 1], bv[j + 1], acc1); }
    }
    const f32x4 acc = acc0 + acc1;
    const size_t r = row0 + wave * 16 + q4 * 4; const int c = col0 + m16;
#pragma unroll
    for (int i = 0; i < 4; ++i) {
        if (MODE == 3) { atomicAdd((float*)C + (r + i) * ldc + c, acc[i] * sgn); }
        else { float v = acc[i]; if (MODE == 2) { v = v > 0.f ? v : 0.f; v = v * v; } ((bf16*)C)[(r + i) * ldc + c] = (bf16)f2bf(v); }
    }
}

__device__ __forceinline__ void skinny_res(int tid, int unit, unsigned char* lds, const bf16* __restrict__ A, const bf16* __restrict__ Bt, int K, float* __restrict__ X) {
    asm volatile("" : "+v"(tid));
    const int lane = tid & 63, wave = tid >> 6, m16 = lane & 15, q4 = lane >> 4;
    const int rg = unit >> 6, ct = unit & 63, rt = wave & 1, ksl = wave >> 1, Ks = K >> 2;
    const bf16* ap = A + ((size_t)MPR + rg * 32 + rt * 16 + m16) * K + ksl * Ks + q4 * 8;
    const bf16* bp = Bt + (size_t)(ct * 16 + m16) * K + ksl * Ks + q4 * 8;
    f32x4 acc0 = {0.f, 0.f, 0.f, 0.f}, acc1 = {0.f, 0.f, 0.f, 0.f};
#pragma unroll 1
    for (int k = 0; k < Ks; k += 256) {
        bf16x8 av[8], bv[8];
#pragma unroll
        for (int j = 0; j < 8; ++j) { av[j] = *(const bf16x8*)(ap + k + j * 32); bv[j] = *(const bf16x8*)(bp + k + j * 32); }
#pragma unroll
        for (int j = 0; j < 8; j += 2) { acc0 = mfma16(av[j], bv[j], acc0); acc1 = mfma16(av[j + 1], bv[j + 1], acc1); }
    }
    f32x4* red = (f32x4*)lds;
    red[wave * 64 + lane] = acc0 + acc1;
    __syncthreads();
    if (ksl == 0) {
        const f32x4 t = (red[rt * 64 + lane] + red[(2 + rt) * 64 + lane]) + (red[(4 + rt) * 64 + lane] + red[(6 + rt) * 64 + lane]);
        float* xp = X + ((size_t)MPR + rg * 32 + rt * 16 + q4 * 4) * DM + ct * 16 + m16;
#pragma unroll
        for (int i = 0; i < 4; ++i) xp[i * DM] += t[i];
    }
    __syncthreads();
}

#define LAS __attribute__((address_space(3)))
#define XB_TMO      128
#define XB_XCNT(j)  (256  + 64 * (j))
#define XB_XSUB(j)  (1280 + 64 * (j))
#define XB_XGEN(j)  (2304 + 64 * (j))
#define XB_TOP      3328
#define XB_TOPGEN   3392
#define XCD_BAR_WORDS 3456
#define XB_SPIN_CAP (1u << 18)

__device__ __forceinline__ unsigned xb_ld(unsigned* p)              { return __hip_atomic_load(p, __ATOMIC_RELAXED, __HIP_MEMORY_SCOPE_AGENT); }
__device__ __forceinline__ unsigned xb_add(unsigned* p, unsigned v) { return __hip_atomic_fetch_add(p, v, __ATOMIC_RELAXED, __HIP_MEMORY_SCOPE_AGENT); }
__device__ __forceinline__ unsigned xb_xcc_id() { return (unsigned)__builtin_amdgcn_s_getreg((3 << 11) | 20) & 0xFu; }
#define XB_SPIN(cond, bar) do { unsigned _sp = 0; while (cond) { __builtin_amdgcn_s_sleep(1); \
    if ((++_sp & 255u) == 0u) { if (xb_ld(&(bar)[XB_TMO])) break; if (_sp > XB_SPIN_CAP) { atomicAdd(&(bar)[XB_TMO], 1u); break; } } } } while (0)

struct XcdBarrier {
    unsigned* bar; unsigned x;
    volatile LAS unsigned* st;
};

__device__ __forceinline__ XcdBarrier xcd_barrier_post(unsigned* bar, volatile LAS unsigned* st) {
    XcdBarrier b; b.bar = bar; b.x = xb_xcc_id(); b.st = st;
    if (threadIdx.x == 0) (void)xb_add(&bar[XB_XCNT(b.x)], 1u);
    return b;
}
__device__ __forceinline__ void xcd_barrier_complete(unsigned* bar, unsigned x, unsigned& nloc, unsigned& nx) {
    const unsigned G = gridDim.x * gridDim.y * gridDim.z;
    unsigned sum, cnt, mine, sp = 0u;
    for (;;) {
        sum = 0u; cnt = 0u; mine = 0u;
#pragma unroll
        for (unsigned j = 0; j < 16; ++j) { const unsigned c = xb_ld(&bar[XB_XCNT(j)]); sum += c; cnt += (c > 0u) ? 1u : 0u; mine = (j == x) ? c : mine; }
        if (sum == G) break;
        __builtin_amdgcn_s_sleep(1);
        if ((++sp & 255u) == 0u) { if (xb_ld(&bar[XB_TMO])) break; if (sp > XB_SPIN_CAP) { atomicAdd(&bar[XB_TMO], 1u); break; } }
    }
    nloc = mine > 0u ? mine : 1u; nx = cnt > 0u ? cnt : 1u;
}

__device__ __forceinline__ void xcd_barrier(const XcdBarrier& b) {
    asm volatile("s_waitcnt vmcnt(0)" ::: "memory");
    __syncthreads();
    if (threadIdx.x == 0) {
        unsigned* bar = b.bar;
        __builtin_amdgcn_s_waitcnt(0);
        unsigned nloc = b.st[0], nx = b.st[1];
        if (nloc == 0u) { xcd_barrier_complete(bar, b.x, nloc, nx); b.st[0] = nloc; b.st[1] = nx; }
        const unsigned old = xb_add(&bar[XB_XSUB(b.x)], 1u);
        const unsigned gen = old / nloc;
        if (old + 1u == (gen + 1u) * nloc) {
            __builtin_amdgcn_fence(__ATOMIC_RELEASE, "agent");
            asm volatile("s_waitcnt vmcnt(0)" ::: "memory");
            const unsigned og = xb_add(&bar[XB_TOP], 1u);
            const unsigned tg = og / nx;
            if (og + 1u == (tg + 1u) * nx) xb_add(&bar[XB_TOPGEN], 1u);
            else XB_SPIN(xb_ld(&bar[XB_TOPGEN]) == tg, bar);
            __builtin_amdgcn_fence(__ATOMIC_ACQUIRE, "agent");
            xb_add(&bar[XB_XGEN(b.x)], 1u);
            asm volatile("s_waitcnt vmcnt(0)" ::: "memory");
        } else {
            XB_SPIN(xb_ld(&bar[XB_XGEN(b.x)]) == gen, bar);
            __builtin_amdgcn_fence(__ATOMIC_ACQUIRE, "agent");
            asm volatile("s_waitcnt vmcnt(0)" ::: "memory");
        }
    }
    __syncthreads();
}

#ifndef PROBE_ID
#define PROBE_ID 0
#endif
constexpr size_t WS_TAB = 4096, WS_BAR = 16384;
constexpr int LDS_BARW = 147392;
__global__ void __launch_bounds__(512, 2) mega_fwd(Args a) {
    extern __shared__ __attribute__((aligned(16))) unsigned char lds[];
    const bool coop = (a.ph_hi - a.ph_lo) > 1;
    if (threadIdx.x < 4) ((LAS unsigned*)((LAS unsigned char*)lds + LDS_BARW))[threadIdx.x] = 0u;
    __syncthreads();
    XcdBarrier xbar; xbar.bar = (unsigned*)(a.ws + WS_BAR); xbar.x = 0; xbar.st = nullptr;
    if (coop) xbar = xcd_barrier_post((unsigned*)(a.ws + WS_BAR), (volatile LAS unsigned*)((LAS unsigned char*)lds + LDS_BARW));
#if PROBE_ID
    bool repeated = false; int repcnt = 0; unsigned donemask = 0u;
#endif
#pragma unroll 1
    for (int ph = a.ph_lo; ph < a.ph_hi; ++ph) {
        int tid = threadIdx.x; asm volatile("" : "+v"(tid));
        int bid = blockIdx.x; asm volatile("" : "+s"(bid));
        unsigned char* ws = a.ws; asm volatile("" : "+s"(ws));
        float* outp = a.out; asm volatile("" : "+s"(outp));
        const int lane = tid & 63, wave = tid >> 6;
        const int G = gridDim.x;
        const int gw = bid * 8 + wave, ngw = G * 8;
        bf16* WEI = (bf16*)(ws + WS_WEI); bf16* WEO = (bf16*)(ws + WS_WEO); bf16* WGI = (bf16*)(ws + WS_WGI); bf16* WGO = (bf16*)(ws + WS_WGO);
        bf16* WUP = (bf16*)(ws + WS_WUP); bf16* WDN = (bf16*)(ws + WS_WDN);
        float* X = (float*)(ws + WS_X); bf16* HB = (bf16*)(ws + WS_HB); bf16* MIX = (bf16*)(ws + WS_MIX);
        bf16* PROJ = (bf16*)(ws + WS_BIG); bf16* HID = (bf16*)(ws + WS_BIG);
        const float* const* in = (const float* const*)(ws + WS_TAB);
        if (ph == 0) {
            if (bid == 0 && tid == 0) { const float** tw = (const float**)(ws + WS_TAB);
#pragma unroll
                for (int k = 0; k < 24; ++k) tw[k] = a.in[k]; }
            float* scr = (float*)(lds + wave * 16640);
            transpose_w(a.in[10], DM, NE_IN, NPE, WEI, scr, gw, ngw, lane);
            transpose_w(a.in[16], DM, DM, DM, WEO, scr, gw, ngw, lane);
            transpose_w(a.in[22], DM, FF, FF, WUP, scr, gw, ngw, lane);
            transpose_w(a.in[23], FF, DM, DM, WDN, scr, gw, ngw, lane);
            for (int m = gw; m < MPAD; m += ngw) {
                f32x4 v[4];
                const float* src = m < MPR ? a.in[0] + (size_t)m * DM : (m < MREAL ? a.in[1] + (size_t)(m - MPR) * DM : nullptr);
#pragma unroll
                for (int j = 0; j < 4; ++j) { v[j] = src ? *(const f32x4*)(src + 4 * lane + 256 * j) : (f32x4){0.f, 0.f, 0.f, 0.f}; if (m >= MPR) *(f32x4*)(X + (size_t)m * DM + 4 * lane + 256 * j) = v[j]; }
                norm_row(v, a.in[7], HB + (size_t)m * DM, nullptr, lane);
                if (m >= MREAL) {
#pragma unroll
                    for (int j = 0; j < 4; ++j) { u32x2 z = {0u, 0u}; *(u32x2*)(MIX + (size_t)m * DM + 4 * lane + 256 * j) = z; }
                }
            }
        } else {
            const int l = (ph - 1) / 9, sp = (ph - 1) % 9, even = !(l & 1), li = l >> 1;
            if (sp == 0) {
                const bf16* Bt = even ? WEI + (size_t)li * NPE * DM : WGI + (size_t)li * NPO * DM; const int ldp = even ? NPE : NPO;
                pg8::Gemm g{HB, Bt, MPR, 3072, DM};
                pg8::StaticOrder S; S.init(g.M, g.N, G, bid);
                pg8::EpiBf16<0> E{PROJ, ldp};
                pg8::gemm_phase<pg8::EpiBf16<0>, pg8::StaticOrder, true, true>((PG8_LAS unsigned char*)lds, g, S, E);
                const int nts = even ? 177 : 193, nsk = even ? nts : nts + 128;
                for (int u = bid; u < nsk; u += G) {
                    if (u < nts) skinny_unit<0>(tid, HB, Bt, DM, DM, (size_t)MPR, u * 16, PROJ, ldp);
                    else skinny_unit<0>(tid, HB, Bt, DM, DM, (size_t)(u - nts) * 128, 3072, PROJ, ldp);
                }
            } else if (sp == 1) {
                if (even) {
                    const float* cw = in[11] + (size_t)li * 4 * 1536; const float* al = in[12] + li * 4; const float* dtb = in[13] + li * 4;
                    for (int u = bid; u < 1024; u += G)
                        dn_stepA(tid, u, lds, PROJ, cw, al, dtb,
                                 (bf16*)(ws + SC_DN_W), (bf16*)(ws + SC_DN_QE), (bf16*)(ws + SC_DN_KT), (bf16*)(ws + SC_DN_AT), (bf16*)(ws + SC_DN_U), (float*)(ws + SC_DN_EGL));
                } else {
                    const float* wg = in[18] + (size_t)li * 16 * 512; const float* bgp = in[19] + li * 512;
                    for (int u = bid; u < 1024; u += G)
                        gla_stepA(tid, u, lds, PROJ, wg, bgp, (bf16*)(ws + SC_GL_US), (bf16*)(ws + SC_GL_QT), (bf16*)(ws + SC_GL_OI), (float*)(ws + SC_GL_EGL));
                }
            } else if (sp == 2) {
                if (even) {
                    const int nb = G > 64 ? 64 : G;
#if PROBE_ID == 12
                    if (!repeated)
#endif
                    if (bid < nb) { for (int it = bid; it < 64; it += nb)
                        dn_stepB(tid, it, lds, (const bf16*)(ws + SC_DN_W), (const bf16*)(ws + SC_DN_KT), (const bf16*)(ws + SC_DN_U),
                                 (const float*)(ws + SC_DN_EGL), (bf16*)(ws + SC_DN_O), (bf16*)(ws + SC_DN_VN), outp + O_PDN + (size_t)li * 2 * 4 * 16384); }
                    const int ob = G > 64 ? bid - 64 : bid, on = G > 64 ? G - 64 : G;
#if PROBE_ID == 11
                    if (!repeated)
#endif
                    if (ob >= 0) {
                        const float* sdn = in[2]; const float* scv = in[3]; const float* ckp = in[4]; const float* cvp = in[5];
                        const float* cw = in[11] + (size_t)li * 4 * 1536; const float* al = in[12] + li * 4; const float* dtb = in[13] + li * 4;
                        const float* dnn = in[14] + li * 128; const float* snk = in[15] + li * 8;
                        for (int u = ob; u < 256 + MSA + 4; u += on) {
                            if (u < 256) swa_prompt(tid, u, lds, PROJ, snk, MIX);
                            else if (u < 256 + MSA) sample_even(tid, u - 256, li, lds, PROJ, sdn, scv, ckp, cvp, cw, al, dtb, dnn, snk, MIX, outp);
                            else prompt_misc(tid, u - 256 - MSA, li, PROJ, outp);
                        }
                        if (l == 0) {
                            float* scr = (float*)(lds + wave * 16640);
                            const int gw2 = ob * 8 + wave, ngw2 = on * 8;
                            transpose_w(in[17], DM, NO_IN, NPO, WGI, scr, gw2, ngw2, lane);
                            transpose_w(in[21], DM, DM, DM, WGO, scr, gw2, ngw2, lane);
                            transpose_w(in[22] + (size_t)1 * DM * FF, DM, FF, FF, WUP + (size_t)1 * FF * DM, scr, gw2, ngw2, lane);
                            transpose_w(in[23] + (size_t)1 * FF * DM, FF, DM, DM, WDN + (size_t)1 * DM * FF, scr, gw2, ngw2, lane);
                            transpose_w(in[10] + (size_t)DM * NE_IN, DM, NE_IN, NPE, WEI + (size_t)NPE * DM, scr, gw2, ngw2, lane);
                            transpose_w(in[16] + (size_t)DM * DM, DM, DM, DM, WEO + (size_t)DM * DM, scr, gw2, ngw2, lane);
                            transpose_w(in[22] + (size_t)2 * DM * FF, DM, FF, FF, WUP + (size_t)2 * FF * DM, scr, gw2, ngw2, lane);
                            transpose_w(in[23] + (size_t)2 * FF * DM, FF, DM, DM, WDN + (size_t)2 * DM * FF, scr, gw2, ngw2, lane);
                            __syncthreads();
                        }
                        if (l == 2) {
                            float* scr = (float*)(lds + wave * 16640);
                            const int gw2 = ob * 8 + wave, ngw2 = on * 8;
                            transpose_w(in[17] + (size_t)DM * NO_IN, DM, NO_IN, NPO, WGI + (size_t)NPO * DM, scr, gw2, ngw2, lane);
                            transpose_w(in[21] + (size_t)DM * DM, DM, DM, DM, WGO + (size_t)DM * DM, scr, gw2, ngw2, lane);
                            transpose_w(in[22] + (size_t)3 * DM * FF, DM, FF, FF, WUP + (size_t)3 * FF * DM, scr, gw2, ngw2, lane);
                            transpose_w(in[23] + (size_t)3 * FF * DM, FF, DM, DM, WDN + (size_t)3 * DM * FF, scr, gw2, ngw2, lane);
                            __syncthreads();
                        }
                    }
                } else {
                    const int nsc = G >= 2 ? G / 2 : G;
                    if (bid < nsc) gla_scan((bf16*)(ws + SC_GL_US), (const float*)(ws + SC_GL_EGL), outp + O_PGLA + (size_t)li * 2 * 4 * 32768, bid * 512 + tid, nsc * 512);
                    if (G < 2 || bid >= nsc) {
                        const float* wg = in[18] + (size_t)li * 16 * 512; const float* bgp = in[19] + li * 512; const float* gn = in[20] + li * 256; const float* sg = in[6];
                        const int ob = G >= 2 ? bid - nsc : 0, on = G >= 2 ? G - nsc : 1;
                        for (int u = ob; u < MSA; u += on) sample_odd(tid, u, li, lds, PROJ, sg, wg, bgp, gn, MIX, outp);
                    }
                }
            } else if (sp == 3) {
                if (even) { const float* dnn = in[14] + li * 128;
                    for (int u = bid; u < 1024; u += G) dn_stepC(tid, u, lds, PROJ, (const bf16*)(ws + SC_DN_QE), (const bf16*)(ws + SC_DN_AT), (const bf16*)(ws + SC_DN_O), (const bf16*)(ws + SC_DN_VN), dnn, MIX); }
                else { const float* gn = in[20] + li * 256;
                    for (int u = bid; u < 1024; u += G) gla_stepC(tid, u, lds, PROJ, (const bf16*)(ws + SC_GL_US), (const bf16*)(ws + SC_GL_QT), (const bf16*)(ws + SC_GL_OI), gn, MIX); }
            } else if (sp == 4 || sp == 7) {
                pg8::Gemm g{sp == 4 ? MIX : HID, sp == 4 ? (even ? WEO : WGO) + (size_t)li * DM * DM : WDN + (size_t)l * DM * FF, MPR, DM, sp == 4 ? DM : FF};
                pg8::StaticOrder S; S.init(g.M, g.N, G, bid);
#if PROBE_ID == 13 || PROBE_ID == 14
                const float sgn = (repcnt == 1) ? -1.f : 1.f;
#else
                const float sgn = 1.f;
#endif
                pg8::EpiRes E{X, DM, sgn, (l == 0 && sp == 4) ? in[0] : (const float*)X};
                pg8::gemm_phase<pg8::EpiRes, pg8::StaticOrder, true, true>((PG8_LAS unsigned char*)lds, g, S, E);
                for (int u = bid; u < 256; u += G) skinny_res(tid, u, lds, g.A, g.Bt, g.K, X);
            } else if (sp == 5) {
                norm_phase(X, in[8] + l * DM, HB, nullptr, gw, ngw, lane);
            } else if (sp == 6) {
                pg8::Gemm g{HB, WUP + (size_t)l * FF * DM, MPR, FF, DM};
                pg8::StaticOrder S; S.init(g.M, g.N, G, bid);
                pg8::EpiBf16<2> E{HID, FF};
                pg8::gemm_phase<pg8::EpiBf16<2>, pg8::StaticOrder, true, true>((PG8_LAS unsigned char*)lds, g, S, E);
                for (int u = bid; u < 256; u += G) skinny_unit<2>(tid, g.A, g.Bt, DM, DM, (size_t)MPR, u * 16, HID, FF);
            } else {
                if (l < 3) norm_phase(X, in[7] + (l + 1) * DM, HB, nullptr, gw, ngw, lane);
                else norm_phase(X, in[9], nullptr, outp + O_Y, gw, ngw, lane);
            }
        }
#if PROBE_ID
        if (coop) {
            const int l_ = (ph - 1) / 9, sp_ = (ph - 1) % 9, ev_ = !(l_ & 1);
            bool rp = false;
            if (PROBE_ID == 1) xcd_barrier(xbar);
            if (PROBE_ID == 2 && ph == 0) rp = true;
            if (ph > 0) {
                if (PROBE_ID == 3 && ev_ && sp_ == 1) rp = true;
                if ((PROBE_ID == 4 || PROBE_ID == 11 || PROBE_ID == 12) && ev_ && sp_ == 2) rp = true;
                if (PROBE_ID == 5 && !ev_ && sp_ == 1) rp = true;
                if (PROBE_ID == 6 && sp_ == 0) rp = true;
                if (PROBE_ID == 7 && sp_ == 6) rp = true;
                if (PROBE_ID == 8 && !ev_ && sp_ == 3) rp = true;
                if (PROBE_ID == 9 && (sp_ == 5 || sp_ == 8)) rp = true;
                if (PROBE_ID == 10 && ev_ && sp_ == 3) rp = true;
            }
            if ((PROBE_ID == 13 && ph > 0 && sp_ == 4) || (PROBE_ID == 14 && ph > 0 && sp_ == 7)) { if (repcnt < 2) { ++repcnt; --ph; xcd_barrier(xbar); continue; } repcnt = 0; }
            if (PROBE_ID == 15 && ph > 0 && !ev_ && sp_ == 2 && !((donemask >> l_) & 1u)) { donemask |= 1u << l_; ph -= 2; xcd_barrier(xbar); continue; }
            if (rp && !repeated) { repeated = true; --ph; xcd_barrier(xbar); continue; }
            repeated = false;
        }
#endif
        if (ph + 1 < a.ph_hi) { if (coop) xcd_barrier(xbar); }
    }
}

extern "C" void kernel_launch(void* const* d_in, const int* in_sizes, int n_in, void* d_out, int out_size, void* d_ws, size_t ws_size, hipStream_t stream) {
    static int grid = 0;
    if (grid == 0) {
        int dev = 0, cus = 0, per_cu = 0;
        hipGetDevice(&dev);
        hipDeviceGetAttribute(&cus, hipDeviceAttributeMultiprocessorCount, dev);
        hipFuncSetAttribute((const void*)mega_fwd, hipFuncAttributeMaxDynamicSharedMemorySize, LDS_BYTES);
        hipOccupancyMaxActiveBlocksPerMultiprocessor(&per_cu, (const void*)mega_fwd, 512, LDS_BYTES);
        if (per_cu < 1) { fprintf(stderr, "kernel_launch: occupancy query says %d blocks/CU\n", per_cu); per_cu = 1; }
        grid = cus * (per_cu > 1 ? 1 : per_cu);
        if (ws_size < WS_END) { fprintf(stderr, "kernel_launch: workspace too small: %zu < %zu\n", ws_size, (size_t)WS_END); grid = -1; }
        if (n_in != 24) { fprintf(stderr, "kernel_launch: expected 24 inputs, got %d\n", n_in); grid = -1; }
    }
    if (grid < 0) return;
    Args a{};
    for (int i = 0; i < 24; ++i) a.in[i] = (const float*)d_in[i];
    a.out = (float*)d_out; a.ws = (unsigned char*)d_ws;
#if MK_LAUNCH_PER_PHASE
    for (int ph = 0; ph < NPH; ++ph) { a.ph_lo = ph; a.ph_hi = ph + 1; hipLaunchKernelGGL(mega_fwd, dim3(grid), dim3(512), LDS_BYTES, stream, a); }
#else
    a.ph_lo = 0; a.ph_hi = NPH;
    if (hipMemsetAsync((char*)d_ws + WS_BAR, 0, 16384, stream) != hipSuccess) { fprintf(stderr, "kernel_launch: memset of barrier words failed\n"); return; }
    void* args[] = {&a};
    hipError_t e = hipLaunchCooperativeKernel((const void*)mega_fwd, dim3(grid), dim3(512), args, LDS_BYTES, stream);
    if (e != hipSuccess) fprintf(stderr, "cooperative launch failed: %s (grid %d)\n", hipGetErrorString(e), grid);
#endif
}
```

```cpp
#include <hip/hip_runtime.h>
#include <hip/hip_cooperative_groups.h>
#include <cstdio>
#include <cstdint>
namespace cg = cooperative_groups;
#ifndef MK_LAUNCH_PER_PHASE
#define MK_LAUNCH_PER_PHASE 0
#endif
namespace pg8 {
#define PG8_LAS __attribute__((address_space(3)))
typedef unsigned short bf16_t;
typedef short bf16x8 __attribute__((ext_vector_type(8)));
typedef float f32x4 __attribute__((ext_vector_type(4)));
typedef unsigned u32x4 __attribute__((ext_vector_type(4)));
constexpr int BM = 256, BK = 64, HALF = 128, HTB = HALF * BK * 2  , STAGE_BYTES = 8 * HTB, NXCD = 8, WGM = 8;

__host__ __device__ __forceinline__ int lds_byte(int r, int c) { const int st = (r >> 4) * 2 + (c >> 5), rr = r & 15, cc = c & 31, ob = rr * 64 + cc * 2; return st * 1024 + (ob ^ (((ob >> 9) & 1) << 5)); }
__host__ __device__ __forceinline__ void stage_rc(int b, int& R, int& C) { const int st = b / 1024, sb = b % 1024, swz = sb ^ (((sb >> 9) & 1) << 5); R = (st >> 1) * 16 + swz / 64; C = (st & 1) * 32 + (swz % 64) / 2; }
__host__ __device__ __forceinline__ int perm32(int rho) { const int n = rho >> 4, i = rho & 15; return 8 * (i >> 2) + 4 * n + (i & 3); }

struct Unit { int pm, pn; };
struct Gemm { const bf16_t* A; const bf16_t* Bt; int M, N, K; };

struct StaticOrder {
    int nM, nN, nwg, G, c;
    __host__ __device__ void init(int M, int N, int G_, int c_) { nM = M / BM; nN = N / BM; nwg = nM * nN; G = G_; c = c_; }
    __host__ __device__ bool next(int i, Unit& u) const {
        const long L = (long)i * G + c; if (L >= nwg) return false;
        int wgid = (int)L; { const int q = nwg / NXCD, r = nwg % NXCD, xcd = wgid % NXCD, off = wgid / NXCD; wgid = (xcd < r ? xcd * (q + 1) : r * (q + 1) + (xcd - r) * q) + off; }
        const int nig = WGM * nN, gid = wgid / nig, fm = gid * WGM, gsz = (nM - fm) < WGM ? (nM - fm) : WGM;
        u.pm = fm + ((wgid % nig) % gsz); u.pn = (wgid % nig) / gsz; return true;
    }
    __device__ __forceinline__ void a_ready(const Unit&) const {}
    __device__ __forceinline__ void done(const Unit&) const {}
};

__device__ __forceinline__ unsigned cvt_pk_bf16(float lo, float hi) { unsigned r; asm volatile("v_cvt_pk_bf16_f32 %0, %1, %2" : "=v"(r) : "v"(lo), "v"(hi)); return r; }
typedef float f32x2 __attribute__((ext_vector_type(2)));
template <int ACT> struct EpiBf16 {
    static constexpr bool PERM = true, AFTER_DRAIN = false;
    bf16_t* O; int ldc;
    __device__ __forceinline__ void operator()(const f32x4 (&acc)[2][2][4][2], const Unit& u, int wr, int wc, int fr, int fq) const {
        const int row0 = u.pm * BM + wr * 64 + fr; const int col0 = u.pn * BM + wc * 32 + 8 * fq;
#pragma unroll
        for (int ai = 0; ai < 2; ++ai)
#pragma unroll
            for (int m = 0; m < 4; ++m) { bf16_t* rowp = O + (size_t)(row0 + ai * HALF + m * 16) * ldc + col0;
#pragma unroll
                for (int bj = 0; bj < 2; ++bj) { f32x4 v0 = acc[ai][bj][m][0], v1 = acc[ai][bj][m][1];
                    if (ACT == 2) {
#pragma unroll
                        for (int j = 0; j < 4; ++j) { float a = v0[j] > 0.f ? v0[j] : 0.f; v0[j] = a * a; float b = v1[j] > 0.f ? v1[j] : 0.f; v1[j] = b * b; } }
                    u32x4 w; w.x = cvt_pk_bf16(v0[0], v0[1]); w.y = cvt_pk_bf16(v0[2], v0[3]); w.z = cvt_pk_bf16(v1[0], v1[1]); w.w = cvt_pk_bf16(v1[2], v1[3]);
                    *(u32x4*)(rowp + bj * HALF) = w; } }
    }
};
struct EpiRes {
    static constexpr bool PERM = false, AFTER_DRAIN = false;
    float* X; int ldc; float sgn; const float* R;
    __device__ __forceinline__ void operator()(const f32x4 (&acc)[2][2][4][2], const Unit& u, int wr, int wc, int fr, int fq) const {
        const int col0 = u.pn * BM + wc * 32 + 4 * fq;
#pragma unroll
        for (int ai = 0; ai < 2; ++ai) {
            float* base = X + (size_t)(u.pm * BM + ai * HALF + wr * 64 + fr) * ldc + col0; const float* rbase = R + (size_t)(u.pm * BM + ai * HALF + wr * 64 + fr) * ldc + col0;
            f32x4 r[4][2][2];
#pragma unroll
            for (int m = 0; m < 4; ++m)
#pragma unroll
                for (int bj = 0; bj < 2; ++bj)
#pragma unroll
                    for (int n = 0; n < 2; ++n) r[m][bj][n] = *(const f32x4*)(rbase + (size_t)(m * 16) * ldc + bj * HALF + n * 16);
            asm volatile("" ::: "memory");
#pragma unroll
            for (int m = 0; m < 4; ++m)
#pragma unroll
                for (int bj = 0; bj < 2; ++bj)
#pragma unroll
                    for (int n = 0; n < 2; ++n) *(f32x4*)(base + (size_t)(m * 16) * ldc + bj * HALF + n * 16) = r[m][bj][n] + acc[ai][bj][m][n] * sgn;
            asm volatile("" ::: "memory");
        }
    }
};
template <class Epi, class Sched, bool ALIGN_EPI = false, bool SP2 = false>
__device__ __forceinline__ void gemm_phase(PG8_LAS unsigned char* lds, const Gemm g, const Sched& S, const Epi& E) {
    int tid = threadIdx.x; asm volatile("" : "+v"(tid)); const int wid = __builtin_amdgcn_readfirstlane(tid >> 6), lane = tid & 63, wr = wid >> 2, wc = wid & 3, fr = lane & 15, fq = lane >> 4;
    const int K = g.K, nt = K / BK;
    unsigned voffA[2], voffB[2];
#pragma unroll
    for (int i = 0; i < 2; ++i) { int R, C; stage_rc(tid * 16 + i * 8192, R, C); const int Rb = Epi::PERM ? ((R & ~31) + perm32(R & 31)) : R;
        voffA[i] = (unsigned)(R * K + C) * 2u; voffB[i] = (unsigned)(Rb * K + C) * 2u; }
    const size_t kstep = (size_t)(BK * 2);
    const size_t hstep = (size_t)HALF * K * 2;
    const size_t tstep = 2 * hstep;
    const unsigned ldsw = (unsigned)wid * 1024u;
    const int aoff = lds_byte(wr * 64 + fr, fq * 8), boff = lds_byte(wc * 32 + fr, fq * 8);
#define PG8_SA(b, h) (((b) * 2 + (h)) * HTB)
#define PG8_SB(b, h) ((4 + (b) * 2 + (h)) * HTB)
#define PG8_STAGE(bufoff, gbase, voff) do { _Pragma("unroll") for (int _i = 0; _i < 2; ++_i) \
        __builtin_amdgcn_global_load_lds((const unsigned*)((const char*)(gbase) + (voff)[_i]), (PG8_LAS unsigned*)(lds + (bufoff) + ldsw + _i * 8192), 16, 0, 0); } while (0)
#define PG8_LDA(dst, b, h) do { _Pragma("unroll") for (int m = 0; m < 4; ++m) _Pragma("unroll") for (int k = 0; k < 2; ++k) dst[m][k] = *(const PG8_LAS bf16x8*)(lds + PG8_SA(b, h) + aoff + m * 2048 + k * 1024); } while (0)
#define PG8_LDB(dst, b, h) do { _Pragma("unroll") for (int n = 0; n < 2; ++n) _Pragma("unroll") for (int k = 0; k < 2; ++k) dst[n][k] = *(const PG8_LAS bf16x8*)(lds + PG8_SB(b, h) + boff + n * 2048 + k * 1024); } while (0)
#define PG8_MMA(ai, bj, At, Bt) do { __builtin_amdgcn_s_setprio(1); _Pragma("unroll") for (int m = 0; m < 4; ++m) _Pragma("unroll") for (int n = 0; n < 2; ++n) _Pragma("unroll") for (int k = 0; k < 2; ++k) \
        acc[ai][bj][m][n] = __builtin_amdgcn_mfma_f32_16x16x32_bf16(Bt[n][k], At[m][k], acc[ai][bj][m][n], 0, 0, 0); __builtin_amdgcn_s_setprio(0); } while (0)
#define PG8_WAIT_V(n) asm volatile("s_waitcnt vmcnt(" #n ")" ::: "memory")
#define PG8_WAIT_L(n) asm volatile("s_waitcnt lgkmcnt(" #n ")" ::: "memory")
#define PG8_BAR __builtin_amdgcn_s_barrier()
#define PG8_SCHED __builtin_amdgcn_sched_barrier(0)
    Unit cur, nxt; int ui = 0;
    if (!S.next(0, cur)) return;
    f32x4 acc[2][2][4][2];
#pragma unroll
    for (int a = 0; a < 2; ++a)
#pragma unroll
        for (int b = 0; b < 2; ++b)
#pragma unroll
            for (int m = 0; m < 4; ++m)
#pragma unroll
                for (int n = 0; n < 2; ++n) acc[a][b][m][n] = (f32x4){0.f, 0.f, 0.f, 0.f};
    bf16x8 At[4][2], B0[2][2], B1[2][2];
    const char* cA = (const char*)g.A + (size_t)cur.pm * tstep; const char* cB = (const char*)g.Bt + (size_t)cur.pn * tstep;
    S.a_ready(cur);
    if constexpr (SP2) {
        PG8_STAGE(PG8_SB(0, 0), cB, voffB); PG8_STAGE(PG8_SB(0, 1), cB + hstep, voffB); PG8_STAGE(PG8_SA(0, 0), cA, voffA); PG8_STAGE(PG8_SA(0, 1), cA + hstep, voffA);
        if (wr == 1) PG8_BAR;
        PG8_WAIT_V(2); PG8_BAR;
        PG8_STAGE(PG8_SB(1, 0), cB + kstep, voffB); PG8_STAGE(PG8_SA(1, 0), cA + kstep, voffA); PG8_STAGE(PG8_SB(1, 1), cB + hstep + kstep, voffB);
        PG8_WAIT_V(6); PG8_BAR;
    } else {
        PG8_STAGE(PG8_SB(0, 0), cB, voffB); PG8_STAGE(PG8_SA(0, 0), cA, voffA); PG8_STAGE(PG8_SB(0, 1), cB + hstep, voffB); PG8_STAGE(PG8_SA(0, 1), cA + hstep, voffA);
        if (wr == 1) PG8_BAR;
        PG8_WAIT_V(4); PG8_BAR;
        PG8_STAGE(PG8_SB(1, 0), cB + kstep, voffB); PG8_STAGE(PG8_SA(1, 0), cA + kstep, voffA); PG8_STAGE(PG8_SB(1, 1), cB + hstep + kstep, voffB);
        PG8_WAIT_V(6); PG8_BAR;
    }
    for (;;) {
        const bool has_next = S.next(ui + 1, nxt);
        const char* nA = has_next ? (const char*)g.A + (size_t)nxt.pm * tstep : cA; const char* nB = has_next ? (const char*)g.Bt + (size_t)nxt.pn * tstep : cB;
        for (int t = 0; t < nt; t += 2) {
            const bool last = (t == nt - 2);
            const char* a1 = cA + (size_t)(t + 1) * kstep;
            const char* a2 = last ? nA : cA + (size_t)(t + 2) * kstep; const char* b2 = last ? nB : cB + (size_t)(t + 2) * kstep;
            const char* a3 = a2 + kstep; const char* b3 = b2 + kstep;
            if (last && has_next) S.a_ready(nxt);
            if constexpr (SP2) {
            PG8_LDB(B0, 0, 0); PG8_LDB(B1, 0, 1); PG8_SCHED; PG8_LDA(At, 0, 0); PG8_STAGE(PG8_SA(1, 1), a1 + hstep, voffA);
            PG8_WAIT_V(8); PG8_WAIT_L(0); PG8_BAR; PG8_MMA(0, 0, At, B0); PG8_MMA(0, 1, At, B1); PG8_BAR; PG8_SCHED;
            PG8_LDA(At, 0, 1); PG8_STAGE(PG8_SB(0, 0), b2, voffB); PG8_STAGE(PG8_SB(0, 1), b2 + hstep, voffB); PG8_STAGE(PG8_SA(0, 0), a2, voffA);
            PG8_WAIT_V(8); PG8_WAIT_L(0); PG8_BAR; PG8_MMA(1, 0, At, B0); PG8_MMA(1, 1, At, B1); PG8_BAR; PG8_SCHED;
            PG8_LDB(B0, 1, 0); PG8_LDB(B1, 1, 1); PG8_SCHED; PG8_LDA(At, 1, 0); PG8_STAGE(PG8_SA(0, 1), a2 + hstep, voffA);
            PG8_WAIT_V(8); PG8_WAIT_L(0); PG8_BAR; PG8_MMA(0, 0, At, B0); PG8_MMA(0, 1, At, B1); PG8_BAR; PG8_SCHED;
            PG8_LDA(At, 1, 1); PG8_STAGE(PG8_SB(1, 0), b3, voffB); PG8_STAGE(PG8_SB(1, 1), b3 + hstep, voffB); PG8_STAGE(PG8_SA(1, 0), a3, voffA);
            PG8_WAIT_V(8); PG8_WAIT_L(0); PG8_BAR; PG8_MMA(1, 0, At, B0); PG8_MMA(1, 1, At, B1); PG8_BAR; PG8_SCHED;
            } else {
            PG8_LDB(B0, 0, 0); PG8_SCHED; PG8_LDA(At, 0, 0); PG8_STAGE(PG8_SA(1, 1), a1 + hstep, voffA);
            PG8_WAIT_L(8); PG8_BAR; PG8_WAIT_L(0); PG8_MMA(0, 0, At, B0); PG8_BAR; PG8_SCHED;
            PG8_LDB(B1, 0, 1); PG8_STAGE(PG8_SB(0, 0), b2, voffB);
            PG8_BAR; PG8_WAIT_L(0); PG8_MMA(0, 1, At, B1); PG8_BAR;
            PG8_LDA(At, 0, 1); PG8_STAGE(PG8_SA(0, 0), a2, voffA);
            PG8_BAR; PG8_WAIT_L(0); PG8_MMA(1, 0, At, B0); PG8_BAR; PG8_SCHED;
            PG8_STAGE(PG8_SB(0, 1), b2 + hstep, voffB);
            PG8_WAIT_V(6); PG8_BAR; PG8_MMA(1, 1, At, B1); PG8_BAR;
            PG8_LDB(B0, 1, 0); PG8_SCHED; PG8_LDA(At, 1, 0); PG8_STAGE(PG8_SA(0, 1), a2 + hstep, voffA);
            PG8_WAIT_L(8); PG8_BAR; PG8_WAIT_L(0); PG8_MMA(0, 0, At, B0); PG8_BAR; PG8_SCHED;
            PG8_LDB(B1, 1, 1); PG8_STAGE(PG8_SB(1, 0), b3, voffB);
            PG8_BAR; PG8_WAIT_L(0); PG8_MMA(0, 1, At, B1); PG8_BAR;
            PG8_LDA(At, 1, 1); PG8_STAGE(PG8_SA(1, 0), a3, voffA);
            PG8_BAR; PG8_WAIT_L(0); PG8_MMA(1, 0, At, B0); PG8_BAR; PG8_SCHED;
            PG8_STAGE(PG8_SB(1, 1), b3 + hstep, voffB);
            PG8_WAIT_V(6); PG8_BAR; PG8_MMA(1, 1, At, B1); PG8_BAR;
            }
        }
        if constexpr (ALIGN_EPI) { if (wr == 0) PG8_BAR; }
        if constexpr (!Epi::AFTER_DRAIN) { E(acc, cur, wr, wc, fr, fq); S.done(cur); }
        if (!has_next) break;
#pragma unroll
        for (int a = 0; a < 2; ++a)
#pragma unroll
            for (int b = 0; b < 2; ++b)
#pragma unroll
                for (int m = 0; m < 4; ++m)
#pragma unroll
                    for (int n = 0; n < 2; ++n) acc[a][b][m][n] = (f32x4){0.f, 0.f, 0.f, 0.f};
        cur = nxt; cA = nA; cB = nB; ++ui;
        if constexpr (ALIGN_EPI) { if (wr == 1) PG8_BAR; }
    }
    PG8_WAIT_V(0);
    if constexpr (!ALIGN_EPI) { if (wr == 0) PG8_BAR; }
    PG8_BAR;
    if constexpr (Epi::AFTER_DRAIN) { E.fused(acc, cur, wr, wc, fr, fq, lds, wid, lane); S.done(cur); }
#undef PG8_SA
#undef PG8_SB
#undef PG8_STAGE
#undef PG8_LDA
#undef PG8_LDB
#undef PG8_MMA
#undef PG8_WAIT_V
#undef PG8_WAIT_L
#undef PG8_BAR
#undef PG8_SCHED
}
}
typedef unsigned short bf16;
typedef short bf16x8 __attribute__((ext_vector_type(8)));
typedef float f32x4 __attribute__((ext_vector_type(4)));
typedef float f32x2v __attribute__((ext_vector_type(2)));
typedef unsigned u32x4 __attribute__((ext_vector_type(4)));
typedef unsigned u32x2 __attribute__((ext_vector_type(2)));

constexpr int DM = 1024, SEQ = 8192, MPR = 16384, MSA = 128, MREAL = 16512, MPAD = 16640, FF = 4096;
constexpr int NPE = 3072, NPO = 3328, NE_IN = 2824, NO_IN = 3088;
constexpr float EPS = 1e-6f;
constexpr size_t MiB = 1u << 20;
constexpr size_t WS_WEI = 1 * MiB;
constexpr size_t WS_WEO = WS_WEI + 12 * MiB;
constexpr size_t WS_WGI = WS_WEO + 4 * MiB;
constexpr size_t WS_WGO = WS_WGI + 13 * MiB;
constexpr size_t WS_WUP = WS_WGO + 4 * MiB;
constexpr size_t WS_WDN = WS_WUP + 32 * MiB;
constexpr size_t WS_X   = WS_WDN + 32 * MiB;
constexpr size_t WS_HB  = WS_X + 65 * MiB;
constexpr size_t WS_MIX = WS_HB + 33 * MiB;
constexpr size_t WS_BIG = WS_MIX + 33 * MiB;
constexpr size_t WS_SCR = WS_BIG + 106 * MiB;
constexpr size_t SC_DN_W = WS_SCR, SC_DN_QE = SC_DN_W + 16 * MiB, SC_DN_KT = SC_DN_QE + 16 * MiB, SC_DN_AT = SC_DN_KT + 16 * MiB,
                 SC_DN_U = SC_DN_AT + 8 * MiB, SC_DN_EGL = SC_DN_U + 16 * MiB, SC_DN_O = SC_DN_EGL + 1 * MiB;
constexpr size_t SC_GL_US = WS_SCR, SC_GL_QT = SC_GL_US + 64 * MiB, SC_GL_OI = SC_GL_QT + 16 * MiB, SC_GL_EGL = SC_GL_OI + 32 * MiB;
constexpr size_t SC_DN_VN = SC_DN_O + 32 * MiB;
constexpr size_t WS_END = WS_SCR + 122 * MiB;
constexpr size_t O_Y = 0, O_PDN = 16908288, O_PCONV = 17170432, O_PK = 17188864, O_PV = 17254400, O_PGLA = 17319936,
                 O_SDN = 17844224, O_SCONV = 34621440, O_SK = 35801088, O_SV = 39995392, O_SGLA = 44189696;
constexpr int LDS_BYTES = 147456;
constexpr int NPH = 37;

struct Args { const float* in[24]; float* out; unsigned char* ws; int ph_lo, ph_hi; };

typedef __bf16 bf16x2_t __attribute__((ext_vector_type(2)));
__device__ __forceinline__ unsigned pk2(float lo, float hi) { bf16x2_t v; v.x = (__bf16)lo; v.y = (__bf16)hi; return __builtin_bit_cast(unsigned, v); }
__device__ __forceinline__ unsigned f2bf(float f) { return pk2(f, 0.f) & 0xffffu; }
__device__ __forceinline__ float bf2f(unsigned h) { return __uint_as_float(h << 16); }

__device__ __forceinline__ float bflo(unsigned u) { return __uint_as_float(u << 16); }
__device__ __forceinline__ float bfhi(unsigned u) { return __uint_as_float(u & 0xffff0000u); }
__device__ __forceinline__ f32x4 mfma16(bf16x8 a, bf16x8 b, f32x4 c) { return __builtin_amdgcn_mfma_f32_16x16x32_bf16(a, b, c, 0, 0, 0); }
__device__ __forceinline__ float opq(float x) { asm volatile("" : "+v"(x)); return x; }
__device__ __forceinline__ float siluf(float x) { return x * __builtin_amdgcn_rcpf(1.f + __expf(-x)); }
#define DPPF(v, ctrl) __int_as_float(__builtin_amdgcn_update_dpp(0, __float_as_int(v), ctrl, 0xf, 0xf, false))
__device__ __forceinline__ float sum16(float v) { v += DPPF(v, 0xB1); v += DPPF(v, 0x4E); v += DPPF(v, 0x141); v += DPPF(v, 0x140); return v; }
__device__ __forceinline__ float max16(float v) { v = fmaxf(v, DPPF(v, 0xB1)); v = fmaxf(v, DPPF(v, 0x4E)); v = fmaxf(v, DPPF(v, 0x141)); v = fmaxf(v, DPPF(v, 0x140)); return v; }
__device__ __forceinline__ float wave_sum(float v) { v = sum16(v); v += __shfl_xor(v, 16); v += __shfl_xor(v, 32); return v; }
__device__ __forceinline__ float wave_max(float v) { v = max16(v); v = fmaxf(v, __shfl_xor(v, 16)); v = fmaxf(v, __shfl_xor(v, 32)); return v; }
#define LDSWAIT() asm volatile("s_waitcnt lgkmcnt(0)" ::: "memory")
#define BAR_LDS() do { asm volatile("s_waitcnt lgkmcnt(0)" ::: "memory"); __builtin_amdgcn_s_barrier(); asm volatile("" ::: "memory"); } while (0)
__device__ __forceinline__ void unpack8(u32x4 w, float (&f)[8]) { f[0] = bflo(w.x); f[1] = bfhi(w.x); f[2] = bflo(w.y); f[3] = bfhi(w.y); f[4] = bflo(w.z); f[5] = bfhi(w.z); f[6] = bflo(w.w); f[7] = bfhi(w.w); }
__device__ __forceinline__ u32x4 pack8(const float (&f)[8]) { u32x4 w; w.x = pk2(f[0], f[1]); w.y = pk2(f[2], f[3]); w.z = pk2(f[4], f[5]); w.w = pk2(f[6], f[7]); return w; }

__device__ __forceinline__ void transpose_w(const float* __restrict__ W, int K, int N, int Npad, bf16* __restrict__ WT, float* scr, int gw, int ngw, int lane) {
    const int nblk = Npad / 64, nitems = (K / 64) * nblk;
    for (int it = gw; it < nitems; it += ngw) {
        const int kb = it / nblk, nb = it % nblk, k0 = 64 * kb, n0 = 64 * nb;
        const int n = n0 + lane;
        float v[64];
#pragma unroll
        for (int kk = 0; kk < 64; ++kk) v[kk] = (n < N) ? W[(size_t)(k0 + kk) * N + n] : 0.f;
#pragma unroll
        for (int kk = 0; kk < 64; ++kk) scr[kk * 65 + lane] = v[kk];
        LDSWAIT();
        const int c = lane & 7;
#pragma unroll
        for (int j = 0; j < 8; ++j) { const int nl = (lane >> 3) + 8 * j; const float* s = scr + (8 * c) * 65 + nl;
            u32x4 o; o.x = pk2(s[0 * 65], s[1 * 65]); o.y = pk2(s[2 * 65], s[3 * 65]); o.z = pk2(s[4 * 65], s[5 * 65]); o.w = pk2(s[6 * 65], s[7 * 65]);
            *(u32x4*)(WT + (size_t)(n0 + nl) * K + k0 + 8 * c) = o; }
        LDSWAIT();
    }
}
__device__ __forceinline__ void norm_row(const f32x4 (&v)[4], const float* g, bf16* hrow, float* yrow, int lane) {
    float s = 0.f;
#pragma unroll
    for (int j = 0; j < 4; ++j) s += (v[j].x * v[j].x + v[j].y * v[j].y) + (v[j].z * v[j].z + v[j].w * v[j].w);
    const float rstd = rsqrtf(wave_sum(s) * (1.f / DM) + EPS);
#pragma unroll
    for (int j = 0; j < 4; ++j) { const f32x4 gg = *(const f32x4*)(g + 4 * lane + 256 * j); const f32x4 o = v[j] * rstd * gg;
        if (hrow) { u32x2 w; w.x = pk2(o.x, o.y); w.y = pk2(o.z, o.w); *(u32x2*)(hrow + 4 * lane + 256 * j) = w; }
        else *(f32x4*)(yrow + 4 * lane + 256 * j) = o; }
}
__device__ __forceinline__ void norm_phase(const float* __restrict__ X, const float* g, bf16* __restrict__ HB, float* __restrict__ Y, int gw, int ngw, int lane) {
    for (int m0 = gw; m0 < MREAL; m0 += 4 * ngw) {
        f32x4 v[4][4];
#pragma unroll
        for (int r = 0; r < 4; ++r) { const int m = m0 + r * ngw; const int mm = m < MREAL ? m : m0;
#pragma unroll
            for (int j = 0; j < 4; ++j) v[r][j] = *(const f32x4*)(X + (size_t)mm * DM + 4 * lane + 256 * j); }
#pragma unroll
        for (int r = 0; r < 4; ++r) { const int m = m0 + r * ngw;
            if (m < MREAL) norm_row(v[r], g, HB ? HB + (size_t)m * DM : nullptr, Y ? Y + (size_t)m * DM : nullptr, lane); }
    }
}

__device__ __forceinline__ void dn_stepA(int tid, int unit, unsigned char* lds, const bf16* PROJ, const float* conv_w, const float* a_log, const float* dt_bias,
                                         bf16* W_, bf16* QE_, bf16* KT_, bf16* AT_, bf16* U_, float* EGL_) {
    asm volatile("" : "+v"(tid));
    const int lane = tid & 63, wave = tid >> 6, m16 = lane & 15, q4 = lane >> 4;
    const int h = unit & 3, c = (unit >> 2) & 127, b = unit >> 9;
    const int t0 = c * 64; const size_t rowb = (size_t)b * SEQ;
    const size_t ch = (size_t)unit;
    bf16* qs = (bf16*)(lds); bf16* ks = (bf16*)(lds + 17408); bf16* kbs = (bf16*)(lds + 34816);
    bf16* vbT = (bf16*)(lds + 52224); bf16* kbgT = (bf16*)(lds + 70656);
    float* Ms = (float*)(lds + 89088); bf16* Tb = (bf16*)(lds + 105728);
    float* Gs = (float*)(lds + 114944); float* Bs = Gs + 64;
    if (wave == 0) {
        const bf16* pr = PROJ + (rowb + t0 + lane) * NPE;
        const float a = bf2f(pr[2048 + h]), bb = bf2f(pr[2052 + h]);
        const float x = a + dt_bias[h];
        const float sp = x > 20.f ? x : __logf(1.f + __expf(x));
        const float g = -__expf(a_log[h]) * sp;
        float G = g;
#pragma unroll
        for (int o = 1; o < 64; o <<= 1) { const float v = __shfl_up(G, o); if (lane >= o) G += v; }
        Gs[lane] = G; Bs[lane] = __builtin_amdgcn_rcpf(1.f + __expf(-bb));
    }
    __syncthreads();
#pragma unroll 1
    for (int bt = 0; bt < 2; ++bt) {
        u32x4 raw[3][4];
#pragma unroll
        for (int ii = 0; ii < 3; ++ii) {
            const int item = (bt * 3 + ii) * 512 + tid, part = item >> 10, t = (item >> 4) & 63, cg = item & 15;
            const int chn = part * 512 + h * 128 + cg * 8;
#pragma unroll
            for (int tap = 0; tap < 4; ++tap) { const int tt = t0 + t - 3 + tap;
                raw[ii][tap] = tt >= 0 ? *(const u32x4*)(PROJ + (rowb + tt) * NPE + chn) : (u32x4){0u, 0u, 0u, 0u}; }
        }
#pragma unroll
        for (int ii = 0; ii < 3; ++ii) {
            const int item = (bt * 3 + ii) * 512 + tid, part = item >> 10, t = (item >> 4) & 63, cg = item & 15;
            const int chn = part * 512 + h * 128 + cg * 8;
            float acc[8];
#pragma unroll
            for (int j = 0; j < 8; ++j) acc[j] = 0.f;
#pragma unroll
            for (int tap = 0; tap < 4; ++tap) {
                float f[8]; unpack8(raw[ii][tap], f);
                const f32x4 c0 = *(const f32x4*)(conv_w + tap * 1536 + chn), c1 = *(const f32x4*)(conv_w + tap * 1536 + chn + 4);
                acc[0] += f[0] * c0.x; acc[1] += f[1] * c0.y; acc[2] += f[2] * c0.z; acc[3] += f[3] * c0.w;
                acc[4] += f[4] * c1.x; acc[5] += f[5] * c1.y; acc[6] += f[6] * c1.z; acc[7] += f[7] * c1.w;
            }
            float ss = 0.f;
#pragma unroll
            for (int j = 0; j < 8; ++j) { acc[j] = siluf(acc[j]); ss += acc[j] * acc[j]; }
            ss = sum16(ss);
            const float rstd = rsqrtf(ss + EPS);
            const float Gt = Gs[t], bt_ = Bs[t];
            if (part == 0) {
                float o[8], oe[8]; const float sc = rstd * 0.08838834764831845f, eg = __expf(Gt);
#pragma unroll
                for (int j = 0; j < 8; ++j) { o[j] = acc[j] * sc; oe[j] = o[j] * eg; }
                *(u32x4*)(qs + t * 136 + cg * 8) = pack8(o);
                *(u32x4*)(QE_ + ch * 8192 + t * 128 + cg * 8) = pack8(oe);
            } else if (part == 1) {
                float o[8], ob[8]; const float eg = __expf(Gt) * bt_;
#pragma unroll
                for (int j = 0; j < 8; ++j) { o[j] = acc[j] * rstd; ob[j] = o[j] * bt_; }
                *(u32x4*)(ks + t * 136 + cg * 8) = pack8(o);
                *(u32x4*)(kbs + t * 136 + cg * 8) = pack8(ob);
#pragma unroll
                for (int j = 0; j < 8; ++j) kbgT[(cg * 8 + j) * 72 + (((t >> 3) ^ (cg & 7)) << 3) + (t & 7)] = (bf16)f2bf(o[j] * eg);
            } else {
#pragma unroll
                for (int j = 0; j < 8; ++j) vbT[(cg * 8 + j) * 72 + (((t >> 3) ^ (cg & 7)) << 3) + (t & 7)] = (bf16)f2bf(acc[j] * bt_);
            }
        }
    }
    __syncthreads();
    {
        const int d = tid >> 2, tg = tid & 3; const float gl = Gs[63];
#pragma unroll
        for (int half = 0; half < 2; ++half) {
            float o[8];
#pragma unroll
            for (int j = 0; j < 8; ++j) { const int t = tg * 16 + half * 8 + j; o[j] = bf2f(ks[t * 136 + d]) * __expf(gl - Gs[t]); }
            *(u32x4*)(KT_ + ch * 8192 + d * 64 + tg * 16 + half * 8) = pack8(o);
        }
        if (tid == 0) EGL_[ch] = __expf(gl);
    }
    {
        const int which = wave >> 2, mt = wave & 3;
        const bf16* As = which ? kbs : qs;
        bf16x8 aF[4];
#pragma unroll
        for (int k4 = 0; k4 < 4; ++k4) aF[k4] = *(const bf16x8*)(As + (mt * 16 + m16) * 136 + k4 * 32 + q4 * 8);
#pragma unroll
        for (int nt = 0; nt < 4; ++nt) {
            f32x4 acc = {0.f, 0.f, 0.f, 0.f};
            if (nt <= mt) {
#pragma unroll
                for (int k4 = 0; k4 < 4; ++k4) { const bf16x8 bF = *(const bf16x8*)(ks + (nt * 16 + m16) * 136 + k4 * 32 + q4 * 8); acc = mfma16(aF[k4], bF, acc); }
            }
            const int s = nt * 16 + m16; const float Gsv = Gs[s];
#pragma unroll
            for (int i = 0; i < 4; ++i) {
                const int t = mt * 16 + q4 * 4 + i;
                const bool on = which ? (t > s) : (t >= s);
                const float v = on ? acc[i] * __expf(Gs[t] - Gsv) : 0.f;
                if (which) Ms[t * 65 + s] = v; else AT_[ch * 4096 + t * 64 + s] = (bf16)f2bf(v);
            }
        }
    }
    __syncthreads();
    {
        float* Ts = (float*)(lds + 115456);
        if (wave == 0) {
            const int blk = lane >> 4, cc = lane & 15; const float* Mb = Ms + (blk * 16) * 65 + blk * 16;
            float tc[16];
#pragma unroll
            for (int r = 0; r < 16; ++r) {
                float acc = (r == cc) ? 1.f : 0.f;
#pragma unroll
                for (int j = 0; j < r; ++j) acc -= Mb[r * 65 + j] * tc[j];
                tc[r] = acc;
            }
#pragma unroll
            for (int r = 0; r < 16; ++r) Ts[(blk * 16 + r) * 65 + blk * 16 + cc] = tc[r];
        }
        __syncthreads();
#pragma unroll 1
        for (int dd = 1; dd < 4; ++dd) {
            if (wave < 4 - dd) {
                const int j = wave, i = wave + dd;
                f32x4 acc = {0.f, 0.f, 0.f, 0.f};
                for (int k = j; k < i; ++k) {
                    const float* A = Ms + (i * 16) * 65 + k * 16; const float* B = Ts + (k * 16) * 65 + j * 16;
#pragma unroll
                    for (int kk = 0; kk < 4; ++kk) acc = __builtin_amdgcn_mfma_f32_16x16x4f32(A[m16 * 65 + kk * 4 + q4], B[(kk * 4 + q4) * 65 + m16], acc, 0, 0, 0);
                }
                float* Tmp = Ts + (j * 16) * 65 + i * 16;
#pragma unroll
                for (int r = 0; r < 4; ++r) Tmp[(q4 * 4 + r) * 65 + m16] = acc[r];
                LDSWAIT();
                f32x4 acc2 = {0.f, 0.f, 0.f, 0.f};
                { const float* A = Ts + (i * 16) * 65 + i * 16;
#pragma unroll
                  for (int kk = 0; kk < 4; ++kk) acc2 = __builtin_amdgcn_mfma_f32_16x16x4f32(A[m16 * 65 + kk * 4 + q4], Tmp[(kk * 4 + q4) * 65 + m16], acc2, 0, 0, 0); }
                float* Out = Ts + (i * 16) * 65 + j * 16;
#pragma unroll
                for (int r = 0; r < 4; ++r) Out[(q4 * 4 + r) * 65 + m16] = -acc2[r];
            }
            __syncthreads();
        }
        const int t = tid >> 3, s8 = (tid & 7) * 8; float o[8];
#pragma unroll
        for (int j = 0; j < 8; ++j) o[j] = (s8 + j <= t) ? Ts[t * 65 + s8 + j] : 0.f;
        *(u32x4*)(Tb + t * 72 + s8) = pack8(o);
    }
    __syncthreads();
    {
        const bf16* BT = wave < 4 ? vbT : kbgT; bf16* OUT = wave < 4 ? U_ : W_;
        bf16x8 bF[2][2];
#pragma unroll
        for (int n2 = 0; n2 < 2; ++n2)
#pragma unroll
            for (int k2 = 0; k2 < 2; ++k2) { const int rr = ((wave & 3) * 2 + n2) * 16 + m16; bF[n2][k2] = *(const bf16x8*)(BT + rr * 72 + (((k2 * 4 + q4) ^ ((rr >> 3) & 7)) << 3)); }
#pragma unroll
        for (int mt = 0; mt < 4; ++mt) {
            bf16x8 aF[2];
#pragma unroll
            for (int k2 = 0; k2 < 2; ++k2) aF[k2] = *(const bf16x8*)(Tb + (mt * 16 + m16) * 72 + k2 * 32 + q4 * 8);
#pragma unroll
            for (int n2 = 0; n2 < 2; ++n2) {
                f32x4 acc = {0.f, 0.f, 0.f, 0.f};
                u32x2 w;
                if (wave < 4) {
                    acc = mfma16(aF[0], bF[n2][0], acc); acc = mfma16(aF[1], bF[n2][1], acc);
                    w.x = pk2(acc[0], acc[1]); w.y = pk2(acc[2], acc[3]);
                    *(u32x2*)(OUT + ch * 8192 + (((wave & 3) * 2 + n2) * 16 + m16) * 64 + mt * 16 + q4 * 4) = w;
                } else {
                    acc = mfma16(bF[n2][0], aF[0], acc); acc = mfma16(bF[n2][1], aF[1], acc);
                    w.x = pk2(acc[0], acc[1]); w.y = pk2(acc[2], acc[3]);
                    *(u32x2*)(OUT + ch * 8192 + (mt * 16 + m16) * 128 + ((wave & 3) * 2 + n2) * 16 + q4 * 4) = w;
                }
            }
        }
    }
    __syncthreads();
}

__device__ __forceinline__ void dn_stepB(int tid, int item, unsigned char* lds, const bf16* W_, const bf16* KT_, const bf16* U_, const float* EGL_,
                                         bf16* SC_, bf16* VN_, float* state_out) {
    asm volatile("" : "+v"(tid));
    const int lane = tid & 63, wave = tid >> 6, m16 = lane & 15, q4 = lane >> 4;
    const int bh = item & 7, sl = item >> 3, b = bh >> 2, h = bh & 3, e0 = sl * 16;
    bf16* Sb = (bf16*)lds;
    bf16* Vn = (bf16*)(lds + 16 * 136 * 2);
    for (int i = tid; i < 16 * 136 / 2; i += 512) ((unsigned*)Sb)[i] = 0u;
    f32x4 accS = {0.f, 0.f, 0.f, 0.f};
    __syncthreads();
    const bool lo = wave < 4;
    int vz = 0; asm volatile("" : "+v"(vz));
    const bf16* xbase = W_ + ((wave & 3) * 16 + m16) * 128 + q4 * 8;
    const bf16* ubase = U_ + (e0 + m16) * 64 + (wave & 3) * 16 + q4 * 4;
    const bf16* kbase = KT_ + (wave * 16 + m16) * 64 + q4 * 8;
    bf16* scbase = SC_ + (e0 + m16) * 128 + wave * 16 + q4 * 4;
    bf16* vnbase = VN_ + (e0 + m16) * 64 + (wave & 3) * 16 + q4 * 4;
#define DNB_LOAD(cc, xA_, kA_, uC_, egl_) do { const int c_ = (cc) < 128 ? (cc) : 127; const size_t ch_ = (size_t)b * 512 + c_ * 4 + h; \
        if (lo) { _Pragma("unroll") for (int k4 = 0; k4 < 4; ++k4) xA_[k4] = *(const bf16x8*)(xbase + ch_ * 8192 + k4 * 32); uC_ = *(const u32x2*)(ubase + ch_ * 8192); } \
        kA_[0] = *(const bf16x8*)(kbase + ch_ * 8192); kA_[1] = *(const bf16x8*)(kbase + ch_ * 8192 + 32); \
        egl_ = EGL_[ch_ + vz]; } while (0)
#define DNB_STEP(cc, xA_, kA_, uC_, egl_) do { const size_t chs_ = (size_t)b * 512 + (cc) * 4 + h; \
        { u32x2 w; w.x = pk2(accS[0], accS[1]); w.y = pk2(accS[2], accS[3]); *(u32x2*)(scbase + chs_ * 16384) = w; }     \
        if (lo) { f32x4 accX = {0.f, 0.f, 0.f, 0.f}; \
            _Pragma("unroll") for (int k4 = 0; k4 < 4; ++k4) { const bf16x8 sB = *(const bf16x8*)(Sb + m16 * 136 + k4 * 32 + q4 * 8); accX = mfma16(xA_[k4], sB, accX); } \
            u32x2 w; w.x = pk2(bflo(uC_.x) - accX[0], bfhi(uC_.x) - accX[1]); w.y = pk2(bflo(uC_.y) - accX[2], bfhi(uC_.y) - accX[3]); \
            *(u32x2*)(Vn + m16 * 72 + wave * 16 + q4 * 4) = w; *(u32x2*)(vnbase + chs_ * 8192) = w; } \
        BAR_LDS(); \
        const bf16x8 vB0 = *(const bf16x8*)(Vn + m16 * 72 + q4 * 8), vB1 = *(const bf16x8*)(Vn + m16 * 72 + 32 + q4 * 8); \
        accS = accS * egl_; \
        accS = mfma16(kA_[0], vB0, accS); accS = mfma16(kA_[1], vB1, accS); \
        { u32x2 w; w.x = pk2(accS[0], accS[1]); w.y = pk2(accS[2], accS[3]); *(u32x2*)(Sb + m16 * 136 + wave * 16 + q4 * 4) = w; } \
        BAR_LDS(); } while (0)
    bf16x8 xA[4], kA[2]; u32x2 uA; float eglA;
    bf16x8 xB[4], kB[2]; u32x2 uB; float eglB;
    bf16x8 xC[4], kC[2]; u32x2 uC; float eglC;
    bf16x8 xD[4], kD[2]; u32x2 uD; float eglD;
    uA = uB = uC = uD = (u32x2){0u, 0u};
#pragma unroll
    for (int k4 = 0; k4 < 4; ++k4) xA[k4] = xB[k4] = xC[k4] = xD[k4] = (bf16x8){0, 0, 0, 0, 0, 0, 0, 0};
    DNB_LOAD(0, xA, kA, uA, eglA); DNB_LOAD(1, xB, kB, uB, eglB); DNB_LOAD(2, xC, kC, uC, eglC);
#pragma unroll 1
    for (int c = 0; c < 128; c += 4) {
        DNB_LOAD(c + 3, xD, kD, uD, eglD);
        DNB_STEP(c, xA, kA, uA, eglA);
        DNB_LOAD(c + 4, xA, kA, uA, eglA);
        DNB_STEP(c + 1, xB, kB, uB, eglB);
        DNB_LOAD(c + 5, xB, kB, uB, eglB);
        DNB_STEP(c + 2, xC, kC, uC, eglC);
        DNB_LOAD(c + 6, xC, kC, uC, eglC);
        DNB_STEP(c + 3, xD, kD, uD, eglD);
    }
#undef DNB_LOAD
#undef DNB_STEP
    {
        float* sp = state_out + ((size_t)(b * 4 + h) * 128 + wave * 16 + q4 * 4) * 128 + e0 + m16;
#pragma unroll
        for (int i = 0; i < 4; ++i) sp[i * 128] = accS[i];
    }
    __syncthreads();
}

__device__ __forceinline__ void dn_stepC(int tid, int unit, unsigned char* lds, const bf16* __restrict__ PROJ, const bf16* __restrict__ QE_, const bf16* __restrict__ AT_, const bf16* __restrict__ SC_, const bf16* __restrict__ VN_,
                                         const float* dn_norm, bf16* __restrict__ MIX) {
    asm volatile("" : "+v"(tid));
    const int lane = tid & 63, wave = tid >> 6, m16 = lane & 15, q4 = lane >> 4;
    const int h = unit & 3, c = (unit >> 2) & 127, b = unit >> 9;
    const size_t row0 = (size_t)b * SEQ + c * 64; const size_t ch = (size_t)unit;
    float* red = (float*)lds;
    bf16x8 scF[4], vnF[2], qeF[4][4], atF[4][2]; u32x2 zg[4];
#pragma unroll
    for (int k4 = 0; k4 < 4; ++k4) scF[k4] = *(const bf16x8*)(SC_ + ch * 16384 + (wave * 16 + m16) * 128 + k4 * 32 + q4 * 8);
#pragma unroll
    for (int k2 = 0; k2 < 2; ++k2) vnF[k2] = *(const bf16x8*)(VN_ + ch * 8192 + (wave * 16 + m16) * 64 + k2 * 32 + q4 * 8);
#pragma unroll
    for (int mt = 0; mt < 4; ++mt) {
#pragma unroll
        for (int k4 = 0; k4 < 4; ++k4) qeF[mt][k4] = *(const bf16x8*)(QE_ + ch * 8192 + (mt * 16 + m16) * 128 + k4 * 32 + q4 * 8);
#pragma unroll
        for (int k2 = 0; k2 < 2; ++k2) atF[mt][k2] = *(const bf16x8*)(AT_ + ch * 4096 + (mt * 16 + m16) * 64 + k2 * 32 + q4 * 8);
        zg[mt] = *(const u32x2*)(PROJ + (row0 + mt * 16 + m16) * NPE + 1536 + h * 128 + wave * 16 + q4 * 4);
    }
    f32x4 acc[4];
#pragma unroll
    for (int mt = 0; mt < 4; ++mt) {
        f32x4 a = {0.f, 0.f, 0.f, 0.f};
#pragma unroll
        for (int k4 = 0; k4 < 4; ++k4) a = mfma16(scF[k4], qeF[mt][k4], a);
#pragma unroll
        for (int k2 = 0; k2 < 2; ++k2) a = mfma16(vnF[k2], atF[mt][k2], a);
        acc[mt] = a;
        float ss = (a[0] * a[0] + a[1] * a[1]) + (a[2] * a[2] + a[3] * a[3]);
        ss += __shfl_xor(ss, 16); ss += __shfl_xor(ss, 32);
        if (q4 == 0) red[wave * 64 + mt * 16 + m16] = ss;
    }
    __syncthreads();
    const f32x4 gn = *(const f32x4*)(dn_norm + wave * 16 + q4 * 4);
#pragma unroll
    for (int mt = 0; mt < 4; ++mt) {
        const int t = mt * 16 + m16; float tot = 0.f;
#pragma unroll
        for (int w = 0; w < 8; ++w) tot += red[w * 64 + t];
        const float rstd = rsqrtf(tot * (1.f / 128.f) + EPS);
        const f32x4 a = acc[mt]; const u32x2 z = zg[mt];
        u32x2 w; w.x = pk2(a[0] * rstd * gn[0] * siluf(bflo(z.x)), a[1] * rstd * gn[1] * siluf(bfhi(z.x)));
        w.y = pk2(a[2] * rstd * gn[2] * siluf(bflo(z.y)), a[3] * rstd * gn[3] * siluf(bfhi(z.y)));
        *(u32x2*)(MIX + (row0 + t) * DM + h * 128 + wave * 16 + q4 * 4) = w;
    }
    __syncthreads();
}

__device__ __forceinline__ void swa_prompt(int tid, int unit, unsigned char* lds, const bf16* PROJ, const float* sinks, bf16* MIX) {
    asm volatile("" : "+v"(tid));
    const int lane = tid & 63, wave = tid >> 6, m16 = lane & 15, q4 = lane >> 4;
    const int qb = unit & 63, kvh = (unit >> 6) & 1, b = unit >> 7;
    const int p0 = qb * 128; const size_t rowb = (size_t)b * SEQ;
    bf16* Ks = (bf16*)lds;
    bf16* VsT = (bf16*)(lds + 39168);
    bf16* Pw = (bf16*)(lds + 75008 + wave * 5376);
    for (int i = 0; i < 4; ++i) {
        const int item = i * 512 + tid, key = item >> 3, dg = item & 7; const int pos = p0 - 128 + key;
        u32x4 kw = {0u, 0u, 0u, 0u}, vw = {0u, 0u, 0u, 0u};
        if (pos >= 0) { const bf16* pr = PROJ + (rowb + pos) * NPE + kvh * 64 + dg * 8; kw = *(const u32x4*)(pr + 2568); vw = *(const u32x4*)(pr + 2696); }
        *(u32x4*)(Ks + key * 72 + dg * 8) = kw;
        VsT[(dg * 8 + 0) * 280 + key] = (bf16)(vw.x & 0xffff); VsT[(dg * 8 + 1) * 280 + key] = (bf16)(vw.x >> 16);
        VsT[(dg * 8 + 2) * 280 + key] = (bf16)(vw.y & 0xffff); VsT[(dg * 8 + 3) * 280 + key] = (bf16)(vw.y >> 16);
        VsT[(dg * 8 + 4) * 280 + key] = (bf16)(vw.z & 0xffff); VsT[(dg * 8 + 5) * 280 + key] = (bf16)(vw.z >> 16);
        VsT[(dg * 8 + 6) * 280 + key] = (bf16)(vw.w & 0xffff); VsT[(dg * 8 + 7) * 280 + key] = (bf16)(vw.w >> 16);
    }
    { unsigned zz = 0u; asm volatile("" : "+v"(zz));
      if (tid < 128) { const int key = 256 + (tid >> 3), dg = tid & 7; *(u32x4*)(Ks + key * 72 + dg * 8) = (u32x4){zz, zz, zz, zz}; } }
    for (int i = tid; i < 64 * 24; i += 512) { const int d = i / 24, kk = 256 + i % 24; VsT[d * 280 + kk] = 0; }
    __syncthreads();
    const int g = wave >> 1, half = wave & 1, head = kvh * 4 + g;
    const float slope = exp2f(-(float)(head + 1)), sink = sinks[head];
#pragma unroll 1
    for (int mt4 = 0; mt4 < 4; ++mt4) {
        const int q0 = half * 64 + mt4 * 16;
        const bf16* qp = PROJ + (rowb + p0 + q0 + m16) * NPE + 2056 + head * 64 + q4 * 8;
        const bf16x8 qA0 = *(const bf16x8*)(qp), qA1 = *(const bf16x8*)(qp + 32);
        float sc[10][4];
#pragma unroll
        for (int kt = 0; kt < 10; ++kt) {
            const int j0 = q0 + kt * 16;
            const bf16x8 kB0 = *(const bf16x8*)(Ks + (j0 + m16) * 72 + q4 * 8), kB1 = *(const bf16x8*)(Ks + (j0 + m16) * 72 + 32 + q4 * 8);
            f32x4 acc = {0.f, 0.f, 0.f, 0.f};
            acc = mfma16(qA0, kB0, acc); acc = mfma16(qA1, kB1, acc);
            const int j = j0 + m16; const int pos = p0 - 128 + j;
#pragma unroll
            for (int i = 0; i < 4; ++i) { const int rel = q0 + q4 * 4 + i + 128 - j; const bool valid = rel >= 0 && rel < 128 && pos >= 0;
                sc[kt][i] = valid ? acc[i] * 0.125f - slope * (float)rel : -1e30f; }
        }
        float inv[4], mx[4];
#pragma unroll
        for (int i = 0; i < 4; ++i) {
            float m = sc[0][i];
#pragma unroll
            for (int kt = 1; kt < 10; ++kt) m = fmaxf(m, sc[kt][i]);
            m = fmaxf(max16(m), sink); mx[i] = m;
            float s = 0.f;
#pragma unroll
            for (int kt = 0; kt < 10; ++kt) { sc[kt][i] = __expf(sc[kt][i] - m); s += sc[kt][i]; }
            s = sum16(s) + __expf(sink - m);
            inv[i] = __builtin_amdgcn_rcpf(s);
        }
#pragma unroll
        for (int kt = 0; kt < 10; ++kt)
#pragma unroll
            for (int i = 0; i < 4; ++i) Pw[(q4 * 4 + i) * 168 + kt * 16 + m16] = (bf16)f2bf(sc[kt][i] * inv[i]);
        LDSWAIT();
        bf16x8 pA[5];
#pragma unroll
        for (int k5 = 0; k5 < 5; ++k5) pA[k5] = *(const bf16x8*)(Pw + m16 * 168 + k5 * 32 + q4 * 8);
#pragma unroll
        for (int nt = 0; nt < 4; ++nt) {
            f32x4 acc = {0.f, 0.f, 0.f, 0.f};
#pragma unroll
            for (int k5 = 0; k5 < 5; ++k5) { const bf16x8 vB = *(const bf16x8*)(VsT + (nt * 16 + m16) * 280 + q0 + k5 * 32 + q4 * 8); acc = mfma16(vB, pA[k5], acc); }
            u32x2 w; w.x = pk2(acc[0], acc[1]); w.y = pk2(acc[2], acc[3]);
            *(u32x2*)(MIX + (rowb + p0 + q0 + m16) * DM + 512 + head * 64 + nt * 16 + q4 * 4) = w;
        }
        LDSWAIT();
    }
    __syncthreads();
}

__device__ __forceinline__ void sample_even(int tid, int s, int el, unsigned char* lds, const bf16* PROJ, const float* state_dn, const float* state_conv, const float* cache_k, const float* cache_v,
                                            const float* conv_w, const float* a_log, const float* dt_bias, const float* dn_norm, const float* sinks, bf16* MIX, float* out) {
    asm volatile("" : "+v"(tid));
    const int lane = tid & 63, wave = tid >> 6;
    const size_t row = (size_t)MPR + s; const bf16* pr = PROJ + row * NPE;
    float* cv = (float*)lds;
    float* gsm = cv + 1536;
    float* red = gsm + 16;
    float* qsw = red + 16;
    float* knew = qsw + 512;
    float* vnew = knew + 128;
    float* scs = vnew + 128;
    {
        const float* cb = state_conv + ((size_t)el * MSA + s) * 3 * 1536;
        float* ob = out + O_SCONV + ((size_t)el * MSA + s) * 3 * 1536;
#pragma unroll
        for (int r = 0; r < 3; ++r) {
            const int chn = tid + r * 512;
            const float x3 = bf2f(pr[chn]), b0 = cb[chn], b1 = cb[1536 + chn], b2 = cb[3072 + chn];
            const float v = b0 * conv_w[chn] + b1 * conv_w[1536 + chn] + b2 * conv_w[3072 + chn] + x3 * conv_w[4608 + chn];
            cv[chn] = siluf(v);
            ob[chn] = b1; ob[1536 + chn] = b2; ob[3072 + chn] = x3;
        }
        qsw[tid] = bf2f(pr[2056 + tid]);
        if (tid < 128) { knew[tid] = bf2f(pr[2568 + tid]); vnew[tid] = bf2f(pr[2696 + tid]); }
        if (tid < 4) {
            const float a = bf2f(pr[2048 + tid]), bb = bf2f(pr[2052 + tid]);
            const float x = a + dt_bias[tid]; const float sp = x > 20.f ? x : __logf(1.f + __expf(x));
            gsm[tid] = __expf(-__expf(a_log[tid]) * sp); gsm[4 + tid] = __builtin_amdgcn_rcpf(1.f + __expf(-bb));
        }
    }
    __syncthreads();
    {
        const float a = cv[wave * 128 + lane], bq = cv[wave * 128 + 64 + lane];
        const float ss = wave_sum(a * a + bq * bq);
        const float sc = rsqrtf(ss + EPS) * (wave < 4 ? 0.08838834764831845f : 1.f);
        cv[wave * 128 + lane] = a * sc; cv[wave * 128 + 64 + lane] = bq * sc;
    }
    __syncthreads();
    if (wave < 4) { const float v = cv[wave * 128 + lane] * cv[512 + wave * 128 + lane] + cv[wave * 128 + 64 + lane] * cv[512 + wave * 128 + 64 + lane]; const float t_ = wave_sum(v); if (lane == 0) gsm[8 + wave] = t_; }
    __syncthreads();
#pragma unroll 1
    for (int p = 0; p < 2; ++p) {
        const int hl = tid >> 8, h = p * 2 + hl, dg = (tid >> 5) & 7, e4 = (tid & 31) * 4;
        const float* __restrict__ S = state_dn + (((size_t)el * MSA + s) * 4 + h) * 16384 + (size_t)(dg * 16) * 128 + e4;
        float* __restrict__ So = out + O_SDN + (((size_t)el * MSA + s) * 4 + h) * 16384 + (size_t)(dg * 16) * 128 + e4;
        const float* qh = cv + h * 128 + dg * 16; const float* kh = cv + 512 + h * 128 + dg * 16;
        float* part = vnew + 128 + 1024;
        f32x4 sv[16];
#pragma unroll
        for (int d = 0; d < 16; ++d) sv[d] = *(const f32x4*)(S + d * 128);
        f32x4 r = {0.f, 0.f, 0.f, 0.f}, qS = {0.f, 0.f, 0.f, 0.f};
#pragma unroll
        for (int d = 0; d < 16; ++d) { r += sv[d] * kh[d]; qS += sv[d] * qh[d]; }
        *(f32x4*)(part + ((hl * 8 + dg) * 128 + e4) * 2) = r; *(f32x4*)(part + ((hl * 8 + dg) * 128 + e4) * 2 + 4) = qS;
        __syncthreads();
        f32x4 rt = {0.f, 0.f, 0.f, 0.f}, qt = {0.f, 0.f, 0.f, 0.f};
#pragma unroll
        for (int g2 = 0; g2 < 8; ++g2) { rt += *(const f32x4*)(part + ((hl * 8 + g2) * 128 + e4) * 2); qt += *(const f32x4*)(part + ((hl * 8 + g2) * 128 + e4) * 2 + 4); }
        const float eg = gsm[h], beta = gsm[4 + h], qk = gsm[8 + h];
        const f32x4 vv4 = *(const f32x4*)(cv + 1024 + h * 128 + e4);
        const f32x4 vn = (vv4 - rt * eg) * beta;
        const f32x4 o = qt * eg + vn * qk;
#pragma unroll
        for (int d = 0; d < 16; ++d) *(f32x4*)(So + d * 128) = sv[d] * eg + vn * kh[d];
        float ss = (o.x * o.x + o.y * o.y) + (o.z * o.z + o.w * o.w);
        ss += __shfl_xor(ss, 1); ss += __shfl_xor(ss, 2); ss += __shfl_xor(ss, 4); ss += __shfl_xor(ss, 8); ss += __shfl_xor(ss, 16);
        const float rstd = rsqrtf(ss * (1.f / 128.f) + EPS);
        if (dg == 0) {
            const u32x2 zw = *(const u32x2*)(pr + 1536 + h * 128 + e4);
            const f32x4 nn = *(const f32x4*)(dn_norm + e4);
            u32x2 w; w.x = pk2(o.x * rstd * nn.x * siluf(bflo(zw.x)), o.y * rstd * nn.y * siluf(bfhi(zw.x)));
            w.y = pk2(o.z * rstd * nn.z * siluf(bflo(zw.y)), o.w * rstd * nn.w * siluf(bfhi(zw.y)));
            *(u32x2*)(MIX + row * DM + h * 128 + e4) = w;
        }
        __syncthreads();
    }
    {
        const float* ck = cache_k + ((size_t)el * MSA + s) * 16384; const float* cvv = cache_v + ((size_t)el * MSA + s) * 16384;
        const int head = tid >> 6, jj = tid & 63, kvh = head >> 2;
        const float slope = exp2f(-(float)(head + 1)); const float c125 = opq(0.125f);
#pragma unroll
        for (int r = 0; r < 2; ++r) {
            const int ci = jj + r * 64;
            float dot = 0.f;
            if (ci < 127) { const float* kp = ck + (ci + 1) * 128 + kvh * 64;
#pragma unroll
                for (int d4 = 0; d4 < 16; ++d4) { const f32x4 kv = *(const f32x4*)(kp + d4 * 4); const float* q = qsw + head * 64 + d4 * 4; dot += kv.x * q[0] + kv.y * q[1] + kv.z * q[2] + kv.w * q[3]; }
            } else {
#pragma unroll
                for (int d = 0; d < 64; ++d) dot += knew[kvh * 64 + d] * qsw[head * 64 + d];
            }
            scs[head * 128 + ci] = dot * c125 - slope * (float)(127 - ci);
        }
        __syncthreads();
        {
            const float sink = sinks[wave];
            const float v0 = scs[wave * 128 + lane], v1 = scs[wave * 128 + 64 + lane];
            const float m = fmaxf(wave_max(fmaxf(v0, v1)), sink);
            const float p0 = __expf(v0 - m), p1 = __expf(v1 - m);
            const float den = wave_sum(p0 + p1) + __expf(sink - m);
            scs[wave * 128 + lane] = p0 / den; scs[wave * 128 + 64 + lane] = p1 / den;
        }
        __syncthreads();
        {
            const int d = tid & 63; float o = 0.f;
#pragma unroll 8
            for (int ci = 0; ci < 127; ++ci) o += scs[head * 128 + ci] * cvv[(ci + 1) * 128 + kvh * 64 + d];
            o += scs[head * 128 + 127] * vnew[kvh * 64 + d];
            MIX[row * DM + 512 + head * 64 + d] = (bf16)f2bf(o);
        }
        float* __restrict__ ok = out + O_SK + ((size_t)el * MSA + s) * 16384; float* __restrict__ ov = out + O_SV + ((size_t)el * MSA + s) * 16384;
        f32x4 ck4[8], cv4[8];
#pragma unroll
        for (int i = 0; i < 8; ++i) { const int i4 = (i * 512 + tid) * 4; const bool past = i4 < 127 * 128;
            ck4[i] = past ? *(const f32x4*)(ck + i4 + 128) : *(const f32x4*)(knew + (i4 & 127));
            cv4[i] = past ? *(const f32x4*)(cvv + i4 + 128) : *(const f32x4*)(vnew + (i4 & 127)); }
#pragma unroll
        for (int i = 0; i < 8; ++i) { const int i4 = (i * 512 + tid) * 4; *(f32x4*)(ok + i4) = ck4[i]; *(f32x4*)(ov + i4) = cv4[i]; }
    }
    __syncthreads();
}
__device__ __forceinline__ void prompt_misc(int tid, int u, int el, const bf16* PROJ, float* out) {
    asm volatile("" : "+v"(tid));
    const int b = u & 1, which = u >> 1;
    float* o = out + (which ? O_PV : O_PK) + ((size_t)el * 2 + b) * 16384;
    for (int i = tid; i < 16384; i += 512) { const int j = i >> 7, rem = i & 127; o[i] = bf2f(PROJ[((size_t)b * SEQ + 8064 + j) * NPE + (which ? 2696 : 2568) + rem]); }
    if (which == 0) { float* oc = out + O_PCONV + ((size_t)el * 2 + b) * 4608;
        for (int i = tid; i < 4608; i += 512) { const int r = i / 1536, chn = i % 1536; oc[i] = bf2f(PROJ[((size_t)b * SEQ + 8189 + r) * NPE + chn]); } }
}

__device__ __forceinline__ void sample_odd(int tid, int s, int ol, unsigned char* lds, const bf16* PROJ, const float* state_gla, const float* Wg, const float* bg, const float* gla_norm, bf16* MIX, float* out) {
    asm volatile("" : "+v"(tid));
    const int lane = tid & 63, wave = tid >> 6;
    const size_t row = (size_t)MPR + s; const bf16* pr = PROJ + row * NPO;
    float* qv = (float*)lds; float* kv = qv + 512; float* egs = kv + 512; float* vv = egs + 512; float* red = vv + 1024;
    {
        float x = bg[tid];
#pragma unroll
        for (int j = 0; j < 16; ++j) x += bf2f(pr[3072 + j]) * Wg[j * 512 + tid];
        const float ls = fminf(x, 0.f) - __logf(1.f + __expf(-fabsf(x)));
        egs[tid] = __expf(ls * (1.f / 16.f));
        qv[tid] = bf2f(pr[tid]) * 0.08838834764831845f; kv[tid] = bf2f(pr[512 + tid]);
        vv[tid] = bf2f(pr[1024 + tid]); vv[tid + 512] = bf2f(pr[1536 + tid]);
    }
    __syncthreads();
    {
        const int h = tid >> 7, dg = (tid >> 6) & 1, e4 = (tid & 63) * 4;
        const float* __restrict__ S = state_gla + (((size_t)ol * MSA + s) * 4 + h) * 32768 + (size_t)(dg * 64) * 256 + e4;
        float* __restrict__ So = out + O_SGLA + (((size_t)ol * MSA + s) * 4 + h) * 32768 + (size_t)(dg * 64) * 256 + e4;
        const f32x4 v4 = *(const f32x4*)(vv + h * 256 + e4);
        const float* kd = kv + h * 128 + dg * 64; const float* ed = egs + h * 128 + dg * 64; const float* qd = qv + h * 128 + dg * 64;
        float* part = red + 16;
        f32x4 o = {0.f, 0.f, 0.f, 0.f};
#pragma unroll 1
        for (int d0 = 0; d0 < 64; d0 += 16) {
            f32x4 sv[16];
#pragma unroll
            for (int d = 0; d < 16; ++d) sv[d] = *(const f32x4*)(S + (d0 + d) * 256);
#pragma unroll
            for (int d = 0; d < 16; ++d) { const f32x4 n = sv[d] * ed[d0 + d] + v4 * kd[d0 + d]; *(f32x4*)(So + (d0 + d) * 256) = n; o += n * qd[d0 + d]; }
        }
        *(f32x4*)(part + (h * 2 + dg) * 256 + e4) = o;
        __syncthreads();
        const f32x4 ot = *(const f32x4*)(part + (h * 2) * 256 + e4) + *(const f32x4*)(part + (h * 2 + 1) * 256 + e4);
        const float ss = wave_sum((ot.x * ot.x + ot.y * ot.y) + (ot.z * ot.z + ot.w * ot.w));
        const float rstd = rsqrtf(ss * (1.f / 256.f) + EPS);
        if (dg == 0) {
            const u32x2 rw = *(const u32x2*)(pr + 2048 + h * 256 + e4);
            const f32x4 nn = *(const f32x4*)(gla_norm + e4);
            u32x2 w; w.x = pk2(ot.x * rstd * nn.x * siluf(bflo(rw.x)), ot.y * rstd * nn.y * siluf(bfhi(rw.x)));
            w.y = pk2(ot.z * rstd * nn.z * siluf(bflo(rw.y)), ot.w * rstd * nn.w * siluf(bfhi(rw.y)));
            *(u32x2*)(MIX + row * DM + h * 256 + e4) = w;
        }
    }
    __syncthreads();
}

__device__ __forceinline__ void gla_stepA(int tid, int unit, unsigned char* lds, const bf16* PROJ, const float* Wg, const float* bg, bf16* US_, bf16* QT_, bf16* OI, float* EGL_) {
    asm volatile("" : "+v"(tid));
    const int lane = tid & 63, wave = tid >> 6, m16 = lane & 15, q4 = lane >> 4;
    const int h = unit & 3, c = (unit >> 2) & 127, b = unit >> 9;
    const size_t row0 = (size_t)b * SEQ + c * 64; const size_t ch = (size_t)unit;
    float* Gs = (float*)lds;
    bf16* qs = (bf16*)(lds + 32768); bf16* ks = (bf16*)(lds + 50176);
    bf16* kT = (bf16*)(lds + 67584);
    bf16* vT = (bf16*)(lds + 86016);
    bf16* as = (bf16*)(lds + 122880);
    float* qt = (float*)(lds + 132096);
    float* gdl = (float*)(lds + 134144);
    u32x4 rq[4], rv[4];
    float wg[16];
    const unsigned short gd0 = PROJ[(row0 + (tid >> 4)) * NPO + 3072 + (tid & 15)], gd1 = PROJ[(row0 + 32 + (tid >> 4)) * NPO + 3072 + (tid & 15)];
#pragma unroll
    for (int j = 0; j < 16; ++j) wg[j] = Wg[j * 512 + h * 128 + (tid & 127)];
#pragma unroll
    for (int i = 0; i < 4; ++i) {
        const int item = i * 512 + tid, part = item >> 10, t = (item >> 4) & 63, cg = item & 15;
        rq[i] = *(const u32x4*)(PROJ + (row0 + t) * NPO + part * 512 + h * 128 + cg * 8);
        const int t2 = item >> 5, eg8 = item & 31;
        rv[i] = *(const u32x4*)(PROJ + (row0 + t2) * NPO + 1024 + h * 256 + eg8 * 8);
    }
    gdl[tid] = bf2f(gd0); gdl[tid + 512] = bf2f(gd1);
    __syncthreads();
    {
        const int d = tid & 127, tq = tid >> 7, col = h * 128 + d;
        const float bgc = bg[col]; float run = 0.f;
        float cum[16];
#pragma unroll
        for (int tt = 0; tt < 16; ++tt) {
            const int t = tq * 16 + tt; float x = bgc;
            const f32x4 gq0 = *(const f32x4*)(gdl + t * 16), gq1 = *(const f32x4*)(gdl + t * 16 + 4), gq2 = *(const f32x4*)(gdl + t * 16 + 8), gq3 = *(const f32x4*)(gdl + t * 16 + 12);
            x += gq0.x * wg[0] + gq0.y * wg[1] + gq0.z * wg[2] + gq0.w * wg[3];
            x += gq1.x * wg[4] + gq1.y * wg[5] + gq1.z * wg[6] + gq1.w * wg[7];
            x += gq2.x * wg[8] + gq2.y * wg[9] + gq2.z * wg[10] + gq2.w * wg[11];
            x += gq3.x * wg[12] + gq3.y * wg[13] + gq3.z * wg[14] + gq3.w * wg[15];
            const float ls = fminf(x, 0.f) - __logf(1.f + __expf(-fabsf(x)));
            run += ls * (1.f / 16.f);
            cum[tt] = run;
        }
        qt[tq * 128 + d] = run;
        __syncthreads();
        float off = 0.f;
#pragma unroll
        for (int q = 0; q < 3; ++q) off += (q < tq) ? qt[q * 128 + d] : 0.f;
#pragma unroll
        for (int tt = 0; tt < 16; ++tt) Gs[(tq * 16 + tt) * 128 + d] = cum[tt] + off;
    }
    __syncthreads();
    {
#pragma unroll
        for (int i = 0; i < 4; ++i) {
            const int item = i * 512 + tid, part = item >> 10, t = (item >> 4) & 63, cg = item & 15;
            float f[8]; unpack8(rq[i], f);
            float o[8];
            const f32x4 g0 = *(const f32x4*)(Gs + t * 128 + cg * 8), g1 = *(const f32x4*)(Gs + t * 128 + cg * 8 + 4), l0 = *(const f32x4*)(Gs + 63 * 128 + cg * 8), l1 = *(const f32x4*)(Gs + 63 * 128 + cg * 8 + 4);
            const float dls[8] = {g0.x - l0.x, g0.y - l0.y, g0.z - l0.z, g0.w - l0.w, g1.x - l1.x, g1.y - l1.y, g1.z - l1.z, g1.w - l1.w};
#pragma unroll
            for (int j = 0; j < 8; ++j) { const float dl = dls[j]; o[j] = part == 0 ? f[j] * 0.08838834764831845f * __expf(dl) : f[j] * __expf(-dl); }
            const u32x4 w = pack8(o);
            if (part == 0) { *(u32x4*)(qs + t * 136 + cg * 8) = w; *(u32x4*)(QT_ + ch * 8192 + t * 128 + cg * 8) = w; }
            else { *(u32x4*)(ks + t * 136 + cg * 8) = w;
#pragma unroll
                for (int j = 0; j < 8; ++j) kT[(cg * 8 + j) * 72 + (((t >> 3) ^ (cg & 7)) << 3) + (t & 7)] = (bf16)f2bf(o[j]); }
        }
#pragma unroll
        for (int i = 0; i < 4; ++i) {
            const int item = i * 512 + tid, t = item >> 5, eg8 = item & 31;
            const u32x4 w = rv[i];
            bf16* vp = vT + (eg8 * 8) * 72 + (((t >> 3) ^ (eg8 & 7)) << 3) + (t & 7);
            vp[0] = (bf16)(w.x & 0xffff); vp[72] = (bf16)(w.x >> 16); vp[144] = (bf16)(w.y & 0xffff); vp[216] = (bf16)(w.y >> 16);
            vp[288] = (bf16)(w.z & 0xffff); vp[360] = (bf16)(w.z >> 16); vp[432] = (bf16)(w.w & 0xffff); vp[504] = (bf16)(w.w >> 16);
        }
    }
    if (tid < 128) EGL_[ch * 128 + tid] = __expf(Gs[63 * 128 + tid]);
    __syncthreads();
    {
        const int mt = wave >> 1;
        bf16x8 aF[4];
#pragma unroll
        for (int k4 = 0; k4 < 4; ++k4) aF[k4] = *(const bf16x8*)(qs + (mt * 16 + m16) * 136 + k4 * 32 + q4 * 8);
#pragma unroll
        for (int n2 = 0; n2 < 2; ++n2) {
            const int nt = (wave & 1) * 2 + n2;
            f32x4 acc = {0.f, 0.f, 0.f, 0.f};
            if (nt <= mt) {
#pragma unroll
                for (int k4 = 0; k4 < 4; ++k4) { const bf16x8 bF = *(const bf16x8*)(ks + (nt * 16 + m16) * 136 + k4 * 32 + q4 * 8); acc = mfma16(aF[k4], bF, acc); }
            }
            const int s = nt * 16 + m16;
#pragma unroll
            for (int i = 0; i < 4; ++i) { const int t = mt * 16 + q4 * 4 + i; as[t * 72 + s] = (bf16)f2bf(t >= s ? acc[i] : 0.f); }
        }
    }
    {
        bf16x8 aF[2];
#pragma unroll
        for (int k2 = 0; k2 < 2; ++k2) { const int rr = wave * 16 + m16; aF[k2] = *(const bf16x8*)(kT + rr * 72 + (((k2 * 4 + q4) ^ ((rr >> 3) & 7)) << 3)); }
#pragma unroll 4
        for (int nt = 0; nt < 16; ++nt) {
            f32x4 acc = {0.f, 0.f, 0.f, 0.f};
#pragma unroll
            for (int k2 = 0; k2 < 2; ++k2) { const int rr = nt * 16 + m16; const bf16x8 bF = *(const bf16x8*)(vT + rr * 72 + (((k2 * 4 + q4) ^ ((rr >> 3) & 7)) << 3)); acc = mfma16(aF[k2], bF, acc); }
            u32x2 w; w.x = pk2(acc[0], acc[1]); w.y = pk2(acc[2], acc[3]);
            *(u32x2*)(US_ + ch * 32768 + (nt * 16 + m16) * 128 + wave * 16 + q4 * 4) = w;
        }
    }
    __syncthreads();
    {
        bf16x8 bF[2][2];
#pragma unroll
        for (int n2 = 0; n2 < 2; ++n2)
#pragma unroll
            for (int k2 = 0; k2 < 2; ++k2) { const int rr = (wave * 2 + n2) * 16 + m16; bF[n2][k2] = *(const bf16x8*)(vT + rr * 72 + (((k2 * 4 + q4) ^ ((rr >> 3) & 7)) << 3)); }
#pragma unroll
        for (int mt = 0; mt < 4; ++mt) {
            bf16x8 aF[2];
#pragma unroll
            for (int k2 = 0; k2 < 2; ++k2) aF[k2] = *(const bf16x8*)(as + (mt * 16 + m16) * 72 + k2 * 32 + q4 * 8);
#pragma unroll
            for (int n2 = 0; n2 < 2; ++n2) {
                f32x4 acc = {0.f, 0.f, 0.f, 0.f};
                acc = mfma16(bF[n2][0], aF[0], acc); acc = mfma16(bF[n2][1], aF[1], acc);
                u32x2 w; w.x = pk2(acc[0], acc[1]); w.y = pk2(acc[2], acc[3]);
                ((u32x2*)OI)[(((ch * 8 + wave) * 4 + mt) * 2 + n2) * 64 + lane] = w;
            }
        }
    }
    __syncthreads();
}

__device__ __forceinline__ void gla_scan(bf16* US_, const float* __restrict__ EGL_, float* __restrict__ state_out, int gtid, int ngt) {
    for (int idx = gtid; idx < 131072; idx += ngt) {
        const int dp = idx & 63, e = (idx >> 6) & 255, bh = idx >> 14, b = bh >> 2, h = bh & 3;
        float s0 = 0.f, s1 = 0.f;
        unsigned* p = (unsigned*)(US_ + ((size_t)b * 512 + h) * 32768 + e * 128 + dp * 2);
        const float* eg = EGL_ + ((size_t)b * 512 + h) * 128 + dp * 2;
        constexpr size_t PS = (size_t)4 * 32768 / 2, GS = (size_t)4 * 128;
        unsigned ua[8], ub[8]; f32x2v ga[8], gb[8];
#define GSC_LOAD(c0, u_, g_) do { _Pragma("unroll") for (int k = 0; k < 8; ++k) { const int cc = (c0) + k < 128 ? (c0) + k : 127; u_[k] = p[cc * PS]; g_[k] = *(const f32x2v*)(eg + cc * GS); } } while (0)
#define GSC_PROC(c0, u_, g_) do { _Pragma("unroll") for (int k = 0; k < 8; ++k) { s0 *= g_[k].x; s1 *= g_[k].y; p[((c0) + k) * PS] = pk2(s0, s1); s0 += bflo(u_[k]); s1 += bfhi(u_[k]); } } while (0)
        GSC_LOAD(0, ua, ga);
#pragma unroll 1
        for (int c0 = 0; c0 < 128; c0 += 16) {
            GSC_LOAD(c0 + 8, ub, gb);
            GSC_PROC(c0, ua, ga);
            GSC_LOAD(c0 + 16, ua, ga);
            GSC_PROC(c0 + 8, ub, gb);
        }
#undef GSC_LOAD
#undef GSC_PROC
        float* so = state_out + ((size_t)(b * 4 + h) * 128 + dp * 2) * 256 + e;
        so[0] = s0; so[256] = s1;
    }
}

__device__ __forceinline__ void gla_stepC(int tid, int unit, unsigned char* lds, const bf16* __restrict__ PROJ, const bf16* __restrict__ US_, const bf16* __restrict__ QT_, const bf16* __restrict__ OI, const float* gla_norm, bf16* __restrict__ MIX) {
    asm volatile("" : "+v"(tid));
    const int lane = tid & 63, wave = tid >> 6, m16 = lane & 15, q4 = lane >> 4;
    const int h = unit & 3, c = (unit >> 2) & 127, b = unit >> 9;
    const size_t row0 = (size_t)b * SEQ + c * 64; const size_t ch = (size_t)unit;
    float* red = (float*)lds;
    bf16x8 sB[2][4], aF[4][4]; u32x2 oi[4][2], rg[4][2];
#pragma unroll
    for (int n2 = 0; n2 < 2; ++n2)
#pragma unroll
        for (int k4 = 0; k4 < 4; ++k4) sB[n2][k4] = *(const bf16x8*)(US_ + ch * 32768 + ((wave * 2 + n2) * 16 + m16) * 128 + k4 * 32 + q4 * 8);
#pragma unroll
    for (int mt = 0; mt < 4; ++mt) {
#pragma unroll
        for (int k4 = 0; k4 < 4; ++k4) aF[mt][k4] = *(const bf16x8*)(QT_ + ch * 8192 + (mt * 16 + m16) * 128 + k4 * 32 + q4 * 8);
#pragma unroll
        for (int n2 = 0; n2 < 2; ++n2) { oi[mt][n2] = ((const u32x2*)OI)[(((ch * 8 + wave) * 4 + mt) * 2 + n2) * 64 + lane];
            rg[mt][n2] = *(const u32x2*)(PROJ + (row0 + mt * 16 + m16) * NPO + 2048 + h * 256 + (wave * 2 + n2) * 16 + q4 * 4); }
    }
    f32x4 acc[4][2];
#pragma unroll
    for (int mt = 0; mt < 4; ++mt) {
        float ss = 0.f;
#pragma unroll
        for (int n2 = 0; n2 < 2; ++n2) {
            f32x4 a = {bflo(oi[mt][n2].x), bfhi(oi[mt][n2].x), bflo(oi[mt][n2].y), bfhi(oi[mt][n2].y)};
#pragma unroll
            for (int k4 = 0; k4 < 4; ++k4) a = mfma16(sB[n2][k4], aF[mt][k4], a);
            acc[mt][n2] = a;
            ss += (a[0] * a[0] + a[1] * a[1]) + (a[2] * a[2] + a[3] * a[3]);
        }
        ss += __shfl_xor(ss, 16); ss += __shfl_xor(ss, 32);
        if (q4 == 0) red[wave * 64 + mt * 16 + m16] = ss;
    }
    __syncthreads();
    f32x4 gn[2];
#pragma unroll
    for (int n2 = 0; n2 < 2; ++n2) gn[n2] = *(const f32x4*)(gla_norm + (wave * 2 + n2) * 16 + q4 * 4);
#pragma unroll
    for (int mt = 0; mt < 4; ++mt) {
        const int t = mt * 16 + m16; float tot = 0.f;
#pragma unroll
        for (int w = 0; w < 8; ++w) tot += red[w * 64 + t];
        const float rstd = rsqrtf(tot * (1.f / 256.f) + EPS);
#pragma unroll
        for (int n2 = 0; n2 < 2; ++n2) {
            const f32x4 a = acc[mt][n2]; const u32x2 r = rg[mt][n2];
            u32x2 w; w.x = pk2(a[0] * rstd * gn[n2][0] * siluf(bflo(r.x)), a[1] * rstd * gn[n2][1] * siluf(bfhi(r.x)));
            w.y = pk2(a[2] * rstd * gn[n2][2] * siluf(bflo(r.y)), a[3] * rstd * gn[n2][3] * siluf(bfhi(r.y)));
            *(u32x2*)(MIX + (row0 + t) * DM + h * 256 + (wave * 2 + n2) * 16 + q4 * 4) = w;
        }
    }
    __syncthreads();
}

template <int MODE>
__device__ __forceinline__ void skinny_unit(int tid, const bf16* A, const bf16* Bt, int K, int ld, size_t row0, int col0, void* C, int ldc, float sgn = 1.f) {
    asm volatile("" : "+v"(tid));
    const int lane = tid & 63, wave = tid >> 6, m16 = lane & 15, q4 = lane >> 4;
    const bf16* ap = A + (row0 + wave * 16 + m16) * ld + q4 * 8;
    const bf16* bp = Bt + (size_t)(col0 + m16) * ld + q4 * 8;
    f32x4 acc0 = {0.f, 0.f, 0.f, 0.f}, acc1 = {0.f, 0.f, 0.f, 0.f};
#pragma unroll 1
    for (int k = 0; k < K; k += 256) {
        bf16x8 av[8], bv[8];
#pragma unroll
        for (int j = 0; j < 8; ++j) { av[j] = *(const bf16x8*)(ap + k + j * 32); bv[j] = *(const bf16x8*)(bp + k + j * 32); }
#pragma unroll
        for (int j = 0; j < 8; j += 2) { acc0 = mfma16(av[j], bv[j], acc0); acc1 = mfma16(av[j + 1], bv[j + 1], acc1); }
    }
    const f32x4 acc = acc0 + acc1;
    const size_t r = row0 + wave * 16 + q4 * 4; const int c = col0 + m16;
#pragma unroll
    for (int i = 0; i < 4; ++i) {
        if (MODE == 3) { atomicAdd((float*)C + (r + i) * ldc + c, acc[i] * sgn); }
        else { float v = acc[i]; if (MODE == 2) { v = v > 0.f ? v : 0.f; v = v * v; } ((bf16*)C)[(r + i) * ldc + c] = (bf16)f2bf(v); }
    }
}

__device__ __forceinline__ void skinny_res(int tid, int unit, unsigned char* lds, const bf16* __restrict__ A, const bf16* __restrict__ Bt, int K, float* __restrict__ X) {
    asm volatile("" : "+v"(tid));
    const int lane = tid & 63, wave = tid >> 6, m16 = lane & 15, q4 = lane >> 4;
    const int rg = unit >> 6, ct = unit & 63, rt = wave & 1, ksl = wave >> 1, Ks = K >> 2;
    const bf16* ap = A + ((size_t)MPR + rg * 32 + rt * 16 + m16) * K + ksl * Ks + q4 * 8;
    const bf16* bp = Bt + (size_t)(ct * 16 + m16) * K + ksl * Ks + q4 * 8;
    f32x4 acc0 = {0.f, 0.f, 0.f, 0.f}, acc1 = {0.f, 0.f, 0.f, 0.f};
#pragma unroll 1
    for (int k = 0; k < Ks; k += 256) {
        bf16x8 av[8], bv[8];
#pragma unroll
        for (int j = 0; j < 8; ++j) { av[j] = *(const bf16x8*)(ap + k + j * 32); bv[j] = *(const bf16x8*)(bp + k + j * 32); }
#pragma unroll
        for (int j = 0; j < 8; j += 2) { acc0 = mfma16(av[j], bv[j], acc0); acc1 = mfma16(av[j + 1], bv[j + 1], acc1); }
    }
    f32x4* red = (f32x4*)lds;
    red[wave * 64 + lane] = acc0 + acc1;
    __syncthreads();
    if (ksl == 0) {
        const f32x4 t = (red[rt * 64 + lane] + red[(2 + rt) * 64 + lane]) + (red[(4 + rt) * 64 + lane] + red[(6 + rt) * 64 + lane]);
        float* xp = X + ((size_t)MPR + rg * 32 + rt * 16 + q4 * 4) * DM + ct * 16 + m16;
#pragma unroll
        for (int i = 0; i < 4; ++i) xp[i * DM] += t[i];
    }
    __syncthreads();
}

#define LAS __attribute__((address_space(3)))
#define XB_TMO      128
#define XB_XCNT(j)  (256  + 64 * (j))
#define XB_XSUB(j)  (1280 + 64 * (j))
#define XB_XGEN(j)  (2304 + 64 * (j))
#define XB_TOP      3328
#define XB_TOPGEN   3392
#define XCD_BAR_WORDS 3456
#define XB_SPIN_CAP (1u << 18)

__device__ __forceinline__ unsigned xb_ld(unsigned* p)              { return __hip_atomic_load(p, __ATOMIC_RELAXED, __HIP_MEMORY_SCOPE_AGENT); }
__device__ __forceinline__ unsigned xb_add(unsigned* p, unsigned v) { return __hip_atomic_fetch_add(p, v, __ATOMIC_RELAXED, __HIP_MEMORY_SCOPE_AGENT); }
__device__ __forceinline__ unsigned xb_xcc_id() { return (unsigned)__builtin_amdgcn_s_getreg((3 << 11) | 20) & 0xFu; }
#define XB_SPIN(cond, bar) do { unsigned _sp = 0; while (cond) { __builtin_amdgcn_s_sleep(1); \
    if ((++_sp & 255u) == 0u) { if (xb_ld(&(bar)[XB_TMO])) break; if (_sp > XB_SPIN_CAP) { atomicAdd(&(bar)[XB_TMO], 1u); break; } } } } while (0)

struct XcdBarrier {
    unsigned* bar; unsigned x;
    volatile LAS unsigned* st;
};

__device__ __forceinline__ XcdBarrier xcd_barrier_post(unsigned* bar, volatile LAS unsigned* st) {
    XcdBarrier b; b.bar = bar; b.x = xb_xcc_id(); b.st = st;
    if (threadIdx.x == 0) (void)xb_add(&bar[XB_XCNT(b.x)], 1u);
    return b;
}
__device__ __forceinline__ void xcd_barrier_complete(unsigned* bar, unsigned x, unsigned& nloc, unsigned& nx) {
    const unsigned G = gridDim.x * gridDim.y * gridDim.z;
    unsigned sum, cnt, mine, sp = 0u;
    for (;;) {
        sum = 0u; cnt = 0u; mine = 0u;
#pragma unroll
        for (unsigned j = 0; j < 16; ++j) { const unsigned c = xb_ld(&bar[XB_XCNT(j)]); sum += c; cnt += (c > 0u) ? 1u : 0u; mine = (j == x) ? c : mine; }
        if (sum == G) break;
        __builtin_amdgcn_s_sleep(1);
        if ((++sp & 255u) == 0u) { if (xb_ld(&bar[XB_TMO])) break; if (sp > XB_SPIN_CAP) { atomicAdd(&bar[XB_TMO], 1u); break; } }
    }
    nloc = mine > 0u ? mine : 1u; nx = cnt > 0u ? cnt : 1u;
}

__device__ __forceinline__ void xcd_barrier(const XcdBarrier& b) {
    asm volatile("s_waitcnt vmcnt(0)" ::: "memory");
    __syncthreads();
    if (threadIdx.x == 0) {
        unsigned* bar = b.bar;
        __builtin_amdgcn_s_waitcnt(0);
        unsigned nloc = b.st[0], nx = b.st[1];
        if (nloc == 0u) { xcd_barrier_complete(bar, b.x, nloc, nx); b.st[0] = nloc; b.st[1] = nx; }
        const unsigned old = xb_add(&bar[XB_XSUB(b.x)], 1u);
        const unsigned gen = old / nloc;
        if (old + 1u == (gen + 1u) * nloc) {
            __builtin_amdgcn_fence(__ATOMIC_RELEASE, "agent");
            asm volatile("s_waitcnt vmcnt(0)" ::: "memory");
            const unsigned og = xb_add(&bar[XB_TOP], 1u);
            const unsigned tg = og / nx;
            if (og + 1u == (tg + 1u) * nx) xb_add(&bar[XB_TOPGEN], 1u);
            else XB_SPIN(xb_ld(&bar[XB_TOPGEN]) == tg, bar);
            __builtin_amdgcn_fence(__ATOMIC_ACQUIRE, "agent");
            xb_add(&bar[XB_XGEN(b.x)], 1u);
            asm volatile("s_waitcnt vmcnt(0)" ::: "memory");
        } else {
            XB_SPIN(xb_ld(&bar[XB_XGEN(b.x)]) == gen, bar);
            __builtin_amdgcn_fence(__ATOMIC_ACQUIRE, "agent");
            asm volatile("s_waitcnt vmcnt(0)" ::: "memory");
        }
    }
    __syncthreads();
}

#ifndef PROBE_ID
#define PROBE_ID 0
#endif
constexpr size_t WS_TAB = 4096, WS_BAR = 16384;
constexpr int LDS_BARW = 147392;
__global__ void __launch_bounds__(512, 2) mega_fwd(Args a) {
    extern __shared__ __attribute__((aligned(16))) unsigned char lds[];
    const bool coop = (a.ph_hi - a.ph_lo) > 1;
    if (threadIdx.x < 4) ((LAS unsigned*)((LAS unsigned char*)lds + LDS_BARW))[threadIdx.x] = 0u;
    __syncthreads();
    XcdBarrier xbar; xbar.bar = (unsigned*)(a.ws + WS_BAR); xbar.x = 0; xbar.st = nullptr;
    if (coop) xbar = xcd_barrier_post((unsigned*)(a.ws + WS_BAR), (volatile LAS unsigned*)((LAS unsigned char*)lds + LDS_BARW));
#if PROBE_ID
    bool repeated = false; int repcnt = 0; unsigned donemask = 0u;
#endif
#pragma unroll 1
    for (int ph = a.ph_lo; ph < a.ph_hi; ++ph) {
        int tid = threadIdx.x; asm volatile("" : "+v"(tid));
        int bid = blockIdx.x; asm volatile("" : "+s"(bid));
        unsigned char* ws = a.ws; asm volatile("" : "+s"(ws));
        float* outp = a.out; asm volatile("" : "+s"(outp));
        const int lane = tid & 63, wave = tid >> 6;
        const int G = gridDim.x;
        const int gw = bid * 8 + wave, ngw = G * 8;
        bf16* WEI = (bf16*)(ws + WS_WEI); bf16* WEO = (bf16*)(ws + WS_WEO); bf16* WGI = (bf16*)(ws + WS_WGI); bf16* WGO = (bf16*)(ws + WS_WGO);
        bf16* WUP = (bf16*)(ws + WS_WUP); bf16* WDN = (bf16*)(ws + WS_WDN);
        float* X = (float*)(ws + WS_X); bf16* HB = (bf16*)(ws + WS_HB); bf16* MIX = (bf16*)(ws + WS_MIX);
        bf16* PROJ = (bf16*)(ws + WS_BIG); bf16* HID = (bf16*)(ws + WS_BIG);
        const float* const* in = (const float* const*)(ws + WS_TAB);
        if (ph == 0) {
            if (bid == 0 && tid == 0) { const float** tw = (const float**)(ws + WS_TAB);
#pragma unroll
                for (int k = 0; k < 24; ++k) tw[k] = a.in[k]; }
            float* scr = (float*)(lds + wave * 16640);
            transpose_w(a.in[10], DM, NE_IN, NPE, WEI, scr, gw, ngw, lane);
            for (int m = gw; m < MPAD; m += ngw) {
                f32x4 v[4];
                const float* src = m < MPR ? a.in[0] + (size_t)m * DM : (m < MREAL ? a.in[1] + (size_t)(m - MPR) * DM : nullptr);
#pragma unroll
                for (int j = 0; j < 4; ++j) { v[j] = src ? *(const f32x4*)(src + 4 * lane + 256 * j) : (f32x4){0.f, 0.f, 0.f, 0.f}; if (m >= MPR) *(f32x4*)(X + (size_t)m * DM + 4 * lane + 256 * j) = v[j]; }
                norm_row(v, a.in[7], HB + (size_t)m * DM, nullptr, lane);
                if (m >= MREAL) {
#pragma unroll
                    for (int j = 0; j < 4; ++j) { u32x2 z = {0u, 0u}; *(u32x2*)(MIX + (size_t)m * DM + 4 * lane + 256 * j) = z; }
                }
            }
        } else {
            const int l = (ph - 1) / 9, sp = (ph - 1) % 9, even = !(l & 1), li = l >> 1;
            if (sp == 0) {
                const bf16* Bt = even ? WEI + (size_t)li * NPE * DM : WGI + (size_t)li * NPO * DM; const int ldp = even ? NPE : NPO;
                pg8::Gemm g{HB, Bt, MPR, 3072, DM};
                pg8::StaticOrder S; S.init(g.M, g.N, G, bid);
                pg8::EpiBf16<0> E{PROJ, ldp};
                pg8::gemm_phase<pg8::EpiBf16<0>, pg8::StaticOrder, true, true>((PG8_LAS unsigned char*)lds, g, S, E);
                const int nts = even ? 177 : 193, nsk = even ? nts : nts + 128;
                for (int u = bid; u < nsk; u += G) {
                    if (u < nts) skinny_unit<0>(tid, HB, Bt, DM, DM, (size_t)MPR, u * 16, PROJ, ldp);
                    else skinny_unit<0>(tid, HB, Bt, DM, DM, (size_t)(u - nts) * 128, 3072, PROJ, ldp);
                }
            } else if (sp == 1) {
                if (even) {
                    const float* cw = in[11] + (size_t)li * 4 * 1536; const float* al = in[12] + li * 4; const float* dtb = in[13] + li * 4;
                    for (int u = bid; u < 1024; u += G)
                        dn_stepA(tid, u, lds, PROJ, cw, al, dtb,
                                 (bf16*)(ws + SC_DN_W), (bf16*)(ws + SC_DN_QE), (bf16*)(ws + SC_DN_KT), (bf16*)(ws + SC_DN_AT), (bf16*)(ws + SC_DN_U), (float*)(ws + SC_DN_EGL));
                } else {
                    const float* wg = in[18] + (size_t)li * 16 * 512; const float* bgp = in[19] + li * 512;
                    for (int u = bid; u < 1024; u += G)
                        gla_stepA(tid, u, lds, PROJ, wg, bgp, (bf16*)(ws + SC_GL_US), (bf16*)(ws + SC_GL_QT), (bf16*)(ws + SC_GL_OI), (float*)(ws + SC_GL_EGL));
                }
            } else if (sp == 2) {
                if (even) {
                    const int nb = G > 64 ? 64 : G;
#if PROBE_ID == 12
                    if (!repeated)
#endif
                    if (bid < nb) { for (int it = bid; it < 64; it += nb)
                        dn_stepB(tid, it, lds, (const bf16*)(ws + SC_DN_W), (const bf16*)(ws + SC_DN_KT), (const bf16*)(ws + SC_DN_U),
                                 (const float*)(ws + SC_DN_EGL), (bf16*)(ws + SC_DN_O), (bf16*)(ws + SC_DN_VN), outp + O_PDN + (size_t)li * 2 * 4 * 16384); }
                    const int ob = G > 64 ? bid - 64 : bid, on = G > 64 ? G - 64 : G;
#if PROBE_ID == 11
                    if (!repeated)
#endif
                    if (ob >= 0) {
                        const float* sdn = in[2]; const float* scv = in[3]; const float* ckp = in[4]; const float* cvp = in[5];
                        const float* cw = in[11] + (size_t)li * 4 * 1536; const float* al = in[12] + li * 4; const float* dtb = in[13] + li * 4;
                        const float* dnn = in[14] + li * 128; const float* snk = in[15] + li * 8;
                        for (int u = ob; u < 256 + MSA + 4; u += on) {
                            if (u < 256) swa_prompt(tid, u, lds, PROJ, snk, MIX);
                            else if (u < 256 + MSA) sample_even(tid, u - 256, li, lds, PROJ, sdn, scv, ckp, cvp, cw, al, dtb, dnn, snk, MIX, outp);
                            else prompt_misc(tid, u - 256 - MSA, li, PROJ, outp);
                        }
                        if (l == 0) {
                            float* scr = (float*)(lds + wave * 16640);
                            const int gw2 = ob * 8 + wave, ngw2 = on * 8;
                            transpose_w(in[16], DM, DM, DM, WEO, scr, gw2, ngw2, lane);
                            transpose_w(in[22], DM, FF, FF, WUP, scr, gw2, ngw2, lane);
                            transpose_w(in[23], FF, DM, DM, WDN, scr, gw2, ngw2, lane);
                            transpose_w(in[17], DM, NO_IN, NPO, WGI, scr, gw2, ngw2, lane);
                            transpose_w(in[21], DM, DM, DM, WGO, scr, gw2, ngw2, lane);
                            transpose_w(in[22] + (size_t)1 * DM * FF, DM, FF, FF, WUP + (size_t)1 * FF * DM, scr, gw2, ngw2, lane);
                            transpose_w(in[23] + (size_t)1 * FF * DM, FF, DM, DM, WDN + (size_t)1 * DM * FF, scr, gw2, ngw2, lane);
                            transpose_w(in[10] + (size_t)DM * NE_IN, DM, NE_IN, NPE, WEI + (size_t)NPE * DM, scr, gw2, ngw2, lane);
                            transpose_w(in[16] + (size_t)DM * DM, DM, DM, DM, WEO + (size_t)DM * DM, scr, gw2, ngw2, lane);
                            transpose_w(in[22] + (size_t)2 * DM * FF, DM, FF, FF, WUP + (size_t)2 * FF * DM, scr, gw2, ngw2, lane);
                            transpose_w(in[23] + (size_t)2 * FF * DM, FF, DM, DM, WDN + (size_t)2 * DM * FF, scr, gw2, ngw2, lane);
                            __syncthreads();
                        }
                        if (l == 2) {
                            float* scr = (float*)(lds + wave * 16640);
                            const int gw2 = ob * 8 + wave, ngw2 = on * 8;
                            transpose_w(in[17] + (size_t)DM * NO_IN, DM, NO_IN, NPO, WGI + (size_t)NPO * DM, scr, gw2, ngw2, lane);
                            transpose_w(in[21] + (size_t)DM * DM, DM, DM, DM, WGO + (size_t)DM * DM, scr, gw2, ngw2, lane);
                            transpose_w(in[22] + (size_t)3 * DM * FF, DM, FF, FF, WUP + (size_t)3 * FF * DM, scr, gw2, ngw2, lane);
                            transpose_w(in[23] + (size_t)3 * FF * DM, FF, DM, DM, WDN + (size_t)3 * DM * FF, scr, gw2, ngw2, lane);
                            __syncthreads();
                        }
                    }
                } else {
                    const int nsc = G >= 2 ? G / 2 : G;
                    if (bid < nsc) gla_scan((bf16*)(ws + SC_GL_US), (const float*)(ws + SC_GL_EGL), outp + O_PGLA + (size_t)li * 2 * 4 * 32768, bid * 512 + tid, nsc * 512);
                    if (G < 2 || bid >= nsc) {
                        const float* wg = in[18] + (size_t)li * 16 * 512; const float* bgp = in[19] + li * 512; const float* gn = in[20] + li * 256; const float* sg = in[6];
                        const int ob = G >= 2 ? bid - nsc : 0, on = G >= 2 ? G - nsc : 1;
                        for (int u = ob; u < MSA; u += on) sample_odd(tid, u, li, lds, PROJ, sg, wg, bgp, gn, MIX, outp);
                    }
                }
            } else if (sp == 3) {
                if (even) { const float* dnn = in[14] + li * 128;
                    for (int u = bid; u < 1024; u += G) dn_stepC(tid, u, lds, PROJ, (const bf16*)(ws + SC_DN_QE), (const bf16*)(ws + SC_DN_AT), (const bf16*)(ws + SC_DN_O), (const bf16*)(ws + SC_DN_VN), dnn, MIX); }
                else { const float* gn = in[20] + li * 256;
                    for (int u = bid; u < 1024; u += G) gla_stepC(tid, u, lds, PROJ, (const bf16*)(ws + SC_GL_US), (const bf16*)(ws + SC_GL_QT), (const bf16*)(ws + SC_GL_OI), gn, MIX); }
            } else if (sp == 4 || sp == 7) {
                pg8::Gemm g{sp == 4 ? MIX : HID, sp == 4 ? (even ? WEO : WGO) + (size_t)li * DM * DM : WDN + (size_t)l * DM * FF, MPR, DM, sp == 4 ? DM : FF};
                pg8::StaticOrder S; S.init(g.M, g.N, G, bid);
#if PROBE_ID == 13 || PROBE_ID == 14
                const float sgn = (repcnt == 1) ? -1.f : 1.f;
#else
                const float sgn = 1.f;
#endif
                pg8::EpiRes E{X, DM, sgn, (l == 0 && sp == 4) ? in[0] : (const float*)X};
                pg8::gemm_phase<pg8::EpiRes, pg8::StaticOrder, true, true>((PG8_LAS unsigned char*)lds, g, S, E);
                for (int u = bid; u < 256; u += G) skinny_res(tid, u, lds, g.A, g.Bt, g.K, X);
            } else if (sp == 5) {
                norm_phase(X, in[8] + l * DM, HB, nullptr, gw, ngw, lane);
            } else if (sp == 6) {
                pg8::Gemm g{HB, WUP + (size_t)l * FF * DM, MPR, FF, DM};
                pg8::StaticOrder S; S.init(g.M, g.N, G, bid);
                pg8::EpiBf16<2> E{HID, FF};
                pg8::gemm_phase<pg8::EpiBf16<2>, pg8::StaticOrder, true, true>((PG8_LAS unsigned char*)lds, g, S, E);
                for (int u = bid; u < 256; u += G) skinny_unit<2>(tid, g.A, g.Bt, DM, DM, (size_t)MPR, u * 16, HID, FF);
            } else {
                if (l < 3) norm_phase(X, in[7] + (l + 1) * DM, HB, nullptr, gw, ngw, lane);
                else norm_phase(X, in[9], nullptr, outp + O_Y, gw, ngw, lane);
            }
        }
#if PROBE_ID
        if (coop) {
            const int l_ = (ph - 1) / 9, sp_ = (ph - 1) % 9, ev_ = !(l_ & 1);
            bool rp = false;
            if (PROBE_ID == 1) xcd_barrier(xbar);
            if (PROBE_ID == 2 && ph == 0) rp = true;
            if (ph > 0) {
                if (PROBE_ID == 3 && ev_ && sp_ == 1) rp = true;
                if ((PROBE_ID == 4 || PROBE_ID == 11 || PROBE_ID == 12) && ev_ && sp_ == 2) rp = true;
                if (PROBE_ID == 5 && !ev_ && sp_ == 1) rp = true;
                if (PROBE_ID == 6 && sp_ == 0) rp = true;
                if (PROBE_ID == 7 && sp_ == 6) rp = true;
                if (PROBE_ID == 8 && !ev_ && sp_ == 3) rp = true;
                if (PROBE_ID == 9 && (sp_ == 5 || sp_ == 8)) rp = true;
                if (PROBE_ID == 10 && ev_ && sp_ == 3) rp = true;
            }
            if ((PROBE_ID == 13 && ph > 0 && sp_ == 4) || (PROBE_ID == 14 && ph > 0 && sp_ == 7)) { if (repcnt < 2) { ++repcnt; --ph; xcd_barrier(xbar); continue; } repcnt = 0; }
            if (PROBE_ID == 15 && ph > 0 && !ev_ && sp_ == 2 && !((donemask >> l_) & 1u)) { donemask |= 1u << l_; ph -= 2; xcd_barrier(xbar); continue; }
            if (rp && !repeated) { repeated = true; --ph; xcd_barrier(xbar); continue; }
            repeated = false;
        }
#endif
        if (ph + 1 < a.ph_hi) { if (coop) xcd_barrier(xbar); }
    }
}

extern "C" void kernel_launch(void* const* d_in, const int* in_sizes, int n_in, void* d_out, int out_size, void* d_ws, size_t ws_size, hipStream_t stream) {
    static int grid = 0;
    if (grid == 0) {
        int dev = 0, cus = 0, per_cu = 0;
        hipGetDevice(&dev);
        hipDeviceGetAttribute(&cus, hipDeviceAttributeMultiprocessorCount, dev);
        hipFuncSetAttribute((const void*)mega_fwd, hipFuncAttributeMaxDynamicSharedMemorySize, LDS_BYTES);
        hipOccupancyMaxActiveBlocksPerMultiprocessor(&per_cu, (const void*)mega_fwd, 512, LDS_BYTES);
        if (per_cu < 1) { fprintf(stderr, "kernel_launch: occupancy query says %d blocks/CU\n", per_cu); per_cu = 1; }
        grid = cus * (per_cu > 1 ? 1 : per_cu);
        if (ws_size < WS_END) { fprintf(stderr, "kernel_launch: workspace too small: %zu < %zu\n", ws_size, (size_t)WS_END); grid = -1; }
        if (n_in != 24) { fprintf(stderr, "kernel_launch: expected 24 inputs, got %d\n", n_in); grid = -1; }
    }
    if (grid < 0) return;
    Args a{};
    for (int i = 0; i < 24; ++i) a.in[i] = (const float*)d_in[i];
    a.out = (float*)d_out; a.ws = (unsigned char*)d_ws;
#if MK_LAUNCH_PER_PHASE
    for (int ph = 0; ph < NPH; ++ph) { a.ph_lo = ph; a.ph_hi = ph + 1; hipLaunchKernelGGL(mega_fwd, dim3(grid), dim3(512), LDS_BYTES, stream, a); }
#else
    a.ph_lo = 0; a.ph_hi = NPH;
    if (hipMemsetAsync((char*)d_ws + WS_BAR, 0, 16384, stream) != hipSuccess) { fprintf(stderr, "kernel_launch: memset of barrier words failed\n"); return; }
    void* args[] = {&a};
    hipError_t e = hipLaunchCooperativeKernel((const void*)mega_fwd, dim3(grid), dim3(512), args, LDS_BYTES, stream);
    if (e != hipSuccess) fprintf(stderr, "cooperative launch failed: %s (grid %d)\n", hipGetErrorString(e), grid);
#endif
}
```

```cpp
#include <hip/hip_runtime.h>
#include <hip/hip_cooperative_groups.h>
#include <cstdio>
#include <cstdint>
namespace cg = cooperative_groups;
#ifndef MK_LAUNCH_PER_PHASE
#define MK_LAUNCH_PER_PHASE 0
#endif
namespace pg8 {
#define PG8_LAS __attribute__((address_space(3)))
typedef unsigned short bf16_t;
typedef short bf16x8 __attribute__((ext_vector_type(8)));
typedef float f32x4 __attribute__((ext_vector_type(4)));
typedef unsigned u32x4 __attribute__((ext_vector_type(4)));
constexpr int BM = 256, BK = 64, HALF = 128, HTB = HALF * BK * 2  , STAGE_BYTES = 8 * HTB, NXCD = 8, WGM = 8;

__host__ __device__ __forceinline__ int lds_byte(int r, int c) { const int st = (r >> 4) * 2 + (c >> 5), rr = r & 15, cc = c & 31, ob = rr * 64 + cc * 2; return st * 1024 + (ob ^ (((ob >> 9) & 1) << 5)); }
__host__ __device__ __forceinline__ void stage_rc(int b, int& R, int& C) { const int st = b / 1024, sb = b % 1024, swz = sb ^ (((sb >> 9) & 1) << 5); R = (st >> 1) * 16 + swz / 64; C = (st & 1) * 32 + (swz % 64) / 2; }
__host__ __device__ __forceinline__ int perm32(int rho) { const int n = rho >> 4, i = rho & 15; return 8 * (i >> 2) + 4 * n + (i & 3); }

struct Unit { int pm, pn; };
struct Gemm { const bf16_t* A; const bf16_t* Bt; int M, N, K; };

struct StaticOrder {
    int nM, nN, nwg, G, c;
    __host__ __device__ void init(int M, int N, int G_, int c_) { nM = M / BM; nN = N / BM; nwg = nM * nN; G = G_; c = c_; }
    __host__ __device__ bool next(int i, Unit& u) const {
        const long L = (long)i * G + c; if (L >= nwg) return false;
        int wgid = (int)L; { const int q = nwg / NXCD, r = nwg % NXCD, xcd = wgid % NXCD, off = wgid / NXCD; wgid = (xcd < r ? xcd * (q + 1) : r * (q + 1) + (xcd - r) * q) + off; }
        const int nig = WGM * nN, gid = wgid / nig, fm = gid * WGM, gsz = (nM - fm) < WGM ? (nM - fm) : WGM;
        u.pm = fm + ((wgid % nig) % gsz); u.pn = (wgid % nig) / gsz; return true;
    }
    __device__ __forceinline__ void a_ready(const Unit&) const {}
    __device__ __forceinline__ void done(const Unit&) const {}
};

__device__ __forceinline__ unsigned cvt_pk_bf16(float lo, float hi) { unsigned r; asm volatile("v_cvt_pk_bf16_f32 %0, %1, %2" : "=v"(r) : "v"(lo), "v"(hi)); return r; }
typedef float f32x2 __attribute__((ext_vector_type(2)));
template <int ACT> struct EpiBf16 {
    static constexpr bool PERM = true, AFTER_DRAIN = false;
    bf16_t* O; int ldc;
    __device__ __forceinline__ void operator()(const f32x4 (&acc)[2][2][4][2], const Unit& u, int wr, int wc, int fr, int fq) const {
        const int row0 = u.pm * BM + wr * 64 + fr; const int col0 = u.pn * BM + wc * 32 + 8 * fq;
#pragma unroll
        for (int ai = 0; ai < 2; ++ai)
#pragma unroll
            for (int m = 0; m < 4; ++m) { bf16_t* rowp = O + (size_t)(row0 + ai * HALF + m * 16) * ldc + col0;
#pragma unroll
                for (int bj = 0; bj < 2; ++bj) { f32x4 v0 = acc[ai][bj][m][0], v1 = acc[ai][bj][m][1];
                    if (ACT == 2) {
#pragma unroll
                        for (int j = 0; j < 4; ++j) { float a = v0[j] > 0.f ? v0[j] : 0.f; v0[j] = a * a; float b = v1[j] > 0.f ? v1[j] : 0.f; v1[j] = b * b; } }
                    u32x4 w; w.x = cvt_pk_bf16(v0[0], v0[1]); w.y = cvt_pk_bf16(v0[2], v0[3]); w.z = cvt_pk_bf16(v1[0], v1[1]); w.w = cvt_pk_bf16(v1[2], v1[3]);
                    *(u32x4*)(rowp + bj * HALF) = w; } }
    }
};
struct EpiRes {
    static constexpr bool PERM = false, AFTER_DRAIN = false;
    float* X; int ldc; float sgn; const float* R;
    __device__ __forceinline__ void operator()(const f32x4 (&acc)[2][2][4][2], const Unit& u, int wr, int wc, int fr, int fq) const {
        const int col0 = u.pn * BM + wc * 32 + 4 * fq;
#pragma unroll
        for (int ai = 0; ai < 2; ++ai) {
            float* base = X + (size_t)(u.pm * BM + ai * HALF + wr * 64 + fr) * ldc + col0; const float* rbase = R + (size_t)(u.pm * BM + ai * HALF + wr * 64 + fr) * ldc + col0;
            f32x4 r[4][2][2];
#pragma unroll
            for (int m = 0; m < 4; ++m)
#pragma unroll
                for (int bj = 0; bj < 2; ++bj)
#pragma unroll
                    for (int n = 0; n < 2; ++n) r[m][bj][n] = *(const f32x4*)(rbase + (size_t)(m * 16) * ldc + bj * HALF + n * 16);
            asm volatile("" ::: "memory");
#pragma unroll
            for (int m = 0; m < 4; ++m)
#pragma unroll
                for (int bj = 0; bj < 2; ++bj)
#pragma unroll
                    for (int n = 0; n < 2; ++n) *(f32x4*)(base + (size_t)(m * 16) * ldc + bj * HALF + n * 16) = r[m][bj][n] + acc[ai][bj][m][n] * sgn;
            asm volatile("" ::: "memory");
        }
    }
};
template <class Epi, class Sched, bool ALIGN_EPI = false, bool SP2 = false>
__device__ __forceinline__ void gemm_phase(PG8_LAS unsigned char* lds, const Gemm g, const Sched& S, const Epi& E) {
    int tid = threadIdx.x; asm volatile("" : "+v"(tid)); const int wid = __builtin_amdgcn_readfirstlane(tid >> 6), lane = tid & 63, wr = wid >> 2, wc = wid & 3, fr = lane & 15, fq = lane >> 4;
    const int K = g.K, nt = K / BK;
    unsigned voffA[2], voffB[2];
#pragma unroll
    for (int i = 0; i < 2; ++i) { int R, C; stage_rc(tid * 16 + i * 8192, R, C); const int Rb = Epi::PERM ? ((R & ~31) + perm32(R & 31)) : R;
        voffA[i] = (unsigned)(R * K + C) * 2u; voffB[i] = (unsigned)(Rb * K + C) * 2u; }
    const size_t kstep = (size_t)(BK * 2);
    const size_t hstep = (size_t)HALF * K * 2;
    const size_t tstep = 2 * hstep;
    const unsigned ldsw = (unsigned)wid * 1024u;
    const int aoff = lds_byte(wr * 64 + fr, fq * 8), boff = lds_byte(wc * 32 + fr, fq * 8);
#define PG8_SA(b, h) (((b) * 2 + (h)) * HTB)
#define PG8_SB(b, h) ((4 + (b) * 2 + (h)) * HTB)
#define PG8_STAGE(bufoff, gbase, voff) do { _Pragma("unroll") for (int _i = 0; _i < 2; ++_i) \
        __builtin_amdgcn_global_load_lds((const unsigned*)((const char*)(gbase) + (voff)[_i]), (PG8_LAS unsigned*)(lds + (bufoff) + ldsw + _i * 8192), 16, 0, 0); } while (0)
#define PG8_LDA(dst, b, h) do { _Pragma("unroll") for (int m = 0; m < 4; ++m) _Pragma("unroll") for (int k = 0; k < 2; ++k) dst[m][k] = *(const PG8_LAS bf16x8*)(lds + PG8_SA(b, h) + aoff + m * 2048 + k * 1024); } while (0)
#define PG8_LDB(dst, b, h) do { _Pragma("unroll") for (int n = 0; n < 2; ++n) _Pragma("unroll") for (int k = 0; k < 2; ++k) dst[n][k] = *(const PG8_LAS bf16x8*)(lds + PG8_SB(b, h) + boff + n * 2048 + k * 1024); } while (0)
#define PG8_MMA(ai, bj, At, Bt) do { __builtin_amdgcn_s_setprio(1); _Pragma("unroll") for (int m = 0; m < 4; ++m) _Pragma("unroll") for (int n = 0; n < 2; ++n) _Pragma("unroll") for (int k = 0; k < 2; ++k) \
        acc[ai][bj][m][n] = __builtin_amdgcn_mfma_f32_16x16x32_bf16(Bt[n][k], At[m][k], acc[ai][bj][m][n], 0, 0, 0); __builtin_amdgcn_s_setprio(0); } while (0)
#define PG8_WAIT_V(n) asm volatile("s_waitcnt vmcnt(" #n ")" ::: "memory")
#define PG8_WAIT_L(n) asm volatile("s_waitcnt lgkmcnt(" #n ")" ::: "memory")
#define PG8_BAR __builtin_amdgcn_s_barrier()
#define PG8_SCHED __builtin_amdgcn_sched_barrier(0)
    Unit cur, nxt; int ui = 0;
    if (!S.next(0, cur)) return;
    f32x4 acc[2][2][4][2];
#pragma unroll
    for (int a = 0; a < 2; ++a)
#pragma unroll
        for (int b = 0; b < 2; ++b)
#pragma unroll
            for (int m = 0; m < 4; ++m)
#pragma unroll
                for (int n = 0; n < 2; ++n) acc[a][b][m][n] = (f32x4){0.f, 0.f, 0.f, 0.f};
    bf16x8 At[4][2], B0[2][2], B1[2][2];
    const char* cA = (const char*)g.A + (size_t)cur.pm * tstep; const char* cB = (const char*)g.Bt + (size_t)cur.pn * tstep;
    S.a_ready(cur);
    if constexpr (SP2) {
        PG8_STAGE(PG8_SB(0, 0), cB, voffB); PG8_STAGE(PG8_SB(0, 1), cB + hstep, voffB); PG8_STAGE(PG8_SA(0, 0), cA, voffA); PG8_STAGE(PG8_SA(0, 1), cA + hstep, voffA);
        if (wr == 1) PG8_BAR;
        PG8_WAIT_V(2); PG8_BAR;
        PG8_STAGE(PG8_SB(1, 0), cB + kstep, voffB); PG8_STAGE(PG8_SA(1, 0), cA + kstep, voffA); PG8_STAGE(PG8_SB(1, 1), cB + hstep + kstep, voffB);
        PG8_WAIT_V(6); PG8_BAR;
    } else {
        PG8_STAGE(PG8_SB(0, 0), cB, voffB); PG8_STAGE(PG8_SA(0, 0), cA, voffA); PG8_STAGE(PG8_SB(0, 1), cB + hstep, voffB); PG8_STAGE(PG8_SA(0, 1), cA + hstep, voffA);
        if (wr == 1) PG8_BAR;
        PG8_WAIT_V(4); PG8_BAR;
        PG8_STAGE(PG8_SB(1, 0), cB + kstep, voffB); PG8_STAGE(PG8_SA(1, 0), cA + kstep, voffA); PG8_STAGE(PG8_SB(1, 1), cB + hstep + kstep, voffB);
        PG8_WAIT_V(6); PG8_BAR;
    }
    for (;;) {
        const bool has_next = S.next(ui + 1, nxt);
        const char* nA = has_next ? (const char*)g.A + (size_t)nxt.pm * tstep : cA; const char* nB = has_next ? (const char*)g.Bt + (size_t)nxt.pn * tstep : cB;
        for (int t = 0; t < nt; t += 2) {
            const bool last = (t == nt - 2);
            const char* a1 = cA + (size_t)(t + 1) * kstep;
            const char* a2 = last ? nA : cA + (size_t)(t + 2) * kstep; const char* b2 = last ? nB : cB + (size_t)(t + 2) * kstep;
            const char* a3 = a2 + kstep; const char* b3 = b2 + kstep;
            if (last && has_next) S.a_ready(nxt);
            if constexpr (SP2) {
            PG8_LDB(B0, 0, 0); PG8_LDB(B1, 0, 1); PG8_SCHED; PG8_LDA(At, 0, 0); PG8_STAGE(PG8_SA(1, 1), a1 + hstep, voffA);
            PG8_WAIT_V(8); PG8_WAIT_L(0); PG8_BAR; PG8_MMA(0, 0, At, B0); PG8_MMA(0, 1, At, B1); PG8_BAR; PG8_SCHED;
            PG8_LDA(At, 0, 1); PG8_STAGE(PG8_SB(0, 0), b2, voffB); PG8_STAGE(PG8_SB(0, 1), b2 + hstep, voffB); PG8_STAGE(PG8_SA(0, 0), a2, voffA);
            PG8_WAIT_V(8); PG8_WAIT_L(0); PG8_BAR; PG8_MMA(1, 0, At, B0); PG8_MMA(1, 1, At, B1); PG8_BAR; PG8_SCHED;
            PG8_LDB(B0, 1, 0); PG8_LDB(B1, 1, 1); PG8_SCHED; PG8_LDA(At, 1, 0); PG8_STAGE(PG8_SA(0, 1), a2 + hstep, voffA);
            PG8_WAIT_V(8); PG8_WAIT_L(0); PG8_BAR; PG8_MMA(0, 0, At, B0); PG8_MMA(0, 1, At, B1); PG8_BAR; PG8_SCHED;
            PG8_LDA(At, 1, 1); PG8_STAGE(PG8_SB(1, 0), b3, voffB); PG8_STAGE(PG8_SB(1, 1), b3 + hstep, voffB); PG8_STAGE(PG8_SA(1, 0), a3, voffA);
            PG8_WAIT_V(8); PG8_WAIT_L(0); PG8_BAR; PG8_MMA(1, 0, At, B0); PG8_MMA(1, 1, At, B1); PG8_BAR; PG8_SCHED;
            } else {
            PG8_LDB(B0, 0, 0); PG8_SCHED; PG8_LDA(At, 0, 0); PG8_STAGE(PG8_SA(1, 1), a1 + hstep, voffA);
            PG8_WAIT_L(8); PG8_BAR; PG8_WAIT_L(0); PG8_MMA(0, 0, At, B0); PG8_BAR; PG8_SCHED;
            PG8_LDB(B1, 0, 1); PG8_STAGE(PG8_SB(0, 0), b2, voffB);
            PG8_BAR; PG8_WAIT_L(0); PG8_MMA(0, 1, At, B1); PG8_BAR;
            PG8_LDA(At, 0, 1); PG8_STAGE(PG8_SA(0, 0), a2, voffA);
            PG8_BAR; PG8_WAIT_L(0); PG8_MMA(1, 0, At, B0); PG8_BAR; PG8_SCHED;
            PG8_STAGE(PG8_SB(0, 1), b2 + hstep, voffB);
            PG8_WAIT_V(6); PG8_BAR; PG8_MMA(1, 1, At, B1); PG8_BAR;
            PG8_LDB(B0, 1, 0); PG8_SCHED; PG8_LDA(At, 1, 0); PG8_STAGE(PG8_SA(0, 1), a2 + hstep, voffA);
            PG8_WAIT_L(8); PG8_BAR; PG8_WAIT_L(0); PG8_MMA(0, 0, At, B0); PG8_BAR; PG8_SCHED;
            PG8_LDB(B1, 1, 1); PG8_STAGE(PG8_SB(1, 0), b3, voffB);
            PG8_BAR; PG8_WAIT_L(0); PG8_MMA(0, 1, At, B1); PG8_BAR;
            PG8_LDA(At, 1, 1); PG8_STAGE(PG8_SA(1, 0), a3, voffA);
            PG8_BAR; PG8_WAIT_L(0); PG8_MMA(1, 0, At, B0); PG8_BAR; PG8_SCHED;
            PG8_STAGE(PG8_SB(1, 1), b3 + hstep, voffB);
            PG8_WAIT_V(6); PG8_BAR; PG8_MMA(1, 1, At, B1); PG8_BAR;
            }
        }
        if constexpr (ALIGN_EPI) { if (wr == 0) PG8_BAR; }
        if constexpr (!Epi::AFTER_DRAIN) { E(acc, cur, wr, wc, fr, fq); S.done(cur); }
        if (!has_next) break;
#pragma unroll
        for (int a = 0; a < 2; ++a)
#pragma unroll
            for (int b = 0; b < 2; ++b)
#pragma unroll
                for (int m = 0; m < 4; ++m)
#pragma unroll
                    for (int n = 0; n < 2; ++n) acc[a][b][m][n] = (f32x4){0.f, 0.f, 0.f, 0.f};
        cur = nxt; cA = nA; cB = nB; ++ui;
        if constexpr (ALIGN_EPI) { if (wr == 1) PG8_BAR; }
    }
    PG8_WAIT_V(0);
    if constexpr (!ALIGN_EPI) { if (wr == 0) PG8_BAR; }
    PG8_BAR;
    if constexpr (Epi::AFTER_DRAIN) { E.fused(acc, cur, wr, wc, fr, fq, lds, wid, lane); S.done(cur); }
#undef PG8_SA
#undef PG8_SB
#undef PG8_STAGE
#undef PG8_LDA
#undef PG8_LDB
#undef PG8_MMA
#undef PG8_WAIT_V
#undef PG8_WAIT_L
#undef PG8_BAR
#undef PG8_SCHED
}
}
typedef unsigned short bf16;
typedef short bf16x8 __attribute__((ext_vector_type(8)));
typedef float f32x4 __attribute__((ext_vector_type(4)));
typedef float f32x2v __attribute__((ext_vector_type(2)));
typedef unsigned u32x4 __attribute__((ext_vector_type(4)));
typedef unsigned u32x2 __attribute__((ext_vector_type(2)));

constexpr int DM = 1024, SEQ = 8192, MPR = 16384, MSA = 128, MREAL = 16512, MPAD = 16640, FF = 4096;
constexpr int NPE = 3072, NPO = 3328, NE_IN = 2824, NO_IN = 3088;
constexpr float EPS = 1e-6f;
constexpr size_t MiB = 1u << 20;
constexpr size_t WS_WEI = 1 * MiB;
constexpr size_t WS_WEO = WS_WEI + 12 * MiB;
constexpr size_t WS_WGI = WS_WEO + 4 * MiB;
constexpr size_t WS_WGO = WS_WGI + 13 * MiB;
constexpr size_t WS_WUP = WS_WGO + 4 * MiB;
constexpr size_t WS_WDN = WS_WUP + 32 * MiB;
constexpr size_t WS_X   = WS_WDN + 32 * MiB;
constexpr size_t WS_HB  = WS_X + 65 * MiB;
constexpr size_t WS_MIX = WS_HB + 33 * MiB;
constexpr size_t WS_BIG = WS_MIX + 33 * MiB;
constexpr size_t WS_SCR = WS_BIG + 106 * MiB;
constexpr size_t SC_DN_W = WS_SCR, SC_DN_QE = SC_DN_W + 16 * MiB, SC_DN_KT = SC_DN_QE + 16 * MiB, SC_DN_AT = SC_DN_KT + 16 * MiB,
                 SC_DN_U = SC_DN_AT + 8 * MiB, SC_DN_EGL = SC_DN_U + 16 * MiB, SC_DN_O = SC_DN_EGL + 1 * MiB;
constexpr size_t SC_GL_US = WS_SCR, SC_GL_QT = SC_GL_US + 64 * MiB, SC_GL_OI = SC_GL_QT + 16 * MiB, SC_GL_EGL = SC_GL_OI + 32 * MiB;
constexpr size_t SC_DN_VN = SC_DN_O + 32 * MiB;
constexpr size_t WS_END = WS_SCR + 122 * MiB;
constexpr size_t O_Y = 0, O_PDN = 16908288, O_PCONV = 17170432, O_PK = 17188864, O_PV = 17254400, O_PGLA = 17319936,
                 O_SDN = 17844224, O_SCONV = 34621440, O_SK = 35801088, O_SV = 39995392, O_SGLA = 44189696;
constexpr int LDS_BYTES = 147456;
constexpr int NPH = 37;

struct Args { const float* in[24]; float* out; unsigned char* ws; int ph_lo, ph_hi; };

typedef __bf16 bf16x2_t __attribute__((ext_vector_type(2)));
__device__ __forceinline__ unsigned pk2(float lo, float hi) { bf16x2_t v; v.x = (__bf16)lo; v.y = (__bf16)hi; return __builtin_bit_cast(unsigned, v); }
__device__ __forceinline__ unsigned f2bf(float f) { return pk2(f, 0.f) & 0xffffu; }
__device__ __forceinline__ float bf2f(unsigned h) { return __uint_as_float(h << 16); }

__device__ __forceinline__ float bflo(unsigned u) { return __uint_as_float(u << 16); }
__device__ __forceinline__ float bfhi(unsigned u) { return __uint_as_float(u & 0xffff0000u); }
__device__ __forceinline__ f32x4 mfma16(bf16x8 a, bf16x8 b, f32x4 c) { return __builtin_amdgcn_mfma_f32_16x16x32_bf16(a, b, c, 0, 0, 0); }
__device__ __forceinline__ float opq(float x) { asm volatile("" : "+v"(x)); return x; }
__device__ __forceinline__ float siluf(float x) { return x * __builtin_amdgcn_rcpf(1.f + __expf(-x)); }
#define DPPF(v, ctrl) __int_as_float(__builtin_amdgcn_update_dpp(0, __float_as_int(v), ctrl, 0xf, 0xf, false))
__device__ __forceinline__ float sum16(float v) { v += DPPF(v, 0xB1); v += DPPF(v, 0x4E); v += DPPF(v, 0x141); v += DPPF(v, 0x140); return v; }
__device__ __forceinline__ float max16(float v) { v = fmaxf(v, DPPF(v, 0xB1)); v = fmaxf(v, DPPF(v, 0x4E)); v = fmaxf(v, DPPF(v, 0x141)); v = fmaxf(v, DPPF(v, 0x140)); return v; }
__device__ __forceinline__ float wave_sum(float v) { v = sum16(v); v += __shfl_xor(v, 16); v += __shfl_xor(v, 32); return v; }
__device__ __forceinline__ float wave_max(float v) { v = max16(v); v = fmaxf(v, __shfl_xor(v, 16)); v = fmaxf(v, __shfl_xor(v, 32)); return v; }
#define LDSWAIT() asm volatile("s_waitcnt lgkmcnt(0)" ::: "memory")
#define BAR_LDS() do { asm volatile("s_waitcnt lgkmcnt(0)" ::: "memory"); __builtin_amdgcn_s_barrier(); asm volatile("" ::: "memory"); } while (0)
__device__ __forceinline__ void unpack8(u32x4 w, float (&f)[8]) { f[0] = bflo(w.x); f[1] = bfhi(w.x); f[2] = bflo(w.y); f[3] = bfhi(w.y); f[4] = bflo(w.z); f[5] = bfhi(w.z); f[6] = bflo(w.w); f[7] = bfhi(w.w); }
__device__ __forceinline__ u32x4 pack8(const float (&f)[8]) { u32x4 w; w.x = pk2(f[0], f[1]); w.y = pk2(f[2], f[3]); w.z = pk2(f[4], f[5]); w.w = pk2(f[6], f[7]); return w; }

__device__ __forceinline__ void transpose_w(const float* __restrict__ W, int K, int N, int Npad, bf16* __restrict__ WT, float* scr, int gw, int ngw, int lane) {
    const int nblk = Npad / 64, nitems = (K / 64) * nblk;
    for (int it = gw; it < nitems; it += ngw) {
        const int kb = it / nblk, nb = it % nblk, k0 = 64 * kb, n0 = 64 * nb;
        const int n = n0 + lane;
        float v[64];
#pragma unroll
        for (int kk = 0; kk < 64; ++kk) v[kk] = (n < N) ? W[(size_t)(k0 + kk) * N + n] : 0.f;
#pragma unroll
        for (int kk = 0; kk < 64; ++kk) scr[kk * 65 + lane] = v[kk];
        LDSWAIT();
        const int c = lane & 7;
#pragma unroll
        for (int j = 0; j < 8; ++j) { const int nl = (lane >> 3) + 8 * j; const float* s = scr + (8 * c) * 65 + nl;
            u32x4 o; o.x = pk2(s[0 * 65], s[1 * 65]); o.y = pk2(s[2 * 65], s[3 * 65]); o.z = pk2(s[4 * 65], s[5 * 65]); o.w = pk2(s[6 * 65], s[7 * 65]);
            *(u32x4*)(WT + (size_t)(n0 + nl) * K + k0 + 8 * c) = o; }
        LDSWAIT();
    }
}
__device__ __forceinline__ void norm_row(const f32x4 (&v)[4], const float* g, bf16* hrow, float* yrow, int lane) {
    float s = 0.f;
#pragma unroll
    for (int j = 0; j < 4; ++j) s += (v[j].x * v[j].x + v[j].y * v[j].y) + (v[j].z * v[j].z + v[j].w * v[j].w);
    const float rstd = rsqrtf(wave_sum(s) * (1.f / DM) + EPS);
#pragma unroll
    for (int j = 0; j < 4; ++j) { const f32x4 gg = *(const f32x4*)(g + 4 * lane + 256 * j); const f32x4 o = v[j] * rstd * gg;
        if (hrow) { u32x2 w; w.x = pk2(o.x, o.y); w.y = pk2(o.z, o.w); *(u32x2*)(hrow + 4 * lane + 256 * j) = w; }
        else *(f32x4*)(yrow + 4 * lane + 256 * j) = o; }
}
__device__ __forceinline__ void norm_phase(const float* __restrict__ X, const float* g, bf16* __restrict__ HB, float* __restrict__ Y, int gw, int ngw, int lane) {
    for (int m0 = gw; m0 < MREAL; m0 += 4 * ngw) {
        f32x4 v[4][4];
#pragma unroll
        for (int r = 0; r < 4; ++r) { const int m = m0 + r * ngw; const int mm = m < MREAL ? m : m0;
#pragma unroll
            for (int j = 0; j < 4; ++j) v[r][j] = *(const f32x4*)(X + (size_t)mm * DM + 4 * lane + 256 * j); }
#pragma unroll
        for (int r = 0; r < 4; ++r) { const int m = m0 + r * ngw;
            if (m < MREAL) norm_row(v[r], g, HB ? HB + (size_t)m * DM : nullptr, Y ? Y + (size_t)m * DM : nullptr, lane); }
    }
}

__device__ __forceinline__ void dn_stepA(int tid, int unit, unsigned char* lds, const bf16* PROJ, const float* conv_w, const float* a_log, const float* dt_bias,
                                         bf16* W_, bf16* QE_, bf16* KT_, bf16* AT_, bf16* U_, float* EGL_) {
    asm volatile("" : "+v"(tid));
    const int lane = tid & 63, wave = tid >> 6, m16 = lane & 15, q4 = lane >> 4;
    const int h = unit & 3, c = (unit >> 2) & 127, b = unit >> 9;
    const int t0 = c * 64; const size_t rowb = (size_t)b * SEQ;
    const size_t ch = (size_t)unit;
    bf16* qs = (bf16*)(lds); bf16* ks = (bf16*)(lds + 17408); bf16* kbs = (bf16*)(lds + 34816);
    bf16* vbT = (bf16*)(lds + 52224); bf16* kbgT = (bf16*)(lds + 70656);
    float* Ms = (float*)(lds + 89088); bf16* Tb = (bf16*)(lds + 105728);
    float* Gs = (float*)(lds + 114944); float* Bs = Gs + 64;
    if (wave == 0) {
        const bf16* pr = PROJ + (rowb + t0 + lane) * NPE;
        const float a = bf2f(pr[2048 + h]), bb = bf2f(pr[2052 + h]);
        const float x = a + dt_bias[h];
        const float sp = x > 20.f ? x : __logf(1.f + __expf(x));
        const float g = -__expf(a_log[h]) * sp;
        float G = g;
#pragma unroll
        for (int o = 1; o < 64; o <<= 1) { const float v = __shfl_up(G, o); if (lane >= o) G += v; }
        Gs[lane] = G; Bs[lane] = __builtin_amdgcn_rcpf(1.f + __expf(-bb));
    }
    __syncthreads();
#pragma unroll 1
    for (int bt = 0; bt < 2; ++bt) {
        u32x4 raw[3][4];
#pragma unroll
        for (int ii = 0; ii < 3; ++ii) {
            const int item = (bt * 3 + ii) * 512 + tid, part = item >> 10, t = (item >> 4) & 63, cg = item & 15;
            const int chn = part * 512 + h * 128 + cg * 8;
#pragma unroll
            for (int tap = 0; tap < 4; ++tap) { const int tt = t0 + t - 3 + tap;
                raw[ii][tap] = tt >= 0 ? *(const u32x4*)(PROJ + (rowb + tt) * NPE + chn) : (u32x4){0u, 0u, 0u, 0u}; }
        }
#pragma unroll
        for (int ii = 0; ii < 3; ++ii) {
            const int item = (bt * 3 + ii) * 512 + tid, part = item >> 10, t = (item >> 4) & 63, cg = item & 15;
            const int chn = part * 512 + h * 128 + cg * 8;
            float acc[8];
#pragma unroll
            for (int j = 0; j < 8; ++j) acc[j] = 0.f;
#pragma unroll
            for (int tap = 0; tap < 4; ++tap) {
                float f[8]; unpack8(raw[ii][tap], f);
                const f32x4 c0 = *(const f32x4*)(conv_w + tap * 1536 + chn), c1 = *(const f32x4*)(conv_w + tap * 1536 + chn + 4);
                acc[0] += f[0] * c0.x; acc[1] += f[1] * c0.y; acc[2] += f[2] * c0.z; acc[3] += f[3] * c0.w;
                acc[4] += f[4] * c1.x; acc[5] += f[5] * c1.y; acc[6] += f[6] * c1.z; acc[7] += f[7] * c1.w;
            }
            float ss = 0.f;
#pragma unroll
            for (int j = 0; j < 8; ++j) { acc[j] = siluf(acc[j]); ss += acc[j] * acc[j]; }
            ss = sum16(ss);
            const float rstd = rsqrtf(ss + EPS);
            const float Gt = Gs[t], bt_ = Bs[t];
            if (part == 0) {
                float o[8], oe[8]; const float sc = rstd * 0.08838834764831845f, eg = __expf(Gt);
#pragma unroll
                for (int j = 0; j < 8; ++j) { o[j] = acc[j] * sc; oe[j] = o[j] * eg; }
                *(u32x4*)(qs + t * 136 + cg * 8) = pack8(o);
                *(u32x4*)(QE_ + ch * 8192 + t * 128 + cg * 8) = pack8(oe);
            } else if (part == 1) {
                float o[8], ob[8]; const float eg = __expf(Gt) * bt_;
#pragma unroll
                for (int j = 0; j < 8; ++j) { o[j] = acc[j] * rstd; ob[j] = o[j] * bt_; }
                *(u32x4*)(ks + t * 136 + cg * 8) = pack8(o);
                *(u32x4*)(kbs + t * 136 + cg * 8) = pack8(ob);
#pragma unroll
                for (int j = 0; j < 8; ++j) kbgT[(cg * 8 + j) * 72 + (((t >> 3) ^ (cg & 7)) << 3) + (t & 7)] = (bf16)f2bf(o[j] * eg);
            } else {
#pragma unroll
                for (int j = 0; j < 8; ++j) vbT[(cg * 8 + j) * 72 + (((t >> 3) ^ (cg & 7)) << 3) + (t & 7)] = (bf16)f2bf(acc[j] * bt_);
            }
        }
    }
    __syncthreads();
    {
        const int d = tid >> 2, tg = tid & 3; const float gl = Gs[63];
#pragma unroll
        for (int half = 0; half < 2; ++half) {
            float o[8];
#pragma unroll
            for (int j = 0; j < 8; ++j) { const int t = tg * 16 + half * 8 + j; o[j] = bf2f(ks[t * 136 + d]) * __expf(gl - Gs[t]); }
            *(u32x4*)(KT_ + ch * 8192 + d * 64 + tg * 16 + half * 8) = pack8(o);
        }
        if (tid == 0) EGL_[ch] = __expf(gl);
    }
    {
        const int which = wave >> 2, mt = wave & 3;
        const bf16* As = which ? kbs : qs;
        bf16x8 aF[4];
#pragma unroll
        for (int k4 = 0; k4 < 4; ++k4) aF[k4] = *(const bf16x8*)(As + (mt * 16 + m16) * 136 + k4 * 32 + q4 * 8);
#pragma unroll
        for (int nt = 0; nt < 4; ++nt) {
            f32x4 acc = {0.f, 0.f, 0.f, 0.f};
            if (nt <= mt) {
#pragma unroll
                for (int k4 = 0; k4 < 4; ++k4) { const bf16x8 bF = *(const bf16x8*)(ks + (nt * 16 + m16) * 136 + k4 * 32 + q4 * 8); acc = mfma16(aF[k4], bF, acc); }
            }
            const int s = nt * 16 + m16; const float Gsv = Gs[s];
#pragma unroll
            for (int i = 0; i < 4; ++i) {
                const int t = mt * 16 + q4 * 4 + i;
                const bool on = which ? (t > s) : (t >= s);
                const float v = on ? acc[i] * __expf(Gs[t] - Gsv) : 0.f;
                if (which) Ms[t * 65 + s] = v; else AT_[ch * 4096 + t * 64 + s] = (bf16)f2bf(v);
            }
        }
    }
    __syncthreads();
    {
        float* Ts = (float*)(lds + 115456);
        if (wave == 0) {
            const int blk = lane >> 4, cc = lane & 15; const float* Mb = Ms + (blk * 16) * 65 + blk * 16;
            float tc[16];
#pragma unroll
            for (int r = 0; r < 16; ++r) {
                float acc = (r == cc) ? 1.f : 0.f;
#pragma unroll
                for (int j = 0; j < r; ++j) acc -= Mb[r * 65 + j] * tc[j];
                tc[r] = acc;
            }
#pragma unroll
            for (int r = 0; r < 16; ++r) Ts[(blk * 16 + r) * 65 + blk * 16 + cc] = tc[r];
        }
        __syncthreads();
#pragma unroll 1
        for (int dd = 1; dd < 4; ++dd) {
            if (wave < 4 - dd) {
                const int j = wave, i = wave + dd;
                f32x4 acc = {0.f, 0.f, 0.f, 0.f};
                for (int k = j; k < i; ++k) {
                    const float* A = Ms + (i * 16) * 65 + k * 16; const float* B = Ts + (k * 16) * 65 + j * 16;
#pragma unroll
                    for (int kk = 0; kk < 4; ++kk) acc = __builtin_amdgcn_mfma_f32_16x16x4f32(A[m16 * 65 + kk * 4 + q4], B[(kk * 4 + q4) * 65 + m16], acc, 0, 0, 0);
                }
                float* Tmp = Ts + (j * 16) * 65 + i * 16;
#pragma unroll
                for (int r = 0; r < 4; ++r) Tmp[(q4 * 4 + r) * 65 + m16] = acc[r];
                LDSWAIT();
                f32x4 acc2 = {0.f, 0.f, 0.f, 0.f};
                { const float* A = Ts + (i * 16) * 65 + i * 16;
#pragma unroll
                  for (int kk = 0; kk < 4; ++kk) acc2 = __builtin_amdgcn_mfma_f32_16x16x4f32(A[m16 * 65 + kk * 4 + q4], Tmp[(kk * 4 + q4) * 65 + m16], acc2, 0, 0, 0); }
                float* Out = Ts + (i * 16) * 65 + j * 16;
#pragma unroll
                for (int r = 0; r < 4; ++r) Out[(q4 * 4 + r) * 65 + m16] = -acc2[r];
            }
            __syncthreads();
        }
        const int t = tid >> 3, s8 = (tid & 7) * 8; float o[8];
#pragma unroll
        for (int j = 0; j < 8; ++j) o[j] = (s8 + j <= t) ? Ts[t * 65 + s8 + j] : 0.f;
        *(u32x4*)(Tb + t * 72 + s8) = pack8(o);
    }
    __syncthreads();
    {
        const bf16* BT = wave < 4 ? vbT : kbgT; bf16* OUT = wave < 4 ? U_ : W_;
        bf16x8 bF[2][2];
#pragma unroll
        for (int n2 = 0; n2 < 2; ++n2)
#pragma unroll
            for (int k2 = 0; k2 < 2; ++k2) { const int rr = ((wave & 3) * 2 + n2) * 16 + m16; bF[n2][k2] = *(const bf16x8*)(BT + rr * 72 + (((k2 * 4 + q4) ^ ((rr >> 3) & 7)) << 3)); }
#pragma unroll
        for (int mt = 0; mt < 4; ++mt) {
            bf16x8 aF[2];
#pragma unroll
            for (int k2 = 0; k2 < 2; ++k2) aF[k2] = *(const bf16x8*)(Tb + (mt * 16 + m16) * 72 + k2 * 32 + q4 * 8);
#pragma unroll
            for (int n2 = 0; n2 < 2; ++n2) {
                f32x4 acc = {0.f, 0.f, 0.f, 0.f};
                u32x2 w;
                if (wave < 4) {
                    acc = mfma16(aF[0], bF[n2][0], acc); acc = mfma16(aF[1], bF[n2][1], acc);
                    w.x = pk2(acc[0], acc[1]); w.y = pk2(acc[2], acc[3]);
                    *(u32x2*)(OUT + ch * 8192 + (((wave & 3) * 2 + n2) * 16 + m16) * 64 + mt * 16 + q4 * 4) = w;
                } else {
                    acc = mfma16(bF[n2][0], aF[0], acc); acc = mfma16(bF[n2][1], aF[1], acc);
                    w.x = pk2(acc[0], acc[1]); w.y = pk2(acc[2], acc[3]);
                    *(u32x2*)(OUT + ch * 8192 + (mt * 16 + m16) * 128 + ((wave & 3) * 2 + n2) * 16 + q4 * 4) = w;
                }
            }
        }
    }
    __syncthreads();
}

__device__ __forceinline__ void dn_stepB(int tid, int item, unsigned char* lds, const bf16* W_, const bf16* KT_, const bf16* U_, const float* EGL_,
                                         bf16* SC_, bf16* VN_, float* state_out) {
    asm volatile("" : "+v"(tid));
    const int lane = tid & 63, wave = tid >> 6, m16 = lane & 15, q4 = lane >> 4;
    const int bh = item & 7, sl = item >> 3, b = bh >> 2, h = bh & 3, e0 = sl * 16;
    bf16* Sb = (bf16*)lds;
    bf16* Vn = (bf16*)(lds + 16 * 136 * 2);
    for (int i = tid; i < 16 * 136 / 2; i += 512) ((unsigned*)Sb)[i] = 0u;
    f32x4 accS = {0.f, 0.f, 0.f, 0.f};
    __syncthreads();
    const bool lo = wave < 4;
    int vz = 0; asm volatile("" : "+v"(vz));
    const bf16* xbase = W_ + ((wave & 3) * 16 + m16) * 128 + q4 * 8;
    const bf16* ubase = U_ + (e0 + m16) * 64 + (wave & 3) * 16 + q4 * 4;
    const bf16* kbase = KT_ + (wave * 16 + m16) * 64 + q4 * 8;
    bf16* scbase = SC_ + (e0 + m16) * 128 + wave * 16 + q4 * 4;
    bf16* vnbase = VN_ + (e0 + m16) * 64 + (wave & 3) * 16 + q4 * 4;
#define DNB_LOAD(cc, xA_, kA_, uC_, egl_) do { const int c_ = (cc) < 128 ? (cc) : 127; const size_t ch_ = (size_t)b * 512 + c_ * 4 + h; \
        if (lo) { _Pragma("unroll") for (int k4 = 0; k4 < 4; ++k4) xA_[k4] = *(const bf16x8*)(xbase + ch_ * 8192 + k4 * 32); uC_ = *(const u32x2*)(ubase + ch_ * 8192); } \
        kA_[0] = *(const bf16x8*)(kbase + ch_ * 8192); kA_[1] = *(const bf16x8*)(kbase + ch_ * 8192 + 32); \
        egl_ = EGL_[ch_ + vz]; } while (0)
#define DNB_STEP(cc, xA_, kA_, uC_, egl_) do { const size_t chs_ = (size_t)b * 512 + (cc) * 4 + h; \
        { u32x2 w; w.x = pk2(accS[0], accS[1]); w.y = pk2(accS[2], accS[3]); *(u32x2*)(scbase + chs_ * 16384) = w; }     \
        if (lo) { f32x4 accX = {0.f, 0.f, 0.f, 0.f}; \
            _Pragma("unroll") for (int k4 = 0; k4 < 4; ++k4) { const bf16x8 sB = *(const bf16x8*)(Sb + m16 * 136 + k4 * 32 + q4 * 8); accX = mfma16(xA_[k4], sB, accX); } \
            u32x2 w; w.x = pk2(bflo(uC_.x) - accX[0], bfhi(uC_.x) - accX[1]); w.y = pk2(bflo(uC_.y) - accX[2], bfhi(uC_.y) - accX[3]); \
            *(u32x2*)(Vn + m16 * 72 + wave * 16 + q4 * 4) = w; *(u32x2*)(vnbase + chs_ * 8192) = w; } \
        BAR_LDS(); \
        const bf16x8 vB0 = *(const bf16x8*)(Vn + m16 * 72 + q4 * 8), vB1 = *(const bf16x8*)(Vn + m16 * 72 + 32 + q4 * 8); \
        accS = accS * egl_; \
        accS = mfma16(kA_[0], vB0, accS); accS = mfma16(kA_[1], vB1, accS); \
        { u32x2 w; w.x = pk2(accS[0], accS[1]); w.y = pk2(accS[2], accS[3]); *(u32x2*)(Sb + m16 * 136 + wave * 16 + q4 * 4) = w; } \
        BAR_LDS(); } while (0)
    bf16x8 xA[4], kA[2]; u32x2 uA; float eglA;
    bf16x8 xB[4], kB[2]; u32x2 uB; float eglB;
    bf16x8 xC[4], kC[2]; u32x2 uC; float eglC;
    bf16x8 xD[4], kD[2]; u32x2 uD; float eglD;
    uA = uB = uC = uD = (u32x2){0u, 0u};
#pragma unroll
    for (int k4 = 0; k4 < 4; ++k4) xA[k4] = xB[k4] = xC[k4] = xD[k4] = (bf16x8){0, 0, 0, 0, 0, 0, 0, 0};
    DNB_LOAD(0, xA, kA, uA, eglA); DNB_LOAD(1, xB, kB, uB, eglB); DNB_LOAD(2, xC, kC, uC, eglC);
#pragma unroll 1
    for (int c = 0; c < 128; c += 4) {
        DNB_LOAD(c + 3, xD, kD, uD, eglD);
        DNB_STEP(c, xA, kA, uA, eglA);
        DNB_LOAD(c + 4, xA, kA, uA, eglA);
        DNB_STEP(c + 1, xB, kB, uB, eglB);
        DNB_LOAD(c + 5, xB, kB, uB, eglB);
        DNB_STEP(c + 2, xC, kC, uC, eglC);
        DNB_LOAD(c + 6, xC, kC, uC, eglC);
        DNB_STEP(c + 3, xD, kD, uD, eglD);
    }
#undef DNB_LOAD
#undef DNB_STEP
    {
        float* sp = state_out + ((size_t)(b * 4 + h) * 128 + wave * 16 + q4 * 4) * 128 + e0 + m16;
#pragma unroll
        for (int i = 0; i < 4; ++i) sp[i * 128] = accS[i];
    }
    __syncthreads();
}

__device__ __forceinline__ void dn_stepC(int tid, int unit, unsigned char* lds, const bf16* __restrict__ PROJ, const bf16* __restrict__ QE_, const bf16* __restrict__ AT_, const bf16* __restrict__ SC_, const bf16* __restrict__ VN_,
                                         const float* dn_norm, bf16* __restrict__ MIX) {
    asm volatile("" : "+v"(tid));
    const int lane = tid & 63, wave = tid >> 6, m16 = lane & 15, q4 = lane >> 4;
    const int h = unit & 3, c = (unit >> 2) & 127, b = unit >> 9;
    const size_t row0 = (size_t)b * SEQ + c * 64; const size_t ch = (size_t)unit;
    float* red = (float*)lds;
    bf16x8 scF[4], vnF[2], qeF[4][4], atF[4][2]; u32x2 zg[4];
#pragma unroll
    for (int k4 = 0; k4 < 4; ++k4) scF[k4] = *(const bf16x8*)(SC_ + ch * 16384 + (wave * 16 + m16) * 128 + k4 * 32 + q4 * 8);
#pragma unroll
    for (int k2 = 0; k2 < 2; ++k2) vnF[k2] = *(const bf16x8*)(VN_ + ch * 8192 + (wave * 16 + m16) * 64 + k2 * 32 + q4 * 8);
#pragma unroll
    for (int mt = 0; mt < 4; ++mt) {
#pragma unroll
        for (int k4 = 0; k4 < 4; ++k4) qeF[mt][k4] = *(const bf16x8*)(QE_ + ch * 8192 + (mt * 16 + m16) * 128 + k4 * 32 + q4 * 8);
#pragma unroll
        for (int k2 = 0; k2 < 2; ++k2) atF[mt][k2] = *(const bf16x8*)(AT_ + ch * 4096 + (mt * 16 + m16) * 64 + k2 * 32 + q4 * 8);
        zg[mt] = *(const u32x2*)(PROJ + (row0 + mt * 16 + m16) * NPE + 1536 + h * 128 + wave * 16 + q4 * 4);
    }
    f32x4 acc[4];
#pragma unroll
    for (int mt = 0; mt < 4; ++mt) {
        f32x4 a = {0.f, 0.f, 0.f, 0.f};
#pragma unroll
        for (int k4 = 0; k4 < 4; ++k4) a = mfma16(scF[k4], qeF[mt][k4], a);
#pragma unroll
        for (int k2 = 0; k2 < 2; ++k2) a = mfma16(vnF[k2], atF[mt][k2], a);
        acc[mt] = a;
        float ss = (a[0] * a[0] + a[1] * a[1]) + (a[2] * a[2] + a[3] * a[3]);
        ss += __shfl_xor(ss, 16); ss += __shfl_xor(ss, 32);
        if (q4 == 0) red[wave * 64 + mt * 16 + m16] = ss;
    }
    __syncthreads();
    const f32x4 gn = *(const f32x4*)(dn_norm + wave * 16 + q4 * 4);
#pragma unroll
    for (int mt = 0; mt < 4; ++mt) {
        const int t = mt * 16 + m16; float tot = 0.f;
#pragma unroll
        for (int w = 0; w < 8; ++w) tot += red[w * 64 + t];
        const float rstd = rsqrtf(tot * (1.f / 128.f) + EPS);
        const f32x4 a = acc[mt]; const u32x2 z = zg[mt];
        u32x2 w; w.x = pk2(a[0] * rstd * gn[0] * siluf(bflo(z.x)), a[1] * rstd * gn[1] * siluf(bfhi(z.x)));
        w.y = pk2(a[2] * rstd * gn[2] * siluf(bflo(z.y)), a[3] * rstd * gn[3] * siluf(bfhi(z.y)));
        *(u32x2*)(MIX + (row0 + t) * DM + h * 128 + wave * 16 + q4 * 4) = w;
    }
    __syncthreads();
}

__device__ __forceinline__ void swa_prompt(int tid, int unit, unsigned char* lds, const bf16* PROJ, const float* sinks, bf16* MIX) {
    asm volatile("" : "+v"(tid));
    const int lane = tid & 63, wave = tid >> 6, m16 = lane & 15, q4 = lane >> 4;
    const int qb = unit & 63, kvh = (unit >> 6) & 1, b = unit >> 7;
    const int p0 = qb * 128; const size_t rowb = (size_t)b * SEQ;
    bf16* Ks = (bf16*)lds;
    bf16* VsT = (bf16*)(lds + 39168);
    bf16* Pw = (bf16*)(lds + 75008 + wave * 5376);
    for (int i = 0; i < 4; ++i) {
        const int item = i * 512 + tid, key = item >> 3, dg = item & 7; const int pos = p0 - 128 + key;
        u32x4 kw = {0u, 0u, 0u, 0u}, vw = {0u, 0u, 0u, 0u};
        if (pos >= 0) { const bf16* pr = PROJ + (rowb + pos) * NPE + kvh * 64 + dg * 8; kw = *(const u32x4*)(pr + 2568); vw = *(const u32x4*)(pr + 2696); }
        *(u32x4*)(Ks + key * 72 + dg * 8) = kw;
        VsT[(dg * 8 + 0) * 280 + key] = (bf16)(vw.x & 0xffff); VsT[(dg * 8 + 1) * 280 + key] = (bf16)(vw.x >> 16);
        VsT[(dg * 8 + 2) * 280 + key] = (bf16)(vw.y & 0xffff); VsT[(dg * 8 + 3) * 280 + key] = (bf16)(vw.y >> 16);
        VsT[(dg * 8 + 4) * 280 + key] = (bf16)(vw.z & 0xffff); VsT[(dg * 8 + 5) * 280 + key] = (bf16)(vw.z >> 16);
        VsT[(dg * 8 + 6) * 280 + key] = (bf16)(vw.w & 0xffff); VsT[(dg * 8 + 7) * 280 + key] = (bf16)(vw.w >> 16);
    }
    { unsigned zz = 0u; asm volatile("" : "+v"(zz));
      if (tid < 128) { const int key = 256 + (tid >> 3), dg = tid & 7; *(u32x4*)(Ks + key * 72 + dg * 8) = (u32x4){zz, zz, zz, zz}; } }
    for (int i = tid; i < 64 * 24; i += 512) { const int d = i / 24, kk = 256 + i % 24; VsT[d * 280 + kk] = 0; }
    __syncthreads();
    const int g = wave >> 1, half = wave & 1, head = kvh * 4 + g;
    const float slope = exp2f(-(float)(head + 1)), sink = sinks[head];
#pragma unroll 1
    for (int mt4 = 0; mt4 < 4; ++mt4) {
        const int q0 = half * 64 + mt4 * 16;
        const bf16* qp = PROJ + (rowb + p0 + q0 + m16) * NPE + 2056 + head * 64 + q4 * 8;
        const bf16x8 qA0 = *(const bf16x8*)(qp), qA1 = *(const bf16x8*)(qp + 32);
        float sc[10][4];
#pragma unroll
        for (int kt = 0; kt < 10; ++kt) {
            const int j0 = q0 + kt * 16;
            const bf16x8 kB0 = *(const bf16x8*)(Ks + (j0 + m16) * 72 + q4 * 8), kB1 = *(const bf16x8*)(Ks + (j0 + m16) * 72 + 32 + q4 * 8);
            f32x4 acc = {0.f, 0.f, 0.f, 0.f};
            acc = mfma16(qA0, kB0, acc); acc = mfma16(qA1, kB1, acc);
            const int j = j0 + m16; const int pos = p0 - 128 + j;
#pragma unroll
            for (int i = 0; i < 4; ++i) { const int rel = q0 + q4 * 4 + i + 128 - j; const bool valid = rel >= 0 && rel < 128 && pos >= 0;
                sc[kt][i] = valid ? acc[i] * 0.125f - slope * (float)rel : -1e30f; }
        }
        float inv[4], mx[4];
#pragma unroll
        for (int i = 0; i < 4; ++i) {
            float m = sc[0][i];
#pragma unroll
            for (int kt = 1; kt < 10; ++kt) m = fmaxf(m, sc[kt][i]);
            m = fmaxf(max16(m), sink); mx[i] = m;
            float s = 0.f;
#pragma unroll
            for (int kt = 0; kt < 10; ++kt) { sc[kt][i] = __expf(sc[kt][i] - m); s += sc[kt][i]; }
            s = sum16(s) + __expf(sink - m);
            inv[i] = __builtin_amdgcn_rcpf(s);
        }
#pragma unroll
        for (int kt = 0; kt < 10; ++kt)
#pragma unroll
            for (int i = 0; i < 4; ++i) Pw[(q4 * 4 + i) * 168 + kt * 16 + m16] = (bf16)f2bf(sc[kt][i] * inv[i]);
        LDSWAIT();
        bf16x8 pA[5];
#pragma unroll
        for (int k5 = 0; k5 < 5; ++k5) pA[k5] = *(const bf16x8*)(Pw + m16 * 168 + k5 * 32 + q4 * 8);
#pragma unroll
        for (int nt = 0; nt < 4; ++nt) {
            f32x4 acc = {0.f, 0.f, 0.f, 0.f};
#pragma unroll
            for (int k5 = 0; k5 < 5; ++k5) { const bf16x8 vB = *(const bf16x8*)(VsT + (nt * 16 + m16) * 280 + q0 + k5 * 32 + q4 * 8); acc = mfma16(vB, pA[k5], acc); }
            u32x2 w; w.x = pk2(acc[0], acc[1]); w.y = pk2(acc[2], acc[3]);
            *(u32x2*)(MIX + (rowb + p0 + q0 + m16) * DM + 512 + head * 64 + nt * 16 + q4 * 4) = w;
        }
        LDSWAIT();
    }
    __syncthreads();
}

__device__ __forceinline__ void sample_even(int tid, int s, int el, unsigned char* lds, const bf16* PROJ, const float* state_dn, const float* state_conv, const float* cache_k, const float* cache_v,
                                            const float* conv_w, const float* a_log, const float* dt_bias, const float* dn_norm, const float* sinks, bf16* MIX, float* out) {
    asm volatile("" : "+v"(tid));
    const int lane = tid & 63, wave = tid >> 6;
    const size_t row = (size_t)MPR + s; const bf16* pr = PROJ + row * NPE;
    float* cv = (float*)lds;
    float* gsm = cv + 1536;
    float* red = gsm + 16;
    float* qsw = red + 16;
    float* knew = qsw + 512;
    float* vnew = knew + 128;
    float* scs = vnew + 128;
    {
        const float* cb = state_conv + ((size_t)el * MSA + s) * 3 * 1536;
        float* ob = out + O_SCONV + ((size_t)el * MSA + s) * 3 * 1536;
#pragma unroll
        for (int r = 0; r < 3; ++r) {
            const int chn = tid + r * 512;
            const float x3 = bf2f(pr[chn]), b0 = cb[chn], b1 = cb[1536 + chn], b2 = cb[3072 + chn];
            const float v = b0 * conv_w[chn] + b1 * conv_w[1536 + chn] + b2 * conv_w[3072 + chn] + x3 * conv_w[4608 + chn];
            cv[chn] = siluf(v);
            ob[chn] = b1; ob[1536 + chn] = b2; ob[3072 + chn] = x3;
        }
        qsw[tid] = bf2f(pr[2056 + tid]);
        if (tid < 128) { knew[tid] = bf2f(pr[2568 + tid]); vnew[tid] = bf2f(pr[2696 + tid]); }
        if (tid < 4) {
            const float a = bf2f(pr[2048 + tid]), bb = bf2f(pr[2052 + tid]);
            const float x = a + dt_bias[tid]; const float sp = x > 20.f ? x : __logf(1.f + __expf(x));
            gsm[tid] = __expf(-__expf(a_log[tid]) * sp); gsm[4 + tid] = __builtin_amdgcn_rcpf(1.f + __expf(-bb));
        }
    }
    __syncthreads();
    {
        const float a = cv[wave * 128 + lane], bq = cv[wave * 128 + 64 + lane];
        const float ss = wave_sum(a * a + bq * bq);
        const float sc = rsqrtf(ss + EPS) * (wave < 4 ? 0.08838834764831845f : 1.f);
        cv[wave * 128 + lane] = a * sc; cv[wave * 128 + 64 + lane] = bq * sc;
    }
    __syncthreads();
    if (wave < 4) { const float v = cv[wave * 128 + lane] * cv[512 + wave * 128 + lane] + cv[wave * 128 + 64 + lane] * cv[512 + wave * 128 + 64 + lane]; const float t_ = wave_sum(v); if (lane == 0) gsm[8 + wave] = t_; }
    __syncthreads();
#pragma unroll 1
    for (int p = 0; p < 2; ++p) {
        const int hl = tid >> 8, h = p * 2 + hl, dg = (tid >> 5) & 7, e4 = (tid & 31) * 4;
        const float* __restrict__ S = state_dn + (((size_t)el * MSA + s) * 4 + h) * 16384 + (size_t)(dg * 16) * 128 + e4;
        float* __restrict__ So = out + O_SDN + (((size_t)el * MSA + s) * 4 + h) * 16384 + (size_t)(dg * 16) * 128 + e4;
        const float* qh = cv + h * 128 + dg * 16; const float* kh = cv + 512 + h * 128 + dg * 16;
        float* part = vnew + 128 + 1024;
        f32x4 sv[16];
#pragma unroll
        for (int d = 0; d < 16; ++d) sv[d] = *(const f32x4*)(S + d * 128);
        f32x4 r = {0.f, 0.f, 0.f, 0.f}, qS = {0.f, 0.f, 0.f, 0.f};
#pragma unroll
        for (int d = 0; d < 16; ++d) { r += sv[d] * kh[d]; qS += sv[d] * qh[d]; }
        *(f32x4*)(part + ((hl * 8 + dg) * 128 + e4) * 2) = r; *(f32x4*)(part + ((hl * 8 + dg) * 128 + e4) * 2 + 4) = qS;
        __syncthreads();
        f32x4 rt = {0.f, 0.f, 0.f, 0.f}, qt = {0.f, 0.f, 0.f, 0.f};
#pragma unroll
        for (int g2 = 0; g2 < 8; ++g2) { rt += *(const f32x4*)(part + ((hl * 8 + g2) * 128 + e4) * 2); qt += *(const f32x4*)(part + ((hl * 8 + g2) * 128 + e4) * 2 + 4); }
        const float eg = gsm[h], beta = gsm[4 + h], qk = gsm[8 + h];
        const f32x4 vv4 = *(const f32x4*)(cv + 1024 + h * 128 + e4);
        const f32x4 vn = (vv4 - rt * eg) * beta;
        const f32x4 o = qt * eg + vn * qk;
#pragma unroll
        for (int d = 0; d < 16; ++d) *(f32x4*)(So + d * 128) = sv[d] * eg + vn * kh[d];
        float ss = (o.x * o.x + o.y * o.y) + (o.z * o.z + o.w * o.w);
        ss += __shfl_xor(ss, 1); ss += __shfl_xor(ss, 2); ss += __shfl_xor(ss, 4); ss += __shfl_xor(ss, 8); ss += __shfl_xor(ss, 16);
        const float rstd = rsqrtf(ss * (1.f / 128.f) + EPS);
        if (dg == 0) {
            const u32x2 zw = *(const u32x2*)(pr + 1536 + h * 128 + e4);
            const f32x4 nn = *(const f32x4*)(dn_norm + e4);
            u32x2 w; w.x = pk2(o.x * rstd * nn.x * siluf(bflo(zw.x)), o.y * rstd * nn.y * siluf(bfhi(zw.x)));
            w.y = pk2(o.z * rstd * nn.z * siluf(bflo(zw.y)), o.w * rstd * nn.w * siluf(bfhi(zw.y)));
            *(u32x2*)(MIX + row * DM + h * 128 + e4) = w;
        }
        __syncthreads();
    }
    {
        const float* ck = cache_k + ((size_t)el * MSA + s) * 16384; const float* cvv = cache_v + ((size_t)el * MSA + s) * 16384;
        const int head = tid >> 6, jj = tid & 63, kvh = head >> 2;
        const float slope = exp2f(-(float)(head + 1)); const float c125 = opq(0.125f);
#pragma unroll
        for (int r = 0; r < 2; ++r) {
            const int ci = jj + r * 64;
            float dot = 0.f;
            if (ci < 127) { const float* kp = ck + (ci + 1) * 128 + kvh * 64;
#pragma unroll
                for (int d4 = 0; d4 < 16; ++d4) { const f32x4 kv = *(const f32x4*)(kp + d4 * 4); const float* q = qsw + head * 64 + d4 * 4; dot += kv.x * q[0] + kv.y * q[1] + kv.z * q[2] + kv.w * q[3]; }
            } else {
#pragma unroll
                for (int d = 0; d < 64; ++d) dot += knew[kvh * 64 + d] * qsw[head * 64 + d];
            }
            scs[head * 128 + ci] = dot * c125 - slope * (float)(127 - ci);
        }
        __syncthreads();
        {
            const float sink = sinks[wave];
            const float v0 = scs[wave * 128 + lane], v1 = scs[wave * 128 + 64 + lane];
            const float m = fmaxf(wave_max(fmaxf(v0, v1)), sink);
            const float p0 = __expf(v0 - m), p1 = __expf(v1 - m);
            const float den = wave_sum(p0 + p1) + __expf(sink - m);
            scs[wave * 128 + lane] = p0 / den; scs[wave * 128 + 64 + lane] = p1 / den;
        }
        __syncthreads();
        {
            const int d = tid & 63; float o = 0.f;
#pragma unroll 8
            for (int ci = 0; ci < 127; ++ci) o += scs[head * 128 + ci] * cvv[(ci + 1) * 128 + kvh * 64 + d];
            o += scs[head * 128 + 127] * vnew[kvh * 64 + d];
            MIX[row * DM + 512 + head * 64 + d] = (bf16)f2bf(o);
        }
        float* __restrict__ ok = out + O_SK + ((size_t)el * MSA + s) * 16384; float* __restrict__ ov = out + O_SV + ((size_t)el * MSA + s) * 16384;
        f32x4 ck4[8], cv4[8];
#pragma unroll
        for (int i = 0; i < 8; ++i) { const int i4 = (i * 512 + tid) * 4; const bool past = i4 < 127 * 128;
            ck4[i] = past ? *(const f32x4*)(ck + i4 + 128) : *(const f32x4*)(knew + (i4 & 127));
            cv4[i] = past ? *(const f32x4*)(cvv + i4 + 128) : *(const f32x4*)(vnew + (i4 & 127)); }
#pragma unroll
        for (int i = 0; i < 8; ++i) { const int i4 = (i * 512 + tid) * 4; *(f32x4*)(ok + i4) = ck4[i]; *(f32x4*)(ov + i4) = cv4[i]; }
    }
    __syncthreads();
}
__device__ __forceinline__ void prompt_misc(int tid, int u, int el, const bf16* PROJ, float* out) {
    asm volatile("" : "+v"(tid));
    const int b = u & 1, which = u >> 1;
    float* o = out + (which ? O_PV : O_PK) + ((size_t)el * 2 + b) * 16384;
    for (int i = tid; i < 16384; i += 512) { const int j = i >> 7, rem = i & 127; o[i] = bf2f(PROJ[((size_t)b * SEQ + 8064 + j) * NPE + (which ? 2696 : 2568) + rem]); }
    if (which == 0) { float* oc = out + O_PCONV + ((size_t)el * 2 + b) * 4608;
        for (int i = tid; i < 4608; i += 512) { const int r = i / 1536, chn = i % 1536; oc[i] = bf2f(PROJ[((size_t)b * SEQ + 8189 + r) * NPE + chn]); } }
}

__device__ __forceinline__ void sample_odd(int tid, int s, int ol, unsigned char* lds, const bf16* PROJ, const float* state_gla, const float* Wg, const float* bg, const float* gla_norm, bf16* MIX, float* out) {
    asm volatile("" : "+v"(tid));
    const int lane = tid & 63, wave = tid >> 6;
    const size_t row = (size_t)MPR + s; const bf16* pr = PROJ + row * NPO;
    float* qv = (float*)lds; float* kv = qv + 512; float* egs = kv + 512; float* vv = egs + 512; float* red = vv + 1024;
    {
        float x = bg[tid];
#pragma unroll
        for (int j = 0; j < 16; ++j) x += bf2f(pr[3072 + j]) * Wg[j * 512 + tid];
        const float ls = fminf(x, 0.f) - __logf(1.f + __expf(-fabsf(x)));
        egs[tid] = __expf(ls * (1.f / 16.f));
        qv[tid] = bf2f(pr[tid]) * 0.08838834764831845f; kv[tid] = bf2f(pr[512 + tid]);
        vv[tid] = bf2f(pr[1024 + tid]); vv[tid + 512] = bf2f(pr[1536 + tid]);
    }
    __syncthreads();
    {
        const int h = tid >> 7, dg = (tid >> 6) & 1, e4 = (tid & 63) * 4;
        const float* __restrict__ S = state_gla + (((size_t)ol * MSA + s) * 4 + h) * 32768 + (size_t)(dg * 64) * 256 + e4;
        float* __restrict__ So = out + O_SGLA + (((size_t)ol * MSA + s) * 4 + h) * 32768 + (size_t)(dg * 64) * 256 + e4;
        const f32x4 v4 = *(const f32x4*)(vv + h * 256 + e4);
        const float* kd = kv + h * 128 + dg * 64; const float* ed = egs + h * 128 + dg * 64; const float* qd = qv + h * 128 + dg * 64;
        float* part = red + 16;
        f32x4 o = {0.f, 0.f, 0.f, 0.f};
#pragma unroll 1
        for (int d0 = 0; d0 < 64; d0 += 16) {
            f32x4 sv[16];
#pragma unroll
            for (int d = 0; d < 16; ++d) sv[d] = *(const f32x4*)(S + (d0 + d) * 256);
#pragma unroll
            for (int d = 0; d < 16; ++d) { const f32x4 n = sv[d] * ed[d0 + d] + v4 * kd[d0 + d]; *(f32x4*)(So + (d0 + d) * 256) = n; o += n * qd[d0 + d]; }
        }
        *(f32x4*)(part + (h * 2 + dg) * 256 + e4) = o;
        __syncthreads();
        const f32x4 ot = *(const f32x4*)(part + (h * 2) * 256 + e4) + *(const f32x4*)(part + (h * 2 + 1) * 256 + e4);
        const float ss = wave_sum((ot.x * ot.x + ot.y * ot.y) + (ot.z * ot.z + ot.w * ot.w));
        const float rstd = rsqrtf(ss * (1.f / 256.f) + EPS);
        if (dg == 0) {
            const u32x2 rw = *(const u32x2*)(pr + 2048 + h * 256 + e4);
            const f32x4 nn = *(const f32x4*)(gla_norm + e4);
            u32x2 w; w.x = pk2(ot.x * rstd * nn.x * siluf(bflo(rw.x)), ot.y * rstd * nn.y * siluf(bfhi(rw.x)));
            w.y = pk2(ot.z * rstd * nn.z * siluf(bflo(rw.y)), ot.w * rstd * nn.w * siluf(bfhi(rw.y)));
            *(u32x2*)(MIX + row * DM + h * 256 + e4) = w;
        }
    }
    __syncthreads();
}

__device__ __forceinline__ void gla_stepA(int tid, int unit, unsigned char* lds, const bf16* PROJ, const float* Wg, const float* bg, bf16* US_, bf16* QT_, bf16* OI, float* EGL_) {
    asm volatile("" : "+v"(tid));
    const int lane = tid & 63, wave = tid >> 6, m16 = lane & 15, q4 = lane >> 4;
    const int h = unit & 3, c = (unit >> 2) & 127, b = unit >> 9;
    const size_t row0 = (size_t)b * SEQ + c * 64; const size_t ch = (size_t)unit;
    float* Gs = (float*)lds;
    bf16* qs = (bf16*)(lds + 32768); bf16* ks = (bf16*)(lds + 50176);
    bf16* kT = (bf16*)(lds + 67584);
    bf16* vT = (bf16*)(lds + 86016);
    bf16* as = (bf16*)(lds + 122880);
    float* qt = (float*)(lds + 132096);
    float* gdl = (float*)(lds + 134144);
    u32x4 rq[4], rv[4];
    float wg[16];
    const unsigned short gd0 = PROJ[(row0 + (tid >> 4)) * NPO + 3072 + (tid & 15)], gd1 = PROJ[(row0 + 32 + (tid >> 4)) * NPO + 3072 + (tid & 15)];
#pragma unroll
    for (int j = 0; j < 16; ++j) wg[j] = Wg[j * 512 + h * 128 + (tid & 127)];
#pragma unroll
    for (int i = 0; i < 4; ++i) {
        const int item = i * 512 + tid, part = item >> 10, t = (item >> 4) & 63, cg = item & 15;
        rq[i] = *(const u32x4*)(PROJ + (row0 + t) * NPO + part * 512 + h * 128 + cg * 8);
        const int t2 = item >> 5, eg8 = item & 31;
        rv[i] = *(const u32x4*)(PROJ + (row0 + t2) * NPO + 1024 + h * 256 + eg8 * 8);
    }
    gdl[tid] = bf2f(gd0); gdl[tid + 512] = bf2f(gd1);
    __syncthreads();
    {
        const int d = tid & 127, tq = tid >> 7, col = h * 128 + d;
        const float bgc = bg[col]; float run = 0.f;
        float cum[16];
#pragma unroll
        for (int tt = 0; tt < 16; ++tt) {
            const int t = tq * 16 + tt; float x = bgc;
            const f32x4 gq0 = *(const f32x4*)(gdl + t * 16), gq1 = *(const f32x4*)(gdl + t * 16 + 4), gq2 = *(const f32x4*)(gdl + t * 16 + 8), gq3 = *(const f32x4*)(gdl + t * 16 + 12);
            x += gq0.x * wg[0] + gq0.y * wg[1] + gq0.z * wg[2] + gq0.w * wg[3];
            x += gq1.x * wg[4] + gq1.y * wg[5] + gq1.z * wg[6] + gq1.w * wg[7];
            x += gq2.x * wg[8] + gq2.y * wg[9] + gq2.z * wg[10] + gq2.w * wg[11];
            x += gq3.x * wg[12] + gq3.y * wg[13] + gq3.z * wg[14] + gq3.w * wg[15];
            const float ls = fminf(x, 0.f) - __logf(1.f + __expf(-fabsf(x)));
            run += ls * (1.f / 16.f);
            cum[tt] = run;
        }
        qt[tq * 128 + d] = run;
        __syncthreads();
        float off = 0.f;
#pragma unroll
        for (int q = 0; q < 3; ++q) off += (q < tq) ? qt[q * 128 + d] : 0.f;
#pragma unroll
        for (int tt = 0; tt < 16; ++tt) Gs[(tq * 16 + tt) * 128 + d] = cum[tt] + off;
    }
    __syncthreads();
    {
#pragma unroll
        for (int i = 0; i < 4; ++i) {
            const int item = i * 512 + tid, part = item >> 10, t = (item >> 4) & 63, cg = item & 15;
            float f[8]; unpack8(rq[i], f);
            float o[8];
            const f32x4 g0 = *(const f32x4*)(Gs + t * 128 + cg * 8), g1 = *(const f32x4*)(Gs + t * 128 + cg * 8 + 4), l0 = *(const f32x4*)(Gs + 63 * 128 + cg * 8), l1 = *(const f32x4*)(Gs + 63 * 128 + cg * 8 + 4);
            const float dls[8] = {g0.x - l0.x, g0.y - l0.y, g0.z - l0.z, g0.w - l0.w, g1.x - l1.x, g1.y - l1.y, g1.z - l1.z, g1.w - l1.w};
#pragma unroll
            for (int j = 0; j < 8; ++j) { const float dl = dls[j]; o[j] = part == 0 ? f[j] * 0.08838834764831845f * __expf(dl) : f[j] * __expf(-dl); }
            const u32x4 w = pack8(o);
            if (part == 0) { *(u32x4*)(qs + t * 136 + cg * 8) = w; *(u32x4*)(QT_ + ch * 8192 + t * 128 + cg * 8) = w; }
            else { *(u32x4*)(ks + t * 136 + cg * 8) = w;
#pragma unroll
                for (int j = 0; j < 8; ++j) kT[(cg * 8 + j) * 72 + (((t >> 3) ^ (cg & 7)) << 3) + (t & 7)] = (bf16)f2bf(o[j]); }
        }
#pragma unroll
        for (int i = 0; i < 4; ++i) {
            const int item = i * 512 + tid, t = item >> 5, eg8 = item & 31;
            const u32x4 w = rv[i];
            bf16* vp = vT + (eg8 * 8) * 72 + (((t >> 3) ^ (eg8 & 7)) << 3) + (t & 7);
            vp[0] = (bf16)(w.x & 0xffff); vp[72] = (bf16)(w.x >> 16); vp[144] = (bf16)(w.y & 0xffff); vp[216] = (bf16)(w.y >> 16);
            vp[288] = (bf16)(w.z & 0xffff); vp[360] = (bf16)(w.z >> 16); vp[432] = (bf16)(w.w & 0xffff); vp[504] = (bf16)(w.w >> 16);
        }
    }
    if (tid < 128) EGL_[ch * 128 + tid] = __expf(Gs[63 * 128 + tid]);
    __syncthreads();
    {
        const int mt = wave >> 1;
        bf16x8 aF[4];
#pragma unroll
        for (int k4 = 0; k4 < 4; ++k4) aF[k4] = *(const bf16x8*)(qs + (mt * 16 + m16) * 136 + k4 * 32 + q4 * 8);
#pragma unroll
        for (int n2 = 0; n2 < 2; ++n2) {
            const int nt = (wave & 1) * 2 + n2;
            f32x4 acc = {0.f, 0.f, 0.f, 0.f};
            if (nt <= mt) {
#pragma unroll
                for (int k4 = 0; k4 < 4; ++k4) { const bf16x8 bF = *(const bf16x8*)(ks + (nt * 16 + m16) * 136 + k4 * 32 + q4 * 8); acc = mfma16(aF[k4], bF, acc); }
            }
            const int s = nt * 16 + m16;
#pragma unroll
            for (int i = 0; i < 4; ++i) { const int t = mt * 16 + q4 * 4 + i; as[t * 72 + s] = (bf16)f2bf(t >= s ? acc[i] : 0.f); }
        }
    }
    {
        bf16x8 aF[2];
#pragma unroll
        for (int k2 = 0; k2 < 2; ++k2) { const int rr = wave * 16 + m16; aF[k2] = *(const bf16x8*)(kT + rr * 72 + (((k2 * 4 + q4) ^ ((rr >> 3) & 7)) << 3)); }
#pragma unroll 4
        for (int nt = 0; nt < 16; ++nt) {
            f32x4 acc = {0.f, 0.f, 0.f, 0.f};
#pragma unroll
            for (int k2 = 0; k2 < 2; ++k2) { const int rr = nt * 16 + m16; const bf16x8 bF = *(const bf16x8*)(vT + rr * 72 + (((k2 * 4 + q4) ^ ((rr >> 3) & 7)) << 3)); acc = mfma16(aF[k2], bF, acc); }
            u32x2 w; w.x = pk2(acc[0], acc[1]); w.y = pk2(acc[2], acc[3]);
            *(u32x2*)(US_ + ch * 32768 + (nt * 16 + m16) * 128 + wave * 16 + q4 * 4) = w;
        }
    }
    __syncthreads();
    {
        bf16x8 bF[2][2];
#pragma unroll
        for (int n2 = 0; n2 < 2; ++n2)
#pragma unroll
            for (int k2 = 0; k2 < 2; ++k2) { const int rr = (wave * 2 + n2) * 16 + m16; bF[n2][k2] = *(const bf16x8*)(vT + rr * 72 + (((k2 * 4 + q4) ^ ((rr >> 3) & 7)) << 3)); }
#pragma unroll
        for (int mt = 0; mt < 4; ++mt) {
            bf16x8 aF[2];
#pragma unroll
            for (int k2 = 0; k2 < 2; ++k2) aF[k2] = *(const bf16x8*)(as + (mt * 16 + m16) * 72 + k2 * 32 + q4 * 8);
#pragma unroll
            for (int n2 = 0; n2 < 2; ++n2) {
                f32x4 acc = {0.f, 0.f, 0.f, 0.f};
                acc = mfma16(bF[n2][0], aF[0], acc); acc = mfma16(bF[n2][1], aF[1], acc);
                u32x2 w; w.x = pk2(acc[0], acc[1]); w.y = pk2(acc[2], acc[3]);
                ((u32x2*)OI)[(((ch * 8 + wave) * 4 + mt) * 2 + n2) * 64 + lane] = w;
            }
        }
    }
    __syncthreads();
}

__device__ __forceinline__ void gla_scan(bf16* US_, const float* __restrict__ EGL_, float* __restrict__ state_out, int gtid, int ngt) {
    for (int idx = gtid; idx < 131072; idx += ngt) {
        const int dp = idx & 63, e = (idx >> 6) & 255, bh = idx >> 14, b = bh >> 2, h = bh & 3;
        float s0 = 0.f, s1 = 0.f;
        unsigned* p = (unsigned*)(US_ + ((size_t)b * 512 + h) * 32768 + e * 128 + dp * 2);
        const float* eg = EGL_ + ((size_t)b * 512 + h) * 128 + dp * 2;
        constexpr size_t PS = (size_t)4 * 32768 / 2, GS = (size_t)4 * 128;
        unsigned ua[8], ub[8]; f32x2v ga[8], gb[8];
#define GSC_LOAD(c0, u_, g_) do { _Pragma("unroll") for (int k = 0; k < 8; ++k) { const int cc = (c0) + k < 128 ? (c0) + k : 127; u_[k] = p[cc * PS]; g_[k] = *(const f32x2v*)(eg + cc * GS); } } while (0)
#define GSC_PROC(c0, u_, g_) do { _Pragma("unroll") for (int k = 0; k < 8; ++k) { s0 *= g_[k].x; s1 *= g_[k].y; p[((c0) + k) * PS] = pk2(s0, s1); s0 += bflo(u_[k]); s1 += bfhi(u_[k]); } } while (0)
        GSC_LOAD(0, ua, ga);
#pragma unroll 1
        for (int c0 = 0; c0 < 128; c0 += 16) {
            GSC_LOAD(c0 + 8, ub, gb);
            GSC_PROC(c0, ua, ga);
            GSC_LOAD(c0 + 16, ua, ga);
            GSC_PROC(c0 + 8, ub, gb);
        }
#undef GSC_LOAD
#undef GSC_PROC
        float* so = state_out + ((size_t)(b * 4 + h) * 128 + dp * 2) * 256 + e;
        so[0] = s0; so[256] = s1;
    }
}

__device__ __forceinline__ void gla_stepC(int tid, int unit, unsigned char* lds, const bf16* __restrict__ PROJ, const bf16* __restrict__ US_, const bf16* __restrict__ QT_, const bf16* __restrict__ OI, const float* gla_norm, bf16* __restrict__ MIX) {
    asm volatile("" : "+v"(tid));
    const int lane = tid & 63, wave = tid >> 6, m16 = lane & 15, q4 = lane >> 4;
    const int h = unit & 3, c = (unit >> 2) & 127, b = unit >> 9;
    const size_t row0 = (size_t)b * SEQ + c * 64; const size_t ch = (size_t)unit;
    float* red = (float*)lds;
    bf16x8 sB[2][4], aF[4][4]; u32x2 oi[4][2], rg[4][2];
#pragma unroll
    for (int n2 = 0; n2 < 2; ++n2)
#pragma unroll
        for (int k4 = 0; k4 < 4; ++k4) sB[n2][k4] = *(const bf16x8*)(US_ + ch * 32768 + ((wave * 2 + n2) * 16 + m16) * 128 + k4 * 32 + q4 * 8);
#pragma unroll
    for (int mt = 0; mt < 4; ++mt) {
#pragma unroll
        for (int k4 = 0; k4 < 4; ++k4) aF[mt][k4] = *(const bf16x8*)(QT_ + ch * 8192 + (mt * 16 + m16) * 128 + k4 * 32 + q4 * 8);
#pragma unroll
        for (int n2 = 0; n2 < 2; ++n2) { oi[mt][n2] = ((const u32x2*)OI)[(((ch * 8 + wave) * 4 + mt) * 2 + n2) * 64 + lane];
            rg[mt][n2] = *(const u32x2*)(PROJ + (row0 + mt * 16 + m16) * NPO + 2048 + h * 256 + (wave * 2 + n2) * 16 + q4 * 4); }
    }
    f32x4 acc[4][2];
#pragma unroll
    for (int mt = 0; mt < 4; ++mt) {
        float ss = 0.f;
#pragma unroll
        for (int n2 = 0; n2 < 2; ++n2) {
            f32x4 a = {bflo(oi[mt][n2].x), bfhi(oi[mt][n2].x), bflo(oi[mt][n2].y), bfhi(oi[mt][n2].y)};
#pragma unroll
            for (int k4 = 0; k4 < 4; ++k4) a = mfma16(sB[n2][k4], aF[mt][k4], a);
            acc[mt][n2] = a;
            ss += (a[0] * a[0] + a[1] * a[1]) + (a[2] * a[2] + a[3] * a[3]);
        }
        ss += __shfl_xor(ss, 16); ss += __shfl_xor(ss, 32);
        if (q4 == 0) red[wave * 64 + mt * 16 + m16] = ss;
    }
    __syncthreads();
    f32x4 gn[2];
#pragma unroll
    for (int n2 = 0; n2 < 2; ++n2) gn[n2] = *(const f32x4*)(gla_norm + (wave * 2 + n2) * 16 + q4 * 4);
#pragma unroll
    for (int mt = 0; mt < 4; ++mt) {
        const int t = mt * 16 + m16; float tot = 0.f;
#pragma unroll
        for (int w = 0; w < 8; ++w) tot += red[w * 64 + t];
        const float rstd = rsqrtf(tot * (1.f / 256.f) + EPS);
#pragma unroll
        for (int n2 = 0; n2 < 2; ++n2) {
            const f32x4 a = acc[mt][n2]; const u32x2 r = rg[mt][n2];
            u32x2 w; w.x = pk2(a[0] * rstd * gn[n2][0] * siluf(bflo(r.x)), a[1] * rstd * gn[n2][1] * siluf(bfhi(r.x)));
            w.y = pk2(a[2] * rstd * gn[n2][2] * siluf(bflo(r.y)), a[3] * rstd * gn[n2][3] * siluf(bfhi(r.y)));
            *(u32x2*)(MIX + (row0 + t) * DM + h * 256 + (wave * 2 + n2) * 16 + q4 * 4) = w;
        }
    }
    __syncthreads();
}

template <int MODE>
__device__ __forceinline__ void skinny_unit(int tid, const bf16* A, const bf16* Bt, int K, int ld, size_t row0, int col0, void* C, int ldc, float sgn = 1.f) {
    asm volatile("" : "+v"(tid));
    const int lane = tid & 63, wave = tid >> 6, m16 = lane & 15, q4 = lane >> 4;
    const bf16* ap = A + (row0 + wave * 16 + m16) * ld + q4 * 8;
    const bf16* bp = Bt + (size_t)(col0 + m16) * ld + q4 * 8;
    f32x4 acc0 = {0.f, 0.f, 0.f, 0.f}, acc1 = {0.f, 0.f, 0.f, 0.f};
#pragma unroll 1
    for (int k = 0; k < K; k += 256) {
        bf16x8 av[8], bv[8];
#pragma unroll
        for (int j = 0; j < 8; ++j) { av[j] = *(const bf16x8*)(ap + k + j * 32); bv[j] = *(const bf16x8*)(bp + k + j * 32); }
#pragma unroll
        for (int j = 0; j < 8; j += 2) { acc0 = mfma16(av[j], bv[j], acc0); acc1 = mfma16(av[j + 1], bv[j + 1], acc1); }
    }
    const f32x4 acc = acc0 + acc1;
    const size_t r = row0 + wave * 16 + q4 * 4; const int c = col0 + m16;
#pragma unroll
    for (int i = 0; i < 4; ++i) {
        if (MODE == 3) { atomicAdd((float*)C + (r + i) * ldc + c, acc[i] * sgn); }
        else { float v = acc[i]; if (MODE == 2) { v = v > 0.f ? v : 0.f; v = v * v; } ((bf16*)C)[(r + i) * ldc + c] = (bf16)f2bf(v); }
    }
}

__device__ __forceinline__ void skinny_res(int tid, int unit, unsigned char* lds, const bf16* __restrict__ A, const bf16* __restrict__ Bt, int K, float* __restrict__ X) {
    asm volatile("" : "+v"(tid));
    const int lane = tid & 63, wave = tid >> 6, m16 = lane & 15, q4 = lane >> 4;
    const int rg = unit >> 6, ct = unit & 63, rt = wave & 1, ksl = wave >> 1, Ks = K >> 2;
    const bf16* ap = A + ((size_t)MPR + rg * 32 + rt * 16 + m16) * K + ksl * Ks + q4 * 8;
    const bf16* bp = Bt + (size_t)(ct * 16 + m16) * K + ksl * Ks + q4 * 8;
    f32x4 acc0 = {0.f, 0.f, 0.f, 0.f}, acc1 = {0.f, 0.f, 0.f, 0.f};
#pragma unroll 1
    for (int k = 0; k < Ks; k += 256) {
        bf16x8 av[8], bv[8];
#pragma unroll
        for (int j = 0; j < 8; ++j) { av[j] = *(const bf16x8*)(ap + k + j * 32); bv[j] = *(const bf16x8*)(bp + k + j * 32); }
#pragma unroll
        for (int j = 0; j < 8; j += 2) { acc0 = mfma16(av[j], bv[j], acc0); acc1 = mfma16(av[j + 1], bv[j + 1], acc1); }
    }
    f32x4* red = (f32x4*)lds;
    red[wave * 64 + lane] = acc0 + acc1;
    __syncthreads();
    if (ksl == 0) {
        const f32x4 t = (red[rt * 64 + lane] + red[(2 + rt) * 64 + lane]) + (red[(4 + rt) * 64 + lane] + red[(6 + rt) * 64 + lane]);
        float* xp = X + ((size_t)MPR + rg * 32 + rt * 16 + q4 * 4) * DM + ct * 16 + m16;
#pragma unroll
        for (int i = 0; i < 4; ++i) xp[i * DM] += t[i];
    }
    __syncthreads();
}

#define LAS __attribute__((address_space(3)))
#define XB_TMO      128
#define XB_XCNT(j)  (256  + 64 * (j))
#define XB_XSUB(j)  (1280 + 64 * (j))
#define XB_XGEN(j)  (2304 + 64 * (j))
#define XB_TOP      3328
#define XB_TOPGEN   3392
#define XCD_BAR_WORDS 3456
#define XB_SPIN_CAP (1u << 18)

__device__ __forceinline__ unsigned xb_ld(unsigned* p)              { return __hip_atomic_load(p, __ATOMIC_RELAXED, __HIP_MEMORY_SCOPE_AGENT); }
__device__ __forceinline__ unsigned xb_add(unsigned* p, unsigned v) { return __hip_atomic_fetch_add(p, v, __ATOMIC_RELAXED, __HIP_MEMORY_SCOPE_AGENT); }
__device__ __forceinline__ unsigned xb_xcc_id() { return (unsigned)__builtin_amdgcn_s_getreg((3 << 11) | 20) & 0xFu; }
#define XB_SPIN(cond, bar) do { unsigned _sp = 0; while (cond) { __builtin_amdgcn_s_sleep(1); \
    if ((++_sp & 255u) == 0u) { if (xb_ld(&(bar)[XB_TMO])) break; if (_sp > XB_SPIN_CAP) { atomicAdd(&(bar)[XB_TMO], 1u); break; } } } } while (0)

struct XcdBarrier {
    unsigned* bar; unsigned x;
    volatile LAS unsigned* st;
};

__device__ __forceinline__ XcdBarrier xcd_barrier_post(unsigned* bar, volatile LAS unsigned* st) {
    XcdBarrier b; b.bar = bar; b.x = xb_xcc_id(); b.st = st;
    if (threadIdx.x == 0) (void)xb_add(&bar[XB_XCNT(b.x)], 1u);
    return b;
}
__device__ __forceinline__ void xcd_barrier_complete(unsigned* bar, unsigned x, unsigned& nloc, unsigned& nx) {
    const unsigned G = gridDim.x * gridDim.y * gridDim.z;
    unsigned sum, cnt, mine, sp = 0u;
    for (;;) {
        sum = 0u; cnt = 0u; mine = 0u;
#pragma unroll
        for (unsigned j = 0; j < 16; ++j) { const unsigned c = xb_ld(&bar[XB_XCNT(j)]); sum += c; cnt += (c > 0u) ? 1u : 0u; mine = (j == x) ? c : mine; }
        if (sum == G) break;
        __builtin_amdgcn_s_sleep(1);
        if ((++sp & 255u) == 0u) { if (xb_ld(&bar[XB_TMO])) break; if (sp > XB_SPIN_CAP) { atomicAdd(&bar[XB_TMO], 1u); break; } }
    }
    nloc = mine > 0u ? mine : 1u; nx = cnt > 0u ? cnt : 1u;
}

__device__ __forceinline__ void xcd_barrier(const XcdBarrier& b) {
    asm volatile("s_waitcnt vmcnt(0)" ::: "memory");
    __syncthreads();
    if (threadIdx.x == 0) {
        unsigned* bar = b.bar;
        __builtin_amdgcn_s_waitcnt(0);
        unsigned nloc = b.st[0], nx = b.st[1];
        if (nloc == 0u) { xcd_barrier_complete(bar, b.x, nloc, nx); b.st[0] = nloc; b.st[1] = nx; }
        const unsigned old = xb_add(&bar[XB_XSUB(b.x)], 1u);
        const unsigned gen = old / nloc;
        if (old + 1u == (gen + 1u) * nloc) {
            __builtin_amdgcn_fence(__ATOMIC_RELEASE, "agent");
            asm volatile("s_waitcnt vmcnt(0)" ::: "memory");
            const unsigned og = xb_add(&bar[XB_TOP], 1u);
            const unsigned tg = og / nx;
            if (og + 1u == (tg + 1u) * nx) xb_add(&bar[XB_TOPGEN], 1u);
            else XB_SPIN(xb_ld(&bar[XB_TOPGEN]) == tg, bar);
            __builtin_amdgcn_fence(__ATOMIC_ACQUIRE, "agent");
            xb_add(&bar[XB_XGEN(b.x)], 1u);
            asm volatile("s_waitcnt vmcnt(0)" ::: "memory");
        } else {
            XB_SPIN(xb_ld(&bar[XB_XGEN(b.x)]) == gen, bar);
            __builtin_amdgcn_fence(__ATOMIC_ACQUIRE, "agent");
            asm volatile("s_waitcnt vmcnt(0)" ::: "memory");
        }
    }
    __syncthreads();
}

#ifndef PROBE_ID
#define PROBE_ID 0
#endif
constexpr size_t WS_TAB = 4096, WS_BAR = 16384;
constexpr int LDS_BARW = 147392;
__global__ void __launch_bounds__(512, 2) mega_fwd(Args a) {
    extern __shared__ __attribute__((aligned(16))) unsigned char lds[];
    const bool coop = (a.ph_hi - a.ph_lo) > 1;
    if (threadIdx.x < 4) ((LAS unsigned*)((LAS unsigned char*)lds + LDS_BARW))[threadIdx.x] = 0u;
    __syncthreads();
    XcdBarrier xbar; xbar.bar = (unsigned*)(a.ws + WS_BAR); xbar.x = 0; xbar.st = nullptr;
    if (coop) xbar = xcd_barrier_post((unsigned*)(a.ws + WS_BAR), (volatile LAS unsigned*)((LAS unsigned char*)lds + LDS_BARW));
#if PROBE_ID
    bool repeated = false; int repcnt = 0; unsigned donemask = 0u;
#endif
#pragma unroll 1
    for (int ph = a.ph_lo; ph < a.ph_hi; ++ph) {
        int tid = threadIdx.x; asm volatile("" : "+v"(tid));
        int bid = blockIdx.x; asm volatile("" : "+s"(bid));
        unsigned char* ws = a.ws; asm volatile("" : "+s"(ws));
        float* outp = a.out; asm volatile("" : "+s"(outp));
        const int lane = tid & 63, wave = tid >> 6;
        const int G = gridDim.x;
        const int gw = bid * 8 + wave, ngw = G * 8;
        bf16* WEI = (bf16*)(ws + WS_WEI); bf16* WEO = (bf16*)(ws + WS_WEO); bf16* WGI = (bf16*)(ws + WS_WGI); bf16* WGO = (bf16*)(ws + WS_WGO);
        bf16* WUP = (bf16*)(ws + WS_WUP); bf16* WDN = (bf16*)(ws + WS_WDN);
        float* X = (float*)(ws + WS_X); bf16* HB = (bf16*)(ws + WS_HB); bf16* MIX = (bf16*)(ws + WS_MIX);
        bf16* PROJ = (bf16*)(ws + WS_BIG); bf16* HID = (bf16*)(ws + WS_BIG);
        const float* const* in = (const float* const*)(ws + WS_TAB);
        if (ph == 0) {
            if (bid == 0 && tid == 0) { const float** tw = (const float**)(ws + WS_TAB);
#pragma unroll
                for (int k = 0; k < 24; ++k) tw[k] = a.in[k]; }
            float* scr = (float*)(lds + wave * 16640);
            transpose_w(a.in[10], DM, NE_IN, NPE, WEI, scr, gw, ngw, lane);
            for (int m0 = gw; m0 < MPAD; m0 += 4 * ngw) {
                f32x4 vv[4][4];
#pragma unroll
                for (int r = 0; r < 4; ++r) { const int m = m0 + r * ngw;
                    const float* src = m < MPR ? a.in[0] + (size_t)m * DM : (m < MREAL ? a.in[1] + (size_t)(m - MPR) * DM : nullptr);
#pragma unroll
                    for (int j = 0; j < 4; ++j) vv[r][j] = src ? *(const f32x4*)(src + 4 * lane + 256 * j) : (f32x4){0.f, 0.f, 0.f, 0.f}; }
#pragma unroll
                for (int r = 0; r < 4; ++r) { const int m = m0 + r * ngw;
                    if (m < MPAD) {
                        if (m >= MPR) {
#pragma unroll
                            for (int j = 0; j < 4; ++j) *(f32x4*)(X + (size_t)m * DM + 4 * lane + 256 * j) = vv[r][j]; }
                        norm_row(vv[r], a.in[7], HB + (size_t)m * DM, nullptr, lane);
                        if (m >= MREAL) {
#pragma unroll
                            for (int j = 0; j < 4; ++j) { u32x2 z = {0u, 0u}; *(u32x2*)(MIX + (size_t)m * DM + 4 * lane + 256 * j) = z; }
                        }
                    }
                }
            }
        } else {
            const int l = (ph - 1) / 9, sp = (ph - 1) % 9, even = !(l & 1), li = l >> 1;
            if (sp == 0) {
                const bf16* Bt = even ? WEI + (size_t)li * NPE * DM : WGI + (size_t)li * NPO * DM; const int ldp = even ? NPE : NPO;
                pg8::Gemm g{HB, Bt, MPR, 3072, DM};
                pg8::StaticOrder S; S.init(g.M, g.N, G, bid);
                pg8::EpiBf16<0> E{PROJ, ldp};
                pg8::gemm_phase<pg8::EpiBf16<0>, pg8::StaticOrder, true, true>((PG8_LAS unsigned char*)lds, g, S, E);
                const int nts = even ? 177 : 193, nsk = even ? nts : nts + 128;
                for (int u = bid; u < nsk; u += G) {
                    if (u < nts) skinny_unit<0>(tid, HB, Bt, DM, DM, (size_t)MPR, u * 16, PROJ, ldp);
                    else skinny_unit<0>(tid, HB, Bt, DM, DM, (size_t)(u - nts) * 128, 3072, PROJ, ldp);
                }
            } else if (sp == 1) {
                if (even) {
                    const float* cw = in[11] + (size_t)li * 4 * 1536; const float* al = in[12] + li * 4; const float* dtb = in[13] + li * 4;
                    for (int u = bid; u < 1024; u += G)
                        dn_stepA(tid, u, lds, PROJ, cw, al, dtb,
                                 (bf16*)(ws + SC_DN_W), (bf16*)(ws + SC_DN_QE), (bf16*)(ws + SC_DN_KT), (bf16*)(ws + SC_DN_AT), (bf16*)(ws + SC_DN_U), (float*)(ws + SC_DN_EGL));
                } else {
                    const float* wg = in[18] + (size_t)li * 16 * 512; const float* bgp = in[19] + li * 512;
                    for (int u = bid; u < 1024; u += G)
                        gla_stepA(tid, u, lds, PROJ, wg, bgp, (bf16*)(ws + SC_GL_US), (bf16*)(ws + SC_GL_QT), (bf16*)(ws + SC_GL_OI), (float*)(ws + SC_GL_EGL));
                }
            } else if (sp == 2) {
                if (even) {
                    const int nb = G > 64 ? 64 : G;
#if PROBE_ID == 12
                    if (!repeated)
#endif
                    if (bid < nb) { for (int it = bid; it < 64; it += nb)
                        dn_stepB(tid, it, lds, (const bf16*)(ws + SC_DN_W), (const bf16*)(ws + SC_DN_KT), (const bf16*)(ws + SC_DN_U),
                                 (const float*)(ws + SC_DN_EGL), (bf16*)(ws + SC_DN_O), (bf16*)(ws + SC_DN_VN), outp + O_PDN + (size_t)li * 2 * 4 * 16384); }
                    const int ob = G > 64 ? bid - 64 : bid, on = G > 64 ? G - 64 : G;
#if PROBE_ID == 11
                    if (!repeated)
#endif
                    if (ob >= 0) {
                        const float* sdn = in[2]; const float* scv = in[3]; const float* ckp = in[4]; const float* cvp = in[5];
                        const float* cw = in[11] + (size_t)li * 4 * 1536; const float* al = in[12] + li * 4; const float* dtb = in[13] + li * 4;
                        const float* dnn = in[14] + li * 128; const float* snk = in[15] + li * 8;
                        for (int u = ob; u < 256 + MSA + 4; u += on) {
                            if (u < 256) swa_prompt(tid, u, lds, PROJ, snk, MIX);
                            else if (u < 256 + MSA) sample_even(tid, u - 256, li, lds, PROJ, sdn, scv, ckp, cvp, cw, al, dtb, dnn, snk, MIX, outp);
                            else prompt_misc(tid, u - 256 - MSA, li, PROJ, outp);
                        }
                        if (l == 0) {
                            float* scr = (float*)(lds + wave * 16640);
                            const int gw2 = ob * 8 + wave, ngw2 = on * 8;
                            transpose_w(in[16], DM, DM, DM, WEO, scr, gw2, ngw2, lane);
                            transpose_w(in[22], DM, FF, FF, WUP, scr, gw2, ngw2, lane);
                            transpose_w(in[23], FF, DM, DM, WDN, scr, gw2, ngw2, lane);
                            transpose_w(in[17], DM, NO_IN, NPO, WGI, scr, gw2, ngw2, lane);
                            transpose_w(in[21], DM, DM, DM, WGO, scr, gw2, ngw2, lane);
                            transpose_w(in[22] + (size_t)1 * DM * FF, DM, FF, FF, WUP + (size_t)1 * FF * DM, scr, gw2, ngw2, lane);
                            transpose_w(in[23] + (size_t)1 * FF * DM, FF, DM, DM, WDN + (size_t)1 * DM * FF, scr, gw2, ngw2, lane);
                            transpose_w(in[10] + (size_t)DM * NE_IN, DM, NE_IN, NPE, WEI + (size_t)NPE * DM, scr, gw2, ngw2, lane);
                            transpose_w(in[16] + (size_t)DM * DM, DM, DM, DM, WEO + (size_t)DM * DM, scr, gw2, ngw2, lane);
                            transpose_w(in[22] + (size_t)2 * DM * FF, DM, FF, FF, WUP + (size_t)2 * FF * DM, scr, gw2, ngw2, lane);
                            transpose_w(in[23] + (size_t)2 * FF * DM, FF, DM, DM, WDN + (size_t)2 * DM * FF, scr, gw2, ngw2, lane);
                            __syncthreads();
                        }
                        if (l == 2) {
                            float* scr = (float*)(lds + wave * 16640);
                            const int gw2 = ob * 8 + wave, ngw2 = on * 8;
                            transpose_w(in[17] + (size_t)DM * NO_IN, DM, NO_IN, NPO, WGI + (size_t)NPO * DM, scr, gw2, ngw2, lane);
                            transpose_w(in[21] + (size_t)DM * DM, DM, DM, DM, WGO + (size_t)DM * DM, scr, gw2, ngw2, lane);
                            transpose_w(in[22] + (size_t)3 * DM * FF, DM, FF, FF, WUP + (size_t)3 * FF * DM, scr, gw2, ngw2, lane);
                            transpose_w(in[23] + (size_t)3 * FF * DM, FF, DM, DM, WDN + (size_t)3 * DM * FF, scr, gw2, ngw2, lane);
                            __syncthreads();
                        }
                    }
                } else {
                    const int nsc = G >= 2 ? G / 2 : G;
                    if (bid < nsc) gla_scan((bf16*)(ws + SC_GL_US), (const float*)(ws + SC_GL_EGL), outp + O_PGLA + (size_t)li * 2 * 4 * 32768, bid * 512 + tid, nsc * 512);
                    if (G < 2 || bid >= nsc) {
                        const float* wg = in[18] + (size_t)li * 16 * 512; const float* bgp = in[19] + li * 512; const float* gn = in[20] + li * 256; const float* sg = in[6];
                        const int ob = G >= 2 ? bid - nsc : 0, on = G >= 2 ? G - nsc : 1;
                        for (int u = ob; u < MSA; u += on) sample_odd(tid, u, li, lds, PROJ, sg, wg, bgp, gn, MIX, outp);
                    }
                }
            } else if (sp == 3) {
                if (even) { const float* dnn = in[14] + li * 128;
                    for (int u = bid; u < 1024; u += G) dn_stepC(tid, u, lds, PROJ, (const bf16*)(ws + SC_DN_QE), (const bf16*)(ws + SC_DN_AT), (const bf16*)(ws + SC_DN_O), (const bf16*)(ws + SC_DN_VN), dnn, MIX); }
                else { const float* gn = in[20] + li * 256;
                    for (int u = bid; u < 1024; u += G) gla_stepC(tid, u, lds, PROJ, (const bf16*)(ws + SC_GL_US), (const bf16*)(ws + SC_GL_QT), (const bf16*)(ws + SC_GL_OI), gn, MIX); }
            } else if (sp == 4 || sp == 7) {
                pg8::Gemm g{sp == 4 ? MIX : HID, sp == 4 ? (even ? WEO : WGO) + (size_t)li * DM * DM : WDN + (size_t)l * DM * FF, MPR, DM, sp == 4 ? DM : FF};
                pg8::StaticOrder S; S.init(g.M, g.N, G, bid);
#if PROBE_ID == 13 || PROBE_ID == 14
                const float sgn = (repcnt == 1) ? -1.f : 1.f;
#else
                const float sgn = 1.f;
#endif
                pg8::EpiRes E{X, DM, sgn, (l == 0 && sp == 4) ? in[0] : (const float*)X};
                pg8::gemm_phase<pg8::EpiRes, pg8::StaticOrder, true, true>((PG8_LAS unsigned char*)lds, g, S, E);
                for (int u = bid; u < 256; u += G) skinny_res(tid, u, lds, g.A, g.Bt, g.K, X);
            } else if (sp == 5) {
                norm_phase(X, in[8] + l * DM, HB, nullptr, gw, ngw, lane);
            } else if (sp == 6) {
                pg8::Gemm g{HB, WUP + (size_t)l * FF * DM, MPR, FF, DM};
                pg8::StaticOrder S; S.init(g.M, g.N, G, bid);
                pg8::EpiBf16<2> E{HID, FF};
                pg8::gemm_phase<pg8::EpiBf16<2>, pg8::StaticOrder, true, true>((PG8_LAS unsigned char*)lds, g, S, E);
                for (int u = bid; u < 256; u += G) skinny_unit<2>(tid, g.A, g.Bt, DM, DM, (size_t)MPR, u * 16, HID, FF);
            } else {
                if (l < 3) norm_phase(X, in[7] + (l + 1) * DM, HB, nullptr, gw, ngw, lane);
                else norm_phase(X, in[9], nullptr, outp + O_Y, gw, ngw, lane);
            }
        }
#if PROBE_ID
        if (coop) {
            const int l_ = (ph - 1) / 9, sp_ = (ph - 1) % 9, ev_ = !(l_ & 1);
            bool rp = false;
            if (PROBE_ID == 1) xcd_barrier(xbar);
            if (PROBE_ID == 2 && ph == 0) rp = true;
            if (ph > 0) {
                if (PROBE_ID == 3 && ev_ && sp_ == 1) rp = true;
                if ((PROBE_ID == 4 || PROBE_ID == 11 || PROBE_ID == 12) && ev_ && sp_ == 2) rp = true;
                if (PROBE_ID == 5 && !ev_ && sp_ == 1) rp = true;
                if (PROBE_ID == 6 && sp_ == 0) rp = true;
                if (PROBE_ID == 7 && sp_ == 6) rp = true;
                if (PROBE_ID == 8 && !ev_ && sp_ == 3) rp = true;
                if (PROBE_ID == 9 && (sp_ == 5 || sp_ == 8)) rp = true;
                if (PROBE_ID == 10 && ev_ && sp_ == 3) rp = true;
            }
            if ((PROBE_ID == 13 && ph > 0 && sp_ == 4) || (PROBE_ID == 14 && ph > 0 && sp_ == 7)) { if (repcnt < 2) { ++repcnt; --ph; xcd_barrier(xbar); continue; } repcnt = 0; }
            if (PROBE_ID == 15 && ph > 0 && !ev_ && sp_ == 2 && !((donemask >> l_) & 1u)) { donemask |= 1u << l_; ph -= 2; xcd_barrier(xbar); continue; }
            if (rp && !repeated) { repeated = true; --ph; xcd_barrier(xbar); continue; }
            repeated = false;
        }
#endif
        if (ph + 1 < a.ph_hi) { if (coop) xcd_barrier(xbar); }
    }
}

extern "C" void kernel_launch(void* const* d_in, const int* in_sizes, int n_in, void* d_out, int out_size, void* d_ws, size_t ws_size, hipStream_t stream) {
    static int grid = 0;
    if (grid == 0) {
        int dev = 0, cus = 0, per_cu = 0;
        hipGetDevice(&dev);
        hipDeviceGetAttribute(&cus, hipDeviceAttributeMultiprocessorCount, dev);
        hipFuncSetAttribute((const void*)mega_fwd, hipFuncAttributeMaxDynamicSharedMemorySize, LDS_BYTES);
        hipOccupancyMaxActiveBlocksPerMultiprocessor(&per_cu, (const void*)mega_fwd, 512, LDS_BYTES);
        if (per_cu < 1) { fprintf(stderr, "kernel_launch: occupancy query says %d blocks/CU\n", per_cu); per_cu = 1; }
        grid = cus * (per_cu > 1 ? 1 : per_cu);
        if (ws_size < WS_END) { fprintf(stderr, "kernel_launch: workspace too small: %zu < %zu\n", ws_size, (size_t)WS_END); grid = -1; }
        if (n_in != 24) { fprintf(stderr, "kernel_launch: expected 24 inputs, got %d\n", n_in); grid = -1; }
    }
    if (grid < 0) return;
    Args a{};
    for (int i = 0; i < 24; ++i) a.in[i] = (const float*)d_in[i];
    a.out = (float*)d_out; a.ws = (unsigned char*)d_ws;
#if MK_LAUNCH_PER_PHASE
    for (int ph = 0; ph < NPH; ++ph) { a.ph_lo = ph; a.ph_hi = ph + 1; hipLaunchKernelGGL(mega_fwd, dim3(grid), dim3(512), LDS_BYTES, stream, a); }
#else
    a.ph_lo = 0; a.ph_hi = NPH;
    if (hipMemsetAsync((char*)d_ws + WS_BAR, 0, 16384, stream) != hipSuccess) { fprintf(stderr, "kernel_launch: memset of barrier words failed\n"); return; }
    void* args[] = {&a};
    hipError_t e = hipLaunchCooperativeKernel((const void*)mega_fwd, dim3(grid), dim3(512), args, LDS_BYTES, stream);
    if (e != hipSuccess) fprintf(stderr, "cooperative launch failed: %s (grid %d)\n", hipGetErrorString(e), grid);
#endif
}
```
